# Optimizing an MI355X kernel written in HIP

```python
import math
import jax, jax.numpy as jnp
from jax import lax
import numpy as np

D_MODEL = 1024
BATCH = 4
SEQ = 8192
DEPTH = 2

CHUNK = 64
Q_BLOCK = 128
N_BUCKETS = 32
MAX_DISTANCE = 128
EPS = 1e-6
A_HEADS = D_MODEL // 256
A_QK_DIM = 64
A_V_DIM = 2 * A_QK_DIM
A_WIDTH = A_HEADS * A_V_DIM
CONV_CH = D_MODEL // 2
CONV_WIDTH = 31
EVEN_IN = 3 * A_WIDTH + 2 * CONV_CH
GLA_HEADS = 4
GLA_KEY = D_MODEL // 2
GLA_VAL = D_MODEL
GLA_DK = GLA_KEY // GLA_HEADS
GLA_DV = GLA_VAL // GLA_HEADS
GATE_RANK = 16
GATE_TAU = 16.0
ODD_IN = 2 * GLA_KEY + 2 * GLA_VAL + GATE_RANK
PEER_HEADS = 8
N_KEYS = 128
N_EXPERTS = N_KEYS * N_KEYS
PEER_TOPK = 16
PEER_KEY_DIM = 256
PEER_HALF = PEER_KEY_DIM // 2
TOKEN_BLOCK = 128

kernel_name = "hybrid_diffattn_conformer_gla_peer"


def rmsnorm(x, g):
    xf = x.astype(jnp.float32)
    y = xf * lax.rsqrt(jnp.mean(xf * xf, axis=-1, keepdims=True) + EPS)
    return (y * g.astype(jnp.float32)).astype(x.dtype)


def layernorm(x, g, b):
    xf = x.astype(jnp.float32)
    mu = jnp.mean(xf, axis=-1, keepdims=True)
    var = jnp.mean(jnp.square(xf - mu), axis=-1, keepdims=True)
    y = (xf - mu) * lax.rsqrt(var + EPS)
    return (y * g.astype(jnp.float32) + b.astype(jnp.float32)).astype(x.dtype)


def t5_bucket(rel):
    nb = N_BUCKETS // 2
    max_exact = nb // 2
    ret = jnp.where(rel > 0, nb, 0)
    n = jnp.abs(rel)
    nf = jnp.maximum(n, 1).astype(jnp.float32)
    large = max_exact + (jnp.log(nf / max_exact) / math.log(MAX_DISTANCE / max_exact)
                         * (nb - max_exact)).astype(jnp.int32)
    large = jnp.minimum(large, nb - 1)
    return ret + jnp.where(n < max_exact, n, large)


def diff_attention(q1, q2, k1, k2, v, lam, rel_bias):
    S = q1.shape[2]
    scale = A_QK_DIM ** -0.5
    outs = []
    for i in range(S // Q_BLOCK):
        q_lo = i * Q_BLOCK
        kv_len = q_lo + Q_BLOCK
        qpos = jnp.arange(q_lo, kv_len)
        kpos = jnp.arange(kv_len)
        mask = (kpos[None, :] // CHUNK) <= (qpos[:, None] // CHUNK)
        bias = rel_bias[t5_bucket(kpos[None, :] - qpos[:, None])]
        bias = jnp.transpose(bias, (2, 0, 1))[None]

        def probs(q, k):
            logits = jnp.einsum('bhqd,bhkd->bhqk', q[:, :, q_lo:kv_len], k[:, :, :kv_len]) * scale + bias
            return jax.nn.softmax(jnp.where(mask, logits, -jnp.inf), axis=-1)

        p = probs(q1, k1) - lam * probs(q2, k2)
        outs.append(jnp.einsum('bhqk,bhkd->bhqd', p, v[:, :, :kv_len]))
    return jnp.concatenate(outs, axis=2)


def causal_depthwise_conv(u, w, b):
    u_pad = jnp.pad(u, ((0, 0), (CONV_WIDTH - 1, 0), (0, 0)))
    y = lax.conv_general_dilated(u_pad, w[:, None, :].astype(u.dtype), window_strides=(1,), padding='VALID',
                                 dimension_numbers=('NWC', 'WIO', 'NWC'), feature_group_count=u.shape[-1])
    return y + b.astype(u.dtype)


def even_mixer(h, w_in, lam_q1, lam_k1, lam_q2, lam_k2, subln_g, conv_w, conv_b, conv_ln_g, conv_ln_b,
               w_out, rel_bias, layer_idx):
    B, S, _ = h.shape
    proj = h @ w_in
    q, k, v, glu = jnp.split(proj, [A_WIDTH, 2 * A_WIDTH, 3 * A_WIDTH], axis=-1)

    def heads(t, d):
        return t.reshape(B, S, A_HEADS, d).transpose(0, 2, 1, 3).astype(jnp.float32)

    q = heads(q, 2 * A_QK_DIM)
    k = heads(k, 2 * A_QK_DIM)
    v = heads(v, A_V_DIM)
    lam_init = 0.8 - 0.6 * math.exp(-0.3 * layer_idx)
    lam = (jnp.exp(jnp.sum(lam_q1.astype(jnp.float32) * lam_k1.astype(jnp.float32)))
           - jnp.exp(jnp.sum(lam_q2.astype(jnp.float32) * lam_k2.astype(jnp.float32))) + lam_init)
    o = diff_attention(q[..., :A_QK_DIM], q[..., A_QK_DIM:], k[..., :A_QK_DIM], k[..., A_QK_DIM:],
                       v, lam, rel_bias.astype(jnp.float32))
    o = o * lax.rsqrt(jnp.mean(o * o, axis=-1, keepdims=True) + EPS) * subln_g.astype(jnp.float32) * (1.0 - lam_init)
    a_out = o.transpose(0, 2, 1, 3).reshape(B, S, A_WIDTH).astype(h.dtype)

    c_val, c_gate = jnp.split(glu, 2, axis=-1)
    c = c_val * jax.nn.sigmoid(c_gate)
    c = causal_depthwise_conv(c, conv_w, conv_b)
    c = jax.nn.silu(layernorm(c, conv_ln_g, conv_ln_b))
    return jnp.concatenate([a_out, c], axis=-1) @ w_out


def gla_mixer(h, w_in, w_gate2, b_gate2, gla_norm_g, w_out):
    B, S, _ = h.shape
    nc = S // CHUNK
    proj = h @ w_in
    q, k, v, g, z = jnp.split(proj, [GLA_KEY, 2 * GLA_KEY, 2 * GLA_KEY + GLA_VAL,
                                     2 * GLA_KEY + 2 * GLA_VAL], axis=-1)
    log_a = jax.nn.log_sigmoid((z @ w_gate2 + b_gate2).astype(jnp.float32)) / GATE_TAU

    def chunks(t, d):
        return t.reshape(B, nc, CHUNK, GLA_HEADS, d).transpose(0, 3, 1, 2, 4).astype(jnp.float32)

    qc = chunks(q, GLA_DK) * (GLA_DK ** -0.5)
    kc = chunks(k, GLA_DK)
    vc = chunks(v, GLA_DV)
    cum = jnp.cumsum(chunks(log_a, GLA_DK), axis=3)
    k_dec = kc * jnp.exp(cum[:, :, :, -1:, :] - cum)
    chunk_decay = jnp.exp(cum[:, :, :, -1, :])

    def step(state, inp):
        q_i, k_i, v_i, d_i = inp
        state = state * d_i[..., None] + jnp.einsum('bhcd,bhce->bhde', k_i, v_i)
        return state, jnp.einsum('bhcd,bhde->bhce', q_i, state)

    xs = tuple(jnp.moveaxis(t, 2, 0) for t in (qc, k_dec, vc, chunk_decay))
    _, o = lax.scan(step, jnp.zeros((B, GLA_HEADS, GLA_DK, GLA_DV), jnp.float32), xs)
    o = o.transpose(1, 0, 3, 2, 4).reshape(B, S, GLA_HEADS, GLA_DV)
    o = o * lax.rsqrt(jnp.mean(o * o, axis=-1, keepdims=True) + EPS) * gla_norm_g.astype(jnp.float32)
    o = o.reshape(B, S, GLA_VAL) * jax.nn.silu(g.astype(jnp.float32))
    return o.astype(h.dtype) @ w_out


def peer(h, w_query, sub_keys, expert_u, expert_v):
    B, S, D = h.shape
    sk = sub_keys.astype(jnp.float32)

    def block(xb):
        t = xb.shape[0]
        q = (xb @ w_query).reshape(t, PEER_HEADS, 2, PEER_HALF).astype(jnp.float32)
        scores = jnp.einsum('thpd,hpnd->thpn', q, sk)
        s_val, s_idx = lax.top_k(scores, PEER_TOPK)
        cand = s_val[:, :, 0, :, None] + s_val[:, :, 1, None, :]
        c_val, c_idx = lax.top_k(cand.reshape(t, PEER_HEADS, PEER_TOPK * PEER_TOPK), PEER_TOPK)
        i1 = jnp.take_along_axis(s_idx[:, :, 0], c_idx // PEER_TOPK, axis=-1)
        i2 = jnp.take_along_axis(s_idx[:, :, 1], c_idx % PEER_TOPK, axis=-1)
        expert = i1 * N_KEYS + i2
        gate = jax.nn.softmax(c_val, axis=-1)
        act = jax.nn.gelu(jnp.einsum('thkd,td->thk', expert_u[expert], xb).astype(jnp.float32))
        coef = (gate * act).astype(xb.dtype)
        return jnp.einsum('thk,thkd->td', coef, expert_v[expert])

    out = lax.map(block, h.reshape(-1, TOKEN_BLOCK, D))
    return out.reshape(B, S, D)


def setup_inputs(seed: int = 0) -> dict:
    key = jax.random.key(seed)
    ks = iter(jax.random.split(key, 32))
    f32 = jnp.float32
    n_even = (DEPTH + 1) // 2
    n_odd = DEPTH // 2

    def nrm(shape, scale):
        return jax.random.normal(next(ks), shape, f32) * scale

    def gain(shape):
        return 1.0 + nrm(shape, 0.02)

    return {
        "x": nrm((BATCH, SEQ, D_MODEL), 1.0),
        "rel_bias": nrm((N_BUCKETS, A_HEADS), 0.1),
        "ln_mix": gain((DEPTH, D_MODEL)),
        "ln_ffn": gain((DEPTH, D_MODEL)),
        "even_w_in": nrm((n_even, D_MODEL, EVEN_IN), D_MODEL ** -0.5),
        "lam_q1": nrm((n_even, A_QK_DIM), 0.1),
        "lam_k1": nrm((n_even, A_QK_DIM), 0.1),
        "lam_q2": nrm((n_even, A_QK_DIM), 0.1),
        "lam_k2": nrm((n_even, A_QK_DIM), 0.1),
        "subln_g": gain((n_even, A_V_DIM)),
        "conv_w": nrm((n_even, CONV_WIDTH, CONV_CH), CONV_WIDTH ** -0.5),
        "conv_b": nrm((n_even, CONV_CH), 0.02),
        "conv_ln_g": gain((n_even, CONV_CH)),
        "conv_ln_b": nrm((n_even, CONV_CH), 0.02),
        "even_w_out": nrm((n_even, A_WIDTH + CONV_CH, D_MODEL), (A_WIDTH + CONV_CH) ** -0.5),
        "odd_w_in": nrm((n_odd, D_MODEL, ODD_IN), D_MODEL ** -0.5),
        "w_gate2": nrm((n_odd, GATE_RANK, GLA_KEY), GATE_RANK ** -0.5),
        "b_gate2": nrm((n_odd, GLA_KEY), 0.1),
        "gla_norm_g": gain((n_odd, GLA_DV)),
        "odd_w_out": nrm((n_odd, GLA_VAL, D_MODEL), GLA_VAL ** -0.5),
        "peer_w_query": nrm((DEPTH, D_MODEL, PEER_HEADS * PEER_KEY_DIM), D_MODEL ** -0.5),
        "peer_sub_keys": nrm((DEPTH, PEER_HEADS, 2, N_KEYS, PEER_HALF), PEER_HALF ** -0.5),
        "peer_u": nrm((DEPTH, N_EXPERTS, D_MODEL), D_MODEL ** -0.5),
        "peer_v": nrm((DEPTH, N_EXPERTS, D_MODEL), 0.25),
        "ln_final": gain((D_MODEL,)),
    }


def reference(x, rel_bias, ln_mix, ln_ffn, even_w_in, lam_q1, lam_k1, lam_q2, lam_k2, subln_g, conv_w,
              conv_b, conv_ln_g, conv_ln_b, even_w_out, odd_w_in, w_gate2, b_gate2, gla_norm_g, odd_w_out,
              peer_w_query, peer_sub_keys, peer_u, peer_v, ln_final):
    for l in range(DEPTH):
        hn = rmsnorm(x, ln_mix[l])
        i = l // 2
        if l % 2 == 0:
            x = x + even_mixer(hn, even_w_in[i], lam_q1[i], lam_k1[i], lam_q2[i], lam_k2[i], subln_g[i],
                               conv_w[i], conv_b[i], conv_ln_g[i], conv_ln_b[i], even_w_out[i], rel_bias, l)
        else:
            x = x + gla_mixer(hn, odd_w_in[i], w_gate2[i], b_gate2[i], gla_norm_g[i], odd_w_out[i])
        x = x + peer(rmsnorm(x, ln_ffn[l]), peer_w_query[l], peer_sub_keys[l], peer_u[l], peer_v[l])
    return rmsnorm(x, ln_final)
```

```cpp
#include <hip/hip_runtime.h>
#include <cstdio>
#include <cstdint>
namespace pg8 {
#define PG8_LAS __attribute__((address_space(3)))
typedef unsigned short bf16_t;
typedef short bf16x8 __attribute__((ext_vector_type(8)));
typedef float f32x4 __attribute__((ext_vector_type(4)));
typedef unsigned u32x4 __attribute__((ext_vector_type(4)));
constexpr int BM = 256, BK = 64, HALF = 128, HTB = HALF * BK * 2  , STAGE_BYTES = 8 * HTB, NXCD = 8, WGM = 8;

__host__ __device__ __forceinline__ int lds_byte(int r, int c) { const int st = (r >> 4) * 2 + (c >> 5), rr = r & 15, cc = c & 31, ob = rr * 64 + cc * 2; return st * 1024 + (ob ^ (((ob >> 9) & 1) << 5)); }
__host__ __device__ __forceinline__ void stage_rc(int b, int& R, int& C) { const int st = b / 1024, sb = b % 1024, swz = sb ^ (((sb >> 9) & 1) << 5); R = (st >> 1) * 16 + swz / 64; C = (st & 1) * 32 + (swz % 64) / 2; }
__host__ __device__ __forceinline__ int perm32(int rho) { const int n = rho >> 4, i = rho & 15; return 8 * (i >> 2) + 4 * n + (i & 3); }

struct Unit { int pm, pn; };
struct Gemm { const bf16_t* A; const bf16_t* Bt; int M, N, K; };

struct StaticOrder {
    int nM, nN, nwg, G, c;
    __host__ __device__ void init(int M, int N, int G_, int c_) { nM = M / BM; nN = N / BM; nwg = nM * nN; G = G_; c = c_; }
    __host__ __device__ bool next(int i, Unit& u) const {
        const long L = (long)i * G + c; if (L >= nwg) return false;
        int wgid = (int)L; { const int q = nwg / NXCD, r = nwg % NXCD, xcd = wgid % NXCD, off = wgid / NXCD; wgid = (xcd < r ? xcd * (q + 1) : r * (q + 1) + (xcd - r) * q) + off; }
        const int nig = WGM * nN, gid = wgid / nig, fm = gid * WGM, gsz = (nM - fm) < WGM ? (nM - fm) : WGM;
        u.pm = fm + ((wgid % nig) % gsz); u.pn = (wgid % nig) / gsz; return true;
    }
    __device__ __forceinline__ void a_ready(const Unit&) const {}
    __device__ __forceinline__ void done(const Unit&) const {}
};
__device__ __forceinline__ unsigned cvt_pk_bf16(float lo, float hi) { unsigned r; asm volatile("v_cvt_pk_bf16_f32 %0, %1, %2" : "=v"(r) : "v"(lo), "v"(hi)); return r; }
template <class Epi, class Sched, bool ALIGN_EPI = false, bool SP2 = false>
__device__ __forceinline__ void gemm_phase(PG8_LAS unsigned char* lds, const Gemm g, const Sched& S, const Epi& E) {
    const int tid = threadIdx.x, wid = __builtin_amdgcn_readfirstlane(tid >> 6), lane = tid & 63, wr = wid >> 2, wc = wid & 3, fr = lane & 15, fq = lane >> 4;
    const int K = g.K, nt = K / BK;
    unsigned voffA[2], voffB[2];
#pragma unroll
    for (int i = 0; i < 2; ++i) { int R, C; stage_rc(tid * 16 + i * 8192, R, C); const int Rb = Epi::PERM ? ((R & ~31) + perm32(R & 31)) : R;
        voffA[i] = (unsigned)(R * K + C) * 2u; voffB[i] = (unsigned)(Rb * K + C) * 2u; }
    const size_t kstep = (size_t)(BK * 2);
    const size_t hstep = (size_t)HALF * K * 2;
    const size_t tstep = 2 * hstep;
    const unsigned ldsw = (unsigned)wid * 1024u;
    const int aoff = lds_byte(wr * 64 + fr, fq * 8), boff = lds_byte(wc * 32 + fr, fq * 8);
#define PG8_SA(b, h) (((b) * 2 + (h)) * HTB)
#define PG8_SB(b, h) ((4 + (b) * 2 + (h)) * HTB)
#define PG8_STAGE(bufoff, gbase, voff) do { _Pragma("unroll") for (int _i = 0; _i < 2; ++_i) \
        __builtin_amdgcn_global_load_lds((const unsigned*)((const char*)(gbase) + (voff)[_i]), (PG8_LAS unsigned*)(lds + (bufoff) + ldsw + _i * 8192), 16, 0, 0); } while (0)
#define PG8_LDA(dst, b, h) do { _Pragma("unroll") for (int m = 0; m < 4; ++m) _Pragma("unroll") for (int k = 0; k < 2; ++k) dst[m][k] = *(const PG8_LAS bf16x8*)(lds + PG8_SA(b, h) + aoff + m * 2048 + k * 1024); } while (0)
#define PG8_LDB(dst, b, h) do { _Pragma("unroll") for (int n = 0; n < 2; ++n) _Pragma("unroll") for (int k = 0; k < 2; ++k) dst[n][k] = *(const PG8_LAS bf16x8*)(lds + PG8_SB(b, h) + boff + n * 2048 + k * 1024); } while (0)
#define PG8_MMA(ai, bj, At, Bt) do { __builtin_amdgcn_s_setprio(1); _Pragma("unroll") for (int m = 0; m < 4; ++m) _Pragma("unroll") for (int n = 0; n < 2; ++n) _Pragma("unroll") for (int k = 0; k < 2; ++k) \
        acc[ai][bj][m][n] = __builtin_amdgcn_mfma_f32_16x16x32_bf16(Bt[n][k], At[m][k], acc[ai][bj][m][n], 0, 0, 0); __builtin_amdgcn_s_setprio(0); } while (0)
#define PG8_WAIT_V(n) asm volatile("s_waitcnt vmcnt(" #n ")" ::: "memory")
#define PG8_WAIT_L(n) asm volatile("s_waitcnt lgkmcnt(" #n ")" ::: "memory")
#define PG8_BAR __builtin_amdgcn_s_barrier()
#define PG8_SCHED __builtin_amdgcn_sched_barrier(0)
    Unit cur, nxt; int ui = 0;
    if (!S.next(0, cur)) return;
    f32x4 acc[2][2][4][2];
#pragma unroll
    for (int a = 0; a < 2; ++a)
#pragma unroll
        for (int b = 0; b < 2; ++b)
#pragma unroll
            for (int m = 0; m < 4; ++m)
#pragma unroll
                for (int n = 0; n < 2; ++n) acc[a][b][m][n] = (f32x4){0.f, 0.f, 0.f, 0.f};
    bf16x8 At[4][2], B0[2][2], B1[2][2];
    const char* cA = (const char*)g.A + (size_t)cur.pm * tstep; const char* cB = (const char*)g.Bt + (size_t)cur.pn * tstep;
    S.a_ready(cur);
    if constexpr (SP2) {
        PG8_STAGE(PG8_SB(0, 0), cB, voffB); PG8_STAGE(PG8_SB(0, 1), cB + hstep, voffB); PG8_STAGE(PG8_SA(0, 0), cA, voffA); PG8_STAGE(PG8_SA(0, 1), cA + hstep, voffA);
        if (wr == 1) PG8_BAR;
        PG8_WAIT_V(2); PG8_BAR;
        PG8_STAGE(PG8_SB(1, 0), cB + kstep, voffB); PG8_STAGE(PG8_SA(1, 0), cA + kstep, voffA); PG8_STAGE(PG8_SB(1, 1), cB + hstep + kstep, voffB);
        PG8_WAIT_V(6); PG8_BAR;
    } else {
        PG8_STAGE(PG8_SB(0, 0), cB, voffB); PG8_STAGE(PG8_SA(0, 0), cA, voffA); PG8_STAGE(PG8_SB(0, 1), cB + hstep, voffB); PG8_STAGE(PG8_SA(0, 1), cA + hstep, voffA);
        if (wr == 1) PG8_BAR;
        PG8_WAIT_V(4); PG8_BAR;
        PG8_STAGE(PG8_SB(1, 0), cB + kstep, voffB); PG8_STAGE(PG8_SA(1, 0), cA + kstep, voffA); PG8_STAGE(PG8_SB(1, 1), cB + hstep + kstep, voffB);
        PG8_WAIT_V(6); PG8_BAR;
    }
    for (;;) {
        const bool has_next = S.next(ui + 1, nxt);
        const char* nA = has_next ? (const char*)g.A + (size_t)nxt.pm * tstep : cA; const char* nB = has_next ? (const char*)g.Bt + (size_t)nxt.pn * tstep : cB;
        for (int t = 0; t < nt; t += 2) {
            const bool last = (t == nt - 2);
            const char* a1 = cA + (size_t)(t + 1) * kstep;
            const char* a2 = last ? nA : cA + (size_t)(t + 2) * kstep; const char* b2 = last ? nB : cB + (size_t)(t + 2) * kstep;
            const char* a3 = a2 + kstep; const char* b3 = b2 + kstep;
            if (last && has_next) S.a_ready(nxt);
            if constexpr (SP2) {
            PG8_LDB(B0, 0, 0); PG8_LDB(B1, 0, 1); PG8_SCHED; PG8_LDA(At, 0, 0); PG8_STAGE(PG8_SA(1, 1), a1 + hstep, voffA);
            PG8_WAIT_V(8); PG8_WAIT_L(0); PG8_BAR; PG8_MMA(0, 0, At, B0); PG8_MMA(0, 1, At, B1); PG8_BAR; PG8_SCHED;
            PG8_LDA(At, 0, 1); PG8_STAGE(PG8_SB(0, 0), b2, voffB); PG8_STAGE(PG8_SB(0, 1), b2 + hstep, voffB); PG8_STAGE(PG8_SA(0, 0), a2, voffA);
            PG8_WAIT_V(8); PG8_WAIT_L(0); PG8_BAR; PG8_MMA(1, 0, At, B0); PG8_MMA(1, 1, At, B1); PG8_BAR; PG8_SCHED;
            PG8_LDB(B0, 1, 0); PG8_LDB(B1, 1, 1); PG8_SCHED; PG8_LDA(At, 1, 0); PG8_STAGE(PG8_SA(0, 1), a2 + hstep, voffA);
            PG8_WAIT_V(8); PG8_WAIT_L(0); PG8_BAR; PG8_MMA(0, 0, At, B0); PG8_MMA(0, 1, At, B1); PG8_BAR; PG8_SCHED;
            PG8_LDA(At, 1, 1); PG8_STAGE(PG8_SB(1, 0), b3, voffB); PG8_STAGE(PG8_SB(1, 1), b3 + hstep, voffB); PG8_STAGE(PG8_SA(1, 0), a3, voffA);
            PG8_WAIT_V(8); PG8_WAIT_L(0); PG8_BAR; PG8_MMA(1, 0, At, B0); PG8_MMA(1, 1, At, B1); PG8_BAR; PG8_SCHED;
            } else {
            PG8_LDB(B0, 0, 0); PG8_SCHED; PG8_LDA(At, 0, 0); PG8_STAGE(PG8_SA(1, 1), a1 + hstep, voffA);
            PG8_WAIT_L(8); PG8_BAR; PG8_WAIT_L(0); PG8_MMA(0, 0, At, B0); PG8_BAR; PG8_SCHED;
            PG8_LDB(B1, 0, 1); PG8_STAGE(PG8_SB(0, 0), b2, voffB);
            PG8_BAR; PG8_WAIT_L(0); PG8_MMA(0, 1, At, B1); PG8_BAR;
            PG8_LDA(At, 0, 1); PG8_STAGE(PG8_SA(0, 0), a2, voffA);
            PG8_BAR; PG8_WAIT_L(0); PG8_MMA(1, 0, At, B0); PG8_BAR; PG8_SCHED;
            PG8_STAGE(PG8_SB(0, 1), b2 + hstep, voffB);
            PG8_WAIT_V(6); PG8_BAR; PG8_MMA(1, 1, At, B1); PG8_BAR;
            PG8_LDB(B0, 1, 0); PG8_SCHED; PG8_LDA(At, 1, 0); PG8_STAGE(PG8_SA(0, 1), a2 + hstep, voffA);
            PG8_WAIT_L(8); PG8_BAR; PG8_WAIT_L(0); PG8_MMA(0, 0, At, B0); PG8_BAR; PG8_SCHED;
            PG8_LDB(B1, 1, 1); PG8_STAGE(PG8_SB(1, 0), b3, voffB);
            PG8_BAR; PG8_WAIT_L(0); PG8_MMA(0, 1, At, B1); PG8_BAR;
            PG8_LDA(At, 1, 1); PG8_STAGE(PG8_SA(1, 0), a3, voffA);
            PG8_BAR; PG8_WAIT_L(0); PG8_MMA(1, 0, At, B0); PG8_BAR; PG8_SCHED;
            PG8_STAGE(PG8_SB(1, 1), b3 + hstep, voffB);
            PG8_WAIT_V(6); PG8_BAR; PG8_MMA(1, 1, At, B1); PG8_BAR;
            }
        }
        if constexpr (ALIGN_EPI) { if (wr == 0) PG8_BAR; }
        if constexpr (!Epi::AFTER_DRAIN) { E(acc, cur, wr, wc, fr, fq); S.done(cur); }
        if (!has_next) break;
#pragma unroll
        for (int a = 0; a < 2; ++a)
#pragma unroll
            for (int b = 0; b < 2; ++b)
#pragma unroll
                for (int m = 0; m < 4; ++m)
#pragma unroll
                    for (int n = 0; n < 2; ++n) acc[a][b][m][n] = (f32x4){0.f, 0.f, 0.f, 0.f};
        cur = nxt; cA = nA; cB = nB; ++ui;
        if constexpr (ALIGN_EPI) { if (wr == 1) PG8_BAR; }
    }
    PG8_WAIT_V(0);
    if constexpr (!ALIGN_EPI) { if (wr == 0) PG8_BAR; }
    PG8_BAR;
    if constexpr (Epi::AFTER_DRAIN) { E.fused(acc, cur, wr, wc, fr, fq, lds, wid, lane); S.done(cur); }
#undef PG8_SA
#undef PG8_SB
#undef PG8_STAGE
#undef PG8_LDA
#undef PG8_LDB
#undef PG8_MMA
#undef PG8_WAIT_V
#undef PG8_WAIT_L
#undef PG8_BAR
#undef PG8_SCHED
}
}

constexpr int NB = 4, SEQ = 8192, DM = 1024, NT = NB * SEQ;
constexpr int EVEN_IN = 2560, ODD_IN = 3088, ODD_IN_PAD = 3328, PQ_N = 2048;
constexpr int NEXP = 16384;
constexpr float EPS = 1e-6f;
constexpr float LOG2E = 1.4426950408889634f;
constexpr float QSCALE_ATT = 0.125f * LOG2E;
constexpr float QSCALE_GLA = 0.08838834764831845f;
constexpr float LAM_INIT0 = 0.2f;

constexpr size_t MiB = 1u << 20;
constexpr size_t WS_CTL = 0, CTL_ZERO_BYTES = 1 * MiB;
constexpr size_t WS_ROWSQ0 = 27 * MiB, WS_ROWSQ1 = 29 * MiB;
constexpr size_t WS_DEC = 1 * MiB;
constexpr size_t WS_WIN0 = 2 * MiB, WS_WOUT0 = 7 * MiB, WS_WIN1 = 9 * MiB, WS_WOUT1 = 16 * MiB, WS_WQ0 = 18 * MiB, WS_WQ1 = 22 * MiB, WS_SK = 26 * MiB;
constexpr size_t WS_UT = 32 * MiB, WS_VT = 96 * MiB;
constexpr size_t WS_HN = 160 * MiB;
constexpr size_t WS_IDS = 224 * MiB, WS_GATE = 240 * MiB;
constexpr size_t WS_SCR = 256 * MiB;
constexpr size_t S0_Q = WS_SCR, S0_K = WS_SCR + 32 * MiB, S0_VT = WS_SCR + 64 * MiB, S0_GLU = WS_SCR + 96 * MiB, S0_CAT = WS_SCR + 128 * MiB;
constexpr size_t SP_PQ = WS_SCR;
constexpr size_t S1_Q = WS_SCR, S1_K = WS_SCR + 32 * MiB, S1_V = WS_SCR + 64 * MiB, S1_G = WS_SCR + 128 * MiB, S1_Z = WS_SCR + 192 * MiB;
constexpr size_t WS_END = 456 * MiB;

constexpr int LDS_BYTES = 155648;
constexpr int MISC_OFF = LDS_BYTES - 256;
constexpr int NWAVES = 8, NTHREADS = 512;

#define GAS __attribute__((address_space(1)))
#define LAS __attribute__((address_space(3)))
typedef unsigned short bf16;
typedef unsigned v4u __attribute__((ext_vector_type(4)));
typedef unsigned v2u __attribute__((ext_vector_type(2)));
typedef float f32x4 __attribute__((ext_vector_type(4)));
typedef float f32x16 __attribute__((ext_vector_type(16)));
typedef short bf16x8 __attribute__((ext_vector_type(8)));
typedef float f32x2_t __attribute__((ext_vector_type(2)));
typedef __bf16 bf16x2_t __attribute__((ext_vector_type(2)));
#define LDS_WAIT() asm volatile("s_waitcnt lgkmcnt(0)" ::: "memory")
#define VM_WAIT() asm volatile("s_waitcnt vmcnt(0)" ::: "memory")
__device__ __forceinline__ unsigned pk2(float lo, float hi) { f32x2_t v = {lo, hi}; bf16x2_t b = __builtin_convertvector(v, bf16x2_t); return __builtin_bit_cast(unsigned, b); }
__device__ __forceinline__ float bf_lo(unsigned w) { return __builtin_bit_cast(float, w << 16); }
__device__ __forceinline__ float bf_hi(unsigned w) { return __builtin_bit_cast(float, w & 0xffff0000u); }
__device__ __forceinline__ float bf2f(bf16 v) { return __builtin_bit_cast(float, (unsigned)v << 16); }
__device__ __forceinline__ bf16 f2bf(float f) { return (bf16)(pk2(f, 0.f) & 0xffffu); }
__device__ __forceinline__ float wave_sum(float v) {
#pragma unroll
    for (int o = 1; o < 64; o <<= 1) v += __shfl_xor(v, o);
    return v;
}
__device__ __forceinline__ float fast_exp2(float x) { return __builtin_amdgcn_exp2f(x); }
__device__ __forceinline__ float fast_rcp(float x) { return __builtin_amdgcn_rcpf(x); }
__device__ __forceinline__ float sigmoidf_(float x) { return fast_rcp(1.f + fast_exp2(-x * LOG2E)); }
__device__ __forceinline__ float siluf_(float x) { return x * sigmoidf_(x); }
#define XB_TMO      128
#define XB_XCNT(j)  (256  + 64 * (j))
#define XB_XSUB(j)  (1280 + 64 * (j))
#define XB_XGEN(j)  (2304 + 64 * (j))
#define XB_TOP      3328
#define XB_TOPGEN   3392
#define XCD_BAR_WORDS 3456
#define XB_SPIN_CAP (1u << 18)

__device__ __forceinline__ unsigned xb_ld(unsigned* p)              { return __hip_atomic_load(p, __ATOMIC_RELAXED, __HIP_MEMORY_SCOPE_AGENT); }
__device__ __forceinline__ unsigned xb_add(unsigned* p, unsigned v) { return __hip_atomic_fetch_add(p, v, __ATOMIC_RELAXED, __HIP_MEMORY_SCOPE_AGENT); }
__device__ __forceinline__ unsigned xb_xcc_id() { return (unsigned)__builtin_amdgcn_s_getreg((3 << 11) | 20) & 0xFu; }
#define XB_SPIN(cond, bar) do { unsigned _sp = 0; while (cond) { __builtin_amdgcn_s_sleep(1); \
    if ((++_sp & 255u) == 0u) { if (xb_ld(&(bar)[XB_TMO])) break; if (_sp > XB_SPIN_CAP) { atomicAdd(&(bar)[XB_TMO], 1u); break; } } } } while (0)

struct XcdBarrier {
    unsigned* bar; unsigned x;
    volatile LAS unsigned* st;
};

__device__ __forceinline__ XcdBarrier xcd_barrier_post(unsigned* bar, volatile LAS unsigned* st) {
    XcdBarrier b; b.bar = bar; b.x = xb_xcc_id(); b.st = st;
    if (threadIdx.x == 0) (void)xb_add(&bar[XB_XCNT(b.x)], 1u);
    return b;
}
__device__ __forceinline__ void xcd_barrier_complete(unsigned* bar, unsigned x, unsigned& nloc, unsigned& nx) {
    const unsigned G = gridDim.x * gridDim.y * gridDim.z;
    unsigned sum, cnt, mine, sp = 0u;
    for (;;) {
        sum = 0u; cnt = 0u; mine = 0u;
#pragma unroll
        for (unsigned j = 0; j < 16; ++j) { const unsigned c = xb_ld(&bar[XB_XCNT(j)]); sum += c; cnt += (c > 0u) ? 1u : 0u; mine = (j == x) ? c : mine; }
        if (sum == G) break;
        __builtin_amdgcn_s_sleep(1);
        if ((++sp & 255u) == 0u) { if (xb_ld(&bar[XB_TMO])) break; if (sp > XB_SPIN_CAP) { atomicAdd(&bar[XB_TMO], 1u); break; } }
    }
    nloc = mine > 0u ? mine : 1u; nx = cnt > 0u ? cnt : 1u;
}

__device__ __forceinline__ void xcd_barrier(const XcdBarrier& b) {
    asm volatile("s_waitcnt vmcnt(0)" ::: "memory");
    __syncthreads();
    if (threadIdx.x == 0) {
        unsigned* bar = b.bar;
        __builtin_amdgcn_s_waitcnt(0);
        unsigned nloc = b.st[0], nx = b.st[1];
        if (nloc == 0u) { xcd_barrier_complete(bar, b.x, nloc, nx); b.st[0] = nloc; b.st[1] = nx; }
        const unsigned old = xb_add(&bar[XB_XSUB(b.x)], 1u);
        const unsigned gen = old / nloc;
        if (old + 1u == (gen + 1u) * nloc) {
            __builtin_amdgcn_fence(__ATOMIC_RELEASE, "agent");
            asm volatile("s_waitcnt vmcnt(0)" ::: "memory");
            const unsigned og = xb_add(&bar[XB_TOP], 1u);
            const unsigned tg = og / nx;
            if (og + 1u == (tg + 1u) * nx) xb_add(&bar[XB_TOPGEN], 1u);
            else XB_SPIN(xb_ld(&bar[XB_TOPGEN]) == tg, bar);
            __builtin_amdgcn_fence(__ATOMIC_ACQUIRE, "agent");
            xb_add(&bar[XB_XGEN(b.x)], 1u);
            asm volatile("s_waitcnt vmcnt(0)" ::: "memory");
        } else {
            XB_SPIN(xb_ld(&bar[XB_XGEN(b.x)]) == gen, bar);
            __builtin_amdgcn_fence(__ATOMIC_ACQUIRE, "agent");
            asm volatile("s_waitcnt vmcnt(0)" ::: "memory");
        }
    }
    __syncthreads();
}

struct Frame {
    LAS unsigned char* lds;
    volatile LAS unsigned* MISC;
    unsigned* ctl;
    int tid, lane, wave;
    int vcu, G;
    const float* const __attribute__((address_space(4)))* in;
    float* out;
    unsigned char* ws;
};
enum { I_X = 0, I_RELB, I_LNMIX, I_LNFFN, I_EWIN, I_LQ1, I_LK1, I_LQ2, I_LK2, I_SUBLN, I_CONVW, I_CONVB, I_CLNG, I_CLNB, I_EWOUT, I_OWIN, I_WG2, I_BG2, I_GLAG, I_OWOUT, I_PWQ, I_PSK, I_PU, I_PV, I_LNF };

__device__ __forceinline__ void p0_transpose_item(const float* W, int Nsrc, bf16* WT, int kb, int dstrow0, int srccol0, const float* gain, LAS float* scr, int lane) {
    const int k0 = 64 * kb; const int col = srccol0 + (lane & 31); const bool ok = col < Nsrc;
#pragma unroll 8
    for (int i = 0; i < 32; ++i) { const int kk = 2 * i + (lane >> 5); float v = ok ? W[(size_t)(k0 + kk) * Nsrc + col] : 0.f; if (gain) v *= gain[k0 + kk]; scr[kk * 33 + (lane & 31)] = v; }
    LDS_WAIT(); asm volatile("" ::: "memory");
    const int c = lane & 7;
#pragma unroll
    for (int j = 0; j < 4; ++j) { const int n = (lane >> 3) + 8 * j; const LAS float* s = scr + (8 * c) * 33 + n;
        v4u o; o.x = pk2(s[0 * 33], s[1 * 33]); o.y = pk2(s[2 * 33], s[3 * 33]); o.z = pk2(s[4 * 33], s[5 * 33]); o.w = pk2(s[6 * 33], s[7 * 33]);
        *(v4u*)(WT + (size_t)(dstrow0 + n) * 1024 + k0 + 8 * c) = o; }
    LDS_WAIT(); asm volatile("" ::: "memory");
}
__device__ __forceinline__ int win0_src(int dstrow) { if (dstrow < 1536) return dstrow; const int r = dstrow - 1536, j = r >> 8, half = (r >> 7) & 1, i = r & 127; return 1536 + 512 * half + 128 * j + i; }

__device__ __forceinline__ void rms_row_to_bf16(const float* xrow, const float* g, bf16* orow, int lane) {
    const f32x4* xr = (const f32x4*)xrow + lane; const f32x4* gr = (const f32x4*)g + lane;
    f32x4 v[4]; float s = 0.f;
#pragma unroll
    for (int j = 0; j < 4; ++j) { v[j] = xr[64 * j]; s += (v[j].x * v[j].x + v[j].y * v[j].y) + (v[j].z * v[j].z + v[j].w * v[j].w); }
    const float r = 1.f / sqrtf(wave_sum(s) * (1.f / DM) + EPS);
    v2u* o8 = (v2u*)orow + lane;
#pragma unroll
    for (int j = 0; j < 4; ++j) { const f32x4 gg = gr[64 * j]; v2u w; w.x = pk2(v[j].x * r * gg.x, v[j].y * r * gg.y); w.y = pk2(v[j].z * r * gg.z, v[j].w * r * gg.w); o8[64 * j] = w; }
}
__device__ __forceinline__ void cvt_stream_bf16(const float* src, bf16* dst, size_t n, int gtid, int gthreads) {
    const size_t n8 = n >> 3;
    for (size_t i = gtid; i < n8; i += gthreads) { const f32x4 a = ((const f32x4*)src)[2 * i], b = ((const f32x4*)src)[2 * i + 1];
        v4u o; o.x = pk2(a.x, a.y); o.y = pk2(a.z, a.w); o.z = pk2(b.x, b.y); o.w = pk2(b.z, b.w); ((v4u*)dst)[i] = o; }
}
__device__ __forceinline__ void p0_prologue(Frame& F) {
    LAS float* scr = (LAS float*)(F.lds + F.wave * 8704);
    const int gw = F.vcu * NWAVES + F.wave, NGW = F.G * NWAVES;
    bf16* WIN0 = (bf16*)(F.ws + WS_WIN0); bf16* WOUT0 = (bf16*)(F.ws + WS_WOUT0); bf16* WIN1 = (bf16*)(F.ws + WS_WIN1); bf16* WOUT1 = (bf16*)(F.ws + WS_WOUT1);
    bf16* WQ0 = (bf16*)(F.ws + WS_WQ0); bf16* WQ1 = (bf16*)(F.ws + WS_WQ1);
    constexpr int I0 = 16 * (EVEN_IN / 32), I1 = 16 * (DM / 32), I2 = 16 * (ODD_IN_PAD / 32), I3 = I1, I4 = 16 * (PQ_N / 32), I5 = I4;
    constexpr int NITEMS = I0 + I1 + I2 + I3 + I4 + I5;
    for (int it = gw; it < NITEMS; it += NGW) {
        int r = it;
        if (r < I0) { const int nb = r % (EVEN_IN / 32), kb = r / (EVEN_IN / 32); p0_transpose_item(F.in[I_EWIN], EVEN_IN, WIN0, kb, 32 * nb, win0_src(32 * nb), nullptr, scr, F.lane); continue; } r -= I0;
        if (r < I1) { const int nb = r % (DM / 32), kb = r / (DM / 32); p0_transpose_item(F.in[I_EWOUT], DM, WOUT0, kb, 32 * nb, 32 * nb, nullptr, scr, F.lane); continue; } r -= I1;
        if (r < I2) { const int nb = r % (ODD_IN_PAD / 32), kb = r / (ODD_IN_PAD / 32); p0_transpose_item(F.in[I_OWIN], ODD_IN, WIN1, kb, 32 * nb, 32 * nb, nullptr, scr, F.lane); continue; } r -= I2;
        if (r < I3) { const int nb = r % (DM / 32), kb = r / (DM / 32); p0_transpose_item(F.in[I_OWOUT], DM, WOUT1, kb, 32 * nb, 32 * nb, nullptr, scr, F.lane); continue; } r -= I3;
        if (r < I4) { const int nb = r % (PQ_N / 32), kb = r / (PQ_N / 32); p0_transpose_item(F.in[I_PWQ], PQ_N, WQ0, kb, 32 * nb, 32 * nb, F.in[I_LNFFN], scr, F.lane); continue; } r -= I4;
        { const int nb = r % (PQ_N / 32), kb = r / (PQ_N / 32); p0_transpose_item(F.in[I_PWQ] + (size_t)DM * PQ_N, PQ_N, WQ1, kb, 32 * nb, 32 * nb, F.in[I_LNFFN] + DM, scr, F.lane); }
    }
    const int gtid = F.vcu * NTHREADS + F.tid, gthreads = F.G * NTHREADS;
    cvt_stream_bf16(F.in[I_PSK], (bf16*)(F.ws + WS_SK), (size_t)2 * 8 * 2 * 128 * 128, gtid, gthreads);
    cvt_stream_bf16(F.in[I_PU], (bf16*)(F.ws + WS_UT), (size_t)2 * NEXP * DM, gtid, gthreads);
    cvt_stream_bf16(F.in[I_PV], (bf16*)(F.ws + WS_VT), (size_t)2 * NEXP * DM, gtid, gthreads);
    bf16* HN = (bf16*)(F.ws + WS_HN);
    for (int m = gw; m < NT; m += NGW) rms_row_to_bf16(F.in[I_X] + (size_t)m * DM, F.in[I_LNMIX], HN + (size_t)m * DM, F.lane);
}

struct EpiIn0 {
    static constexpr bool PERM = false, AFTER_DRAIN = false;
    bf16* Q; bf16* K; bf16* Vt; bf16* GLU;
    __device__ __forceinline__ void operator()(const pg8::f32x4 (&acc)[2][2][4][2], const pg8::Unit& u, int wr, int wc, int fr, int fq) const {
        const int pn = u.pn;
#pragma unroll
        for (int ai = 0; ai < 2; ++ai)
#pragma unroll
            for (int m = 0; m < 4; ++m) {
                const int row = u.pm * 256 + ai * 128 + wr * 64 + m * 16 + fr; const int b = row >> 13, s = row & 8191;
                if (pn < 4) {
                    bf16* base = (pn < 2) ? Q : K; const float sc = (pn < 2) ? QSCALE_ATT : 1.f;
#pragma unroll
                    for (int bj = 0; bj < 2; ++bj)
#pragma unroll
                        for (int n = 0; n < 2; ++n) { const int c = (pn & 1) * 256 + bj * 128 + wc * 32 + n * 16 + fq * 4; const int h = c >> 7, mp = (c >> 6) & 1, d = c & 63;
                            const pg8::f32x4 v = acc[ai][bj][m][n] * sc; v2u w; w.x = pk2(v[0], v[1]); w.y = pk2(v[2], v[3]);
                            *(v2u*)(base + ((((size_t)(b * 4 + h) * 2 + mp) * SEQ + s) * 64 + d)) = w; }
                } else if (pn < 6) {
#pragma unroll
                    for (int bj = 0; bj < 2; ++bj)
#pragma unroll
                        for (int n = 0; n < 2; ++n) { const int c = (pn - 4) * 256 + bj * 128 + wc * 32 + n * 16 + fq * 4; const int h = c >> 7, d = c & 127;
                            bf16* p = Vt + ((size_t)(b * 4 + h) * 128 + d) * SEQ + s; const pg8::f32x4 v = acc[ai][bj][m][n];
                            p[0] = f2bf(v[0]); p[SEQ] = f2bf(v[1]); p[2 * SEQ] = f2bf(v[2]); p[3 * SEQ] = f2bf(v[3]); }
                } else {
#pragma unroll
                    for (int n = 0; n < 2; ++n) { const int ch = (pn - 6) * 128 + wc * 32 + n * 16 + fq * 4; const pg8::f32x4 a = acc[ai][0][m][n], g = acc[ai][1][m][n];
                        v2u w; w.x = pk2(a[0] * sigmoidf_(g[0]), a[1] * sigmoidf_(g[1])); w.y = pk2(a[2] * sigmoidf_(g[2]), a[3] * sigmoidf_(g[3]));
                        *(v2u*)(GLU + (size_t)row * 512 + ch) = w; }
                }
            }
    }
};
struct EpiRes {
    static constexpr bool PERM = false, AFTER_DRAIN = false;
    const float* base; float* out; bf16* xb; float* rowsq;
    __device__ __forceinline__ void operator()(const pg8::f32x4 (&acc)[2][2][4][2], const pg8::Unit& u, int wr, int wc, int fr, int fq) const {
#pragma unroll
        for (int ai = 0; ai < 2; ++ai)
#pragma unroll
            for (int m = 0; m < 4; ++m) {
                const int row = u.pm * 256 + ai * 128 + wr * 64 + m * 16 + fr; float ss = 0.f;
#pragma unroll
                for (int bj = 0; bj < 2; ++bj)
#pragma unroll
                    for (int n = 0; n < 2; ++n) { const size_t off = (size_t)row * DM + u.pn * 256 + bj * 128 + wc * 32 + n * 16 + fq * 4;
                        const pg8::f32x4 o = *(const pg8::f32x4*)(base + off) + acc[ai][bj][m][n];
                        *(pg8::f32x4*)(out + off) = o; v2u w; w.x = pk2(o[0], o[1]); w.y = pk2(o[2], o[3]); *(v2u*)(xb + off) = w;
                        ss += (o[0] * o[0] + o[1] * o[1]) + (o[2] * o[2] + o[3] * o[3]); }
                ss += __shfl_xor(ss, 16); ss += __shfl_xor(ss, 32);
                if (fq == 0) rowsq[(size_t)row * 16 + u.pn * 4 + wc] = ss;
            }
    }
};
struct EpiPq {
    static constexpr bool PERM = false, AFTER_DRAIN = false;
    bf16* PQ; const float* rowsq;
    __device__ __forceinline__ void operator()(const pg8::f32x4 (&acc)[2][2][4][2], const pg8::Unit& u, int wr, int wc, int fr, int fq) const {
#pragma unroll
        for (int ai = 0; ai < 2; ++ai)
#pragma unroll
            for (int m = 0; m < 4; ++m) {
                const int row = u.pm * 256 + ai * 128 + wr * 64 + m * 16 + fr; const f32x4 q0 = *(const f32x4*)(rowsq + (size_t)row * 16), q1 = *(const f32x4*)(rowsq + (size_t)row * 16 + 4), q2 = *(const f32x4*)(rowsq + (size_t)row * 16 + 8), q3 = *(const f32x4*)(rowsq + (size_t)row * 16 + 12);
                const float rs = 1.f / sqrtf(((((q0.x + q0.y) + (q0.z + q0.w)) + ((q1.x + q1.y) + (q1.z + q1.w))) + (((q2.x + q2.y) + (q2.z + q2.w)) + ((q3.x + q3.y) + (q3.z + q3.w)))) * (1.f / DM) + EPS);
#pragma unroll
                for (int bj = 0; bj < 2; ++bj)
#pragma unroll
                    for (int n = 0; n < 2; ++n) { const size_t off = (size_t)row * PQ_N + u.pn * 256 + bj * 128 + wc * 32 + n * 16 + fq * 4;
                        const pg8::f32x4 v = acc[ai][bj][m][n] * rs; v2u w; w.x = pk2(v[0], v[1]); w.y = pk2(v[2], v[3]); *(v2u*)(PQ + off) = w; }
            }
    }
};
struct EpiIn1 {
    static constexpr bool PERM = false, AFTER_DRAIN = false;
    bf16* Q; bf16* K; bf16* V; bf16* G; float* Z;
    __device__ __forceinline__ void operator()(const pg8::f32x4 (&acc)[2][2][4][2], const pg8::Unit& u, int wr, int wc, int fr, int fq) const {
        const int pn = u.pn;
#pragma unroll
        for (int ai = 0; ai < 2; ++ai)
#pragma unroll
            for (int m = 0; m < 4; ++m) {
                const int row = u.pm * 256 + ai * 128 + wr * 64 + m * 16 + fr;
#pragma unroll
                for (int bj = 0; bj < 2; ++bj)
#pragma unroll
                    for (int n = 0; n < 2; ++n) { const int c = pn * 256 + bj * 128 + wc * 32 + n * 16 + fq * 4; pg8::f32x4 v = acc[ai][bj][m][n];
                        if (pn < 2) { v = v * QSCALE_GLA; v2u w; w.x = pk2(v[0], v[1]); w.y = pk2(v[2], v[3]); *(v2u*)(Q + (size_t)row * 512 + c) = w; }
                        else if (pn < 4) { v2u w; w.x = pk2(v[0], v[1]); w.y = pk2(v[2], v[3]); *(v2u*)(K + (size_t)row * 512 + (c - 512)) = w; }
                        else if (pn < 8) { v2u w; w.x = pk2(v[0], v[1]); w.y = pk2(v[2], v[3]); *(v2u*)(V + (size_t)row * 1024 + (c - 1024)) = w; }
                        else if (pn < 12) { v2u w; w.x = pk2(siluf_(v[0]), siluf_(v[1])); w.y = pk2(siluf_(v[2]), siluf_(v[3])); *(v2u*)(G + (size_t)row * 1024 + (c - 2048)) = w; }
                        else { const int cz = c - 3072; if (cz < 16) *(pg8::f32x4*)(Z + (size_t)row * 16 + cz) = v; } }
            }
    }
};

namespace att {
constexpr int KSTR = 144, VSTR = 136;
constexpr int OFF_K1 = 0, OFF_K2 = 64 * KSTR, OFF_V = 2 * 64 * KSTR, BUFB = OFF_V + 128 * VSTR;
constexpr int OFF_TB = 2 * BUFB;
constexpr float THR = 8.f;
__device__ __forceinline__ int t5_bucket(int rel) {
    const int n = rel < 0 ? -rel : rel; int v;
    if (n < 8) v = n; else { v = 8 + (31 - __clz(n * n)) - 6; if (v > 15) v = 15; }
    return (rel > 0 ? 16 : 0) + v;
}
__device__ __forceinline__ void attn_unit(Frame& F, int bh, int qb, float lam) {
    const int tid = F.tid, lane = F.lane, wid = F.wave, r32 = lane & 31, hi = lane >> 5;
    const int mp = wid >> 2, wq = wid & 3, h = bh & 3;
    const int q0 = qb * 128, qw = q0 + 32 * wq;
    LAS unsigned char* lds = F.lds;
    const bf16* Qg = (const bf16*)(F.ws + S0_Q); const bf16* Kg = (const bf16*)(F.ws + S0_K); const bf16* Vg = (const bf16*)(F.ws + S0_VT);
    LAS float* tb = (LAS float*)(lds + OFF_TB);
    const float* relb = F.in[I_RELB];
    for (int i = tid; i < 320; i += NTHREADS) tb[i] = relb[t5_bucket(i - 255) * 4 + h] * LOG2E;
    const float c15 = relb[15 * 4 + h] * LOG2E;
    const bf16* Qp = Qg + (((size_t)(bh * 2 + mp) * SEQ) + qw + r32) * 64 + 8 * hi;
    bf16x8 qf[4];
#pragma unroll
    for (int s = 0; s < 4; ++s) qf[s] = *(const bf16x8*)(Qp + 16 * s);
    const int nt_unit = 2 * qb + 2, nt_wave = (qw >> 6) + 1;
    const int krow = tid >> 3, kch = tid & 7;
    const bf16* k1src = Kg + (((size_t)(bh * 2 + 0) * SEQ) + krow) * 64 + kch * 8;
    const bf16* k2src = Kg + (((size_t)(bh * 2 + 1) * SEQ) + krow) * 64 + kch * 8;
    const bf16* vsrc = Vg + ((size_t)bh * 128 + krow) * SEQ + kch * 8;
    const int kdst = krow * KSTR + kch * 16, vdst = krow * VSTR + kch * 16;
    v4u rk1, rk2, rv0, rv1;
#define ATT_LOAD(t) do { rk1 = *(const v4u*)(k1src + (size_t)(t) * 4096); rk2 = *(const v4u*)(k2src + (size_t)(t) * 4096); rv0 = *(const v4u*)(vsrc + (t) * 64); rv1 = *(const v4u*)(vsrc + (size_t)64 * SEQ + (t) * 64); } while (0)
#define ATT_STORE(bf) do { LAS unsigned char* bb = lds + (bf) * BUFB; *(LAS v4u*)(bb + OFF_K1 + kdst) = rk1; *(LAS v4u*)(bb + OFF_K2 + kdst) = rk2; \
        *(LAS v2u*)(bb + OFF_V + vdst) = (v2u){rv0.x, rv0.y}; *(LAS v2u*)(bb + OFF_V + vdst + 8) = (v2u){rv0.z, rv0.w}; \
        *(LAS v2u*)(bb + OFF_V + 64 * VSTR + vdst) = (v2u){rv1.x, rv1.y}; *(LAS v2u*)(bb + OFF_V + 64 * VSTR + vdst + 8) = (v2u){rv1.z, rv1.w}; } while (0)
    ATT_LOAD(0); ATT_STORE(0);
    __syncthreads();
    f32x16 o[4];
#pragma unroll
    for (int d = 0; d < 4; ++d)
#pragma unroll
        for (int r = 0; r < 16; ++r) o[d][r] = 0.f;
    float m_run = -INFINITY, l_run = 0.f;
    for (int t = 0; t < nt_unit; ++t) {
        const int buf = t & 1;
        if (t + 1 < nt_unit) ATT_LOAD(t + 1);
        if (t < nt_wave) {
            const LAS unsigned char* kb = lds + buf * BUFB + (mp ? OFF_K2 : OFF_K1) + r32 * KSTR + hi * 16;
            f32x16 p0, p1;
#pragma unroll
            for (int r = 0; r < 16; ++r) { p0[r] = 0.f; p1[r] = 0.f; }
#pragma unroll
            for (int s = 0; s < 4; ++s) { const bf16x8 a0 = *(const LAS bf16x8*)(kb + s * 32), a1 = *(const LAS bf16x8*)(kb + 32 * KSTR + s * 32);
                p0 = __builtin_amdgcn_mfma_f32_32x32x16_bf16(a0, qf[s], p0, 0, 0, 0); p1 = __builtin_amdgcn_mfma_f32_32x32x16_bf16(a1, qf[s], p1, 0, 0, 0); }
            if (64 * t + 154 <= qw) {
#pragma unroll
                for (int r = 0; r < 16; ++r) { p0[r] += c15; p1[r] += c15; }
            } else {
                const int base = 64 * t - (qw + r32) + 255 + 4 * hi;
#pragma unroll
                for (int r = 0; r < 16; ++r) { const int idx = base + (r & 3) + 8 * (r >> 2); p0[r] += tb[idx]; p1[r] += tb[idx + 32]; }
            }
            float rm = fmaxf(p0[0], p1[0]);
#pragma unroll
            for (int r = 1; r < 16; ++r) rm = fmaxf(rm, fmaxf(p0[r], p1[r]));
            rm = fmaxf(rm, __shfl_xor(rm, 32));
            if (__any(rm > m_run + THR)) {
                const float mn = fmaxf(m_run, rm), al = fast_exp2(m_run - mn);
#pragma unroll
                for (int d = 0; d < 4; ++d)
#pragma unroll
                    for (int r = 0; r < 16; ++r) o[d][r] *= al;
                l_run *= al; m_run = mn;
            }
            float ls = 0.f;
#pragma unroll
            for (int r = 0; r < 16; ++r) { p0[r] = fast_exp2(p0[r] - m_run); p1[r] = fast_exp2(p1[r] - m_run); ls += p0[r] + p1[r]; }
            l_run += ls;
            bf16x8 pb[4];
            { v4u w;
              w.x = pk2(p0[0], p0[1]); w.y = pk2(p0[2], p0[3]); w.z = pk2(p0[4], p0[5]); w.w = pk2(p0[6], p0[7]); pb[0] = __builtin_bit_cast(bf16x8, w);
              w.x = pk2(p0[8], p0[9]); w.y = pk2(p0[10], p0[11]); w.z = pk2(p0[12], p0[13]); w.w = pk2(p0[14], p0[15]); pb[1] = __builtin_bit_cast(bf16x8, w);
              w.x = pk2(p1[0], p1[1]); w.y = pk2(p1[2], p1[3]); w.z = pk2(p1[4], p1[5]); w.w = pk2(p1[6], p1[7]); pb[2] = __builtin_bit_cast(bf16x8, w);
              w.x = pk2(p1[8], p1[9]); w.y = pk2(p1[10], p1[11]); w.z = pk2(p1[12], p1[13]); w.w = pk2(p1[14], p1[15]); pb[3] = __builtin_bit_cast(bf16x8, w); }
            const LAS unsigned char* vb = lds + buf * BUFB + OFF_V + r32 * VSTR + hi * 8;
#pragma unroll
            for (int d = 0; d < 4; ++d)
#pragma unroll
                for (int s = 0; s < 4; ++s) { const v2u lo = *(const LAS v2u*)(vb + d * 32 * VSTR + s * 32), h8 = *(const LAS v2u*)(vb + d * 32 * VSTR + s * 32 + 16);
                    const v4u aw = {lo.x, lo.y, h8.x, h8.y};
                    o[d] = __builtin_amdgcn_mfma_f32_32x32x16_bf16(__builtin_bit_cast(bf16x8, aw), pb[s], o[d], 0, 0, 0); }
        }
        if (t + 1 < nt_unit) ATT_STORE(buf ^ 1);
        __syncthreads();
    }
#undef ATT_LOAD
#undef ATT_STORE
    l_run += __shfl_xor(l_run, 32);
    const float inv = 1.f / l_run;
    LAS float* X = (LAS float*)lds + (size_t)(wq * 64) * 64 + lane;
    if (mp == 1) {
#pragma unroll
        for (int d = 0; d < 4; ++d)
#pragma unroll
            for (int r = 0; r < 16; ++r) X[(d * 16 + r) * 64] = o[d][r] * inv;
    }
    __syncthreads();
    if (mp == 0) {
        float ss = 0.f;
#pragma unroll
        for (int d = 0; d < 4; ++d)
#pragma unroll
            for (int r = 0; r < 16; ++r) { const float v = o[d][r] * inv - lam * X[(d * 16 + r) * 64]; o[d][r] = v; ss += v * v; }
        ss += __shfl_xor(ss, 32);
        const float rn = (1.f - LAM_INIT0) / sqrtf(ss * (1.f / 128.f) + EPS);
        bf16* CAT = (bf16*)(F.ws + S0_CAT) + ((size_t)(bh >> 2) * SEQ + qw + r32) * DM + h * 128;
        const float* sg = F.in[I_SUBLN];
#pragma unroll
        for (int d = 0; d < 4; ++d)
#pragma unroll
            for (int rg = 0; rg < 4; ++rg) { const int dd = 32 * d + 8 * rg + 4 * hi; const f32x4 g4 = *(const f32x4*)(sg + dd);
                v2u w; w.x = pk2(o[d][4 * rg] * rn * g4.x, o[d][4 * rg + 1] * rn * g4.y); w.y = pk2(o[d][4 * rg + 2] * rn * g4.z, o[d][4 * rg + 3] * rn * g4.w);
                *(v2u*)(CAT + dd) = w; }
    }
    __syncthreads();
}
__device__ __forceinline__ void conv_unit(Frame& F, int tile) {
    const int c = F.tid, t0 = tile * 32, s0 = t0 & (SEQ - 1);
    const bf16* GLU = (const bf16*)(F.ws + S0_GLU);
    const float* cw = F.in[I_CONVW];
    float w[31];
#pragma unroll
    for (int j = 0; j < 31; ++j) w[j] = cw[j * 512 + c];
    const float bias = F.in[I_CONVB][c];
    float u[62];
#pragma unroll
    for (int i = 0; i < 62; ++i) { const int s = s0 - 30 + i; u[i] = (s >= 0) ? bf2f(GLU[(size_t)(t0 - 30 + i) * 512 + c]) : 0.f; }
    LAS float* Y = (LAS float*)F.lds;
#pragma unroll
    for (int tt = 0; tt < 32; ++tt) { float y = bias;
#pragma unroll
        for (int j = 0; j < 31; ++j) y += w[j] * u[tt + j];
        Y[tt * 516 + c] = y; }
    __syncthreads();
    const float* lg = F.in[I_CLNG]; const float* lb = F.in[I_CLNB];
    bf16* CAT = (bf16*)(F.ws + S0_CAT);
#pragma unroll
    for (int k = 0; k < 4; ++k) { const int tt = 4 * F.wave + k;
        const f32x4 a = *(const LAS f32x4*)(Y + tt * 516 + F.lane * 8), b = *(const LAS f32x4*)(Y + tt * 516 + F.lane * 8 + 4);
        const float mean = wave_sum((a.x + a.y) + (a.z + a.w) + (b.x + b.y) + (b.z + b.w)) * (1.f / 512.f);
        const f32x4 da = a - mean, db = b - mean;
        const float var = wave_sum((da.x * da.x + da.y * da.y) + (da.z * da.z + da.w * da.w) + (db.x * db.x + db.y * db.y) + (db.z * db.z + db.w * db.w)) * (1.f / 512.f);
        const float rs = 1.f / sqrtf(var + EPS);
        const f32x4 g0 = *(const f32x4*)(lg + F.lane * 8), g1 = *(const f32x4*)(lg + F.lane * 8 + 4), b0 = *(const f32x4*)(lb + F.lane * 8), b1 = *(const f32x4*)(lb + F.lane * 8 + 4);
        const f32x4 y0 = da * rs * g0 + b0, y1 = db * rs * g1 + b1;
        v4u o; o.x = pk2(siluf_(y0.x), siluf_(y0.y)); o.y = pk2(siluf_(y0.z), siluf_(y0.w)); o.z = pk2(siluf_(y1.x), siluf_(y1.y)); o.w = pk2(siluf_(y1.z), siluf_(y1.w));
        *(v4u*)(CAT + (size_t)(t0 + tt) * DM + 512 + F.lane * 8) = o; }
    __syncthreads();
}
__device__ __forceinline__ void p2_attn_conv(Frame& F) {
    const float d1 = wave_sum(F.in[I_LQ1][F.lane] * F.in[I_LK1][F.lane]), d2 = wave_sum(F.in[I_LQ2][F.lane] * F.in[I_LK2][F.lane]);
    const float lam = expf(d1) - expf(d2) + LAM_INIT0;
    for (int a = F.vcu; a < 1024; a += F.G) { const int i = a >> 8, v = a & 255, x = v >> 5, j = v & 31; attn_unit(F, 2 * x + (i >> 1), (i & 1) ? (63 - j) : j, lam); }
    for (int a = F.vcu; a < NT / 32; a += F.G) conv_unit(F, a);
}
}

namespace peer {
constexpr int SSTR = 136;
__device__ __forceinline__ unsigned mono(float f) { const unsigned u = __builtin_bit_cast(unsigned, f); return u ^ ((unsigned)((int)u >> 31) | 0x80000000u); }
__device__ __forceinline__ float unmono(unsigned m) { const unsigned u = (m & 0x80000000u) ? (m ^ 0x80000000u) : ~m; return __builtin_bit_cast(float, u); }
#define CE_DESC(a, b) do { const unsigned _x = (a), _y = (b); (a) = _x > _y ? _x : _y; (b) = _x > _y ? _y : _x; } while (0)
#define CE_ASC(a, b)  do { const unsigned _x = (a), _y = (b); (a) = _x > _y ? _y : _x; (b) = _x > _y ? _x : _y; } while (0)
__device__ __forceinline__ void merge16(unsigned (&k)[16], bool desc) {
#pragma unroll
    for (int stride = 8; stride > 0; stride >>= 1)
#pragma unroll
        for (int i = 0; i < 16; ++i) if ((i & stride) == 0) { if (desc) CE_DESC(k[i], k[i + stride]); else CE_ASC(k[i], k[i + stride]); }
}
__device__ __forceinline__ void top16_of_64(unsigned (&k)[64], unsigned (&res)[16]) {
#pragma unroll
    for (int size = 2; size <= 16; size <<= 1)
#pragma unroll
        for (int stride = size >> 1; stride > 0; stride >>= 1)
#pragma unroll
            for (int i = 0; i < 64; ++i) if ((i & stride) == 0) { if ((i & size) == 0) CE_DESC(k[i], k[i + stride]); else CE_ASC(k[i], k[i + stride]); }
    unsigned t0[16], t1[16];
#pragma unroll
    for (int i = 0; i < 16; ++i) { t0[i] = k[i] > k[16 + i] ? k[i] : k[16 + i]; t1[i] = k[32 + i] > k[48 + i] ? k[32 + i] : k[48 + i]; }
    merge16(t0, true); merge16(t1, false);
#pragma unroll
    for (int i = 0; i < 16; ++i) res[i] = t0[i] > t1[i] ? t0[i] : t1[i];
    merge16(res, true);
}
__device__ __forceinline__ void topk_unit(Frame& F, int tile, int h, int layer) {
    const int tid = F.tid, lane = F.lane, wid = F.wave;
    const bf16* PQ = (const bf16*)(F.ws + SP_PQ); const bf16* SK = (const bf16*)(F.ws + WS_SK) + (size_t)((layer * 8 + h) * 2) * 128 * 128;
    LAS float* S = (LAS float*)F.lds;
    const int t0 = tile * 256, fr = lane & 15, fq = lane >> 4;
    unsigned sel[2][16];
#pragma unroll
    for (int p = 0; p < 2; ++p) {
        {
            bf16x8 af[2][4];
#pragma unroll
            for (int mt = 0; mt < 2; ++mt)
#pragma unroll
                for (int ks = 0; ks < 4; ++ks) af[mt][ks] = *(const bf16x8*)(PQ + (size_t)(t0 + 32 * wid + 16 * mt + fr) * PQ_N + h * 256 + p * 128 + 32 * ks + 8 * fq);
            const bf16* SKp = SK + (size_t)p * 128 * 128;
#pragma unroll 2
            for (int nt = 0; nt < 8; ++nt) {
                f32x4 a0 = {0.f, 0.f, 0.f, 0.f}, a1 = {0.f, 0.f, 0.f, 0.f};
#pragma unroll
                for (int ks = 0; ks < 4; ++ks) { const bf16x8 bfr = *(const bf16x8*)(SKp + (size_t)(16 * nt + fr) * 128 + 32 * ks + 8 * fq);
                    a0 = __builtin_amdgcn_mfma_f32_16x16x32_bf16(af[0][ks], bfr, a0, 0, 0, 0); a1 = __builtin_amdgcn_mfma_f32_16x16x32_bf16(af[1][ks], bfr, a1, 0, 0, 0); }
                const int key = 16 * nt + fr, col = key + ((key >> 6) << 2);
#pragma unroll
                for (int r = 0; r < 4; ++r) { S[(32 * wid + 4 * fq + r) * SSTR + col] = a0[r]; S[(32 * wid + 16 + 4 * fq + r) * SSTR + col] = a1[r]; }
            }
        }
        __syncthreads();
        {
            const int row = tid >> 1, kh = tid & 1;
            unsigned k[64];
#pragma unroll
            for (int i = 0; i < 16; ++i) { const f32x4 v = *(const LAS f32x4*)(S + row * SSTR + 68 * kh + 4 * i);
#pragma unroll
                for (int e = 0; e < 4; ++e) k[4 * i + e] = (mono(v[e]) & ~127u) | (unsigned)(127 - (64 * kh + 4 * i + e)); }
            unsigned mine[16];
            top16_of_64(k, mine);
#pragma unroll
            for (int i = 0; i < 16; ++i) { const unsigned other = (unsigned)__shfl_xor((int)mine[15 - i], 1); sel[p][i] = mine[i] > other ? mine[i] : other; }
            merge16(sel[p], true);
        }
        __syncthreads();
    }
    float v1[16], v2[16]; int i1[16], i2[16];
#pragma unroll
    for (int i = 0; i < 16; ++i) { v1[i] = unmono(sel[0][i] & ~127u); i1[i] = 127 - (int)(sel[0][i] & 127u); v2[i] = unmono(sel[1][i] & ~127u); i2[i] = 127 - (int)(sel[1][i] & 127u); }
    unsigned k2[64];
    {
        int n = 0;
#pragma unroll
        for (int i = 0; i < 16; ++i)
#pragma unroll
            for (int j = 0; j < 16; ++j) if ((i + 1) * (j + 1) <= 16) { k2[n] = (mono(v1[i] + v2[j]) & ~255u) | (unsigned)(255 - (i * 16 + j)); ++n; }
#pragma unroll
        for (int q = 50; q < 64; ++q) k2[q] = 0u;
    }
    unsigned top[16];
    top16_of_64(k2, top);
    const int row = tid >> 1, kh = tid & 1;
    const size_t obase = ((size_t)(t0 + row) * 8 + h) * 16;
    if (kh == 0) {
        int* IDS = (int*)(F.ws + WS_IDS) + obase;
#pragma unroll
        for (int q4 = 0; q4 < 4; ++q4) { int ev[4];
#pragma unroll
            for (int e = 0; e < 4; ++e) { const int cid = 255 - (int)(top[4 * q4 + e] & 255u), ci = cid >> 4, cj = cid & 15; int e1 = 0, e2 = 0;
#pragma unroll
                for (int i = 0; i < 16; ++i) { e1 = (ci == i) ? i1[i] : e1; e2 = (cj == i) ? i2[i] : e2; }
                ev[e] = e1 * 128 + e2; }
            *(v4u*)(IDS + 4 * q4) = (v4u){(unsigned)ev[0], (unsigned)ev[1], (unsigned)ev[2], (unsigned)ev[3]}; }
    } else {
        float* GT = (float*)(F.ws + WS_GATE) + obase;
        float cv[16]; float sum = 0.f;
        const float mx = unmono(top[0] & ~255u);
#pragma unroll
        for (int q = 0; q < 16; ++q) { cv[q] = fast_exp2((unmono(top[q] & ~255u) - mx) * LOG2E); sum += cv[q]; }
        const float inv = 1.f / sum;
#pragma unroll
        for (int q4 = 0; q4 < 4; ++q4) *(f32x4*)(GT + 4 * q4) = (f32x4){cv[4 * q4] * inv, cv[4 * q4 + 1] * inv, cv[4 * q4 + 2] * inv, cv[4 * q4 + 3] * inv};
    }
}
__device__ __forceinline__ void topk_phase(Frame& F, int layer) {
    for (int a = F.vcu; a < (NT / 256) * 8; a += F.G) topk_unit(F, a >> 3, a & 7, layer);
}
__device__ __forceinline__ float gelu_tanh(float x) { const float y = 1.5957691216057308f * (x + 0.044715f * x * x * x); return x * fast_rcp(1.f + fast_exp2(-y * LOG2E)); }
__device__ __forceinline__ void experts_phase(Frame& F, int layer) {
    const int lane = F.lane;
    const bf16* UT = (const bf16*)(F.ws + WS_UT) + (size_t)layer * NEXP * DM; const bf16* VT = (const bf16*)(F.ws + WS_VT) + (size_t)layer * NEXP * DM;
    const int* IDS = (const int*)(F.ws + WS_IDS); const float* GT = (const float*)(F.ws + WS_GATE);
    float* XR = F.out;
    const float* gffn = F.in[I_LNFFN] + layer * DM;
    const float* gnext = layer == 0 ? F.in[I_LNMIX] + DM : F.in[I_LNF];
    bf16* HN = (bf16*)(F.ws + WS_HN);
    const int gw = F.vcu * NWAVES + F.wave, NGW = F.G * NWAVES;
    const int d0 = 8 * lane, d1 = 512 + 8 * lane;
    for (int t = gw; t < NT; t += NGW) {
        float x[16], hn[16], acc[16];
        { const f32x4 a = *(const f32x4*)(XR + (size_t)t * DM + d0), b = *(const f32x4*)(XR + (size_t)t * DM + d0 + 4), c = *(const f32x4*)(XR + (size_t)t * DM + d1), d = *(const f32x4*)(XR + (size_t)t * DM + d1 + 4);
          x[0] = a.x; x[1] = a.y; x[2] = a.z; x[3] = a.w; x[4] = b.x; x[5] = b.y; x[6] = b.z; x[7] = b.w; x[8] = c.x; x[9] = c.y; x[10] = c.z; x[11] = c.w; x[12] = d.x; x[13] = d.y; x[14] = d.z; x[15] = d.w; }
        float ss = 0.f;
#pragma unroll
        for (int i = 0; i < 16; ++i) ss += x[i] * x[i];
        const float r = 1.f / sqrtf(wave_sum(ss) * (1.f / DM) + EPS);
#pragma unroll
        for (int i = 0; i < 16; ++i) { hn[i] = x[i] * r * gffn[(i < 8 ? d0 : d1 - 8) + i]; acc[i] = 0.f; }
        const int idv0 = IDS[(size_t)t * 128 + lane], idv1 = IDS[(size_t)t * 128 + 64 + lane];
        const float gv0 = GT[(size_t)t * 128 + lane], gv1 = GT[(size_t)t * 128 + 64 + lane];
#pragma unroll
        for (int half = 0; half < 2; ++half) {
            const int idv = half ? idv1 : idv0; const float gv = half ? gv1 : gv0;
            for (int b8 = 0; b8 < 8; ++b8) {
                int id[8]; float p[8];
#pragma unroll
                for (int e = 0; e < 8; ++e) id[e] = __builtin_amdgcn_readlane(idv, b8 * 8 + e);
                v4u ua[8], ub[8];
#pragma unroll
                for (int e = 0; e < 8; ++e) { const bf16* up = UT + (size_t)id[e] * DM; ua[e] = *(const v4u*)(up + d0); ub[e] = *(const v4u*)(up + d1); }
#pragma unroll
                for (int e = 0; e < 8; ++e) {
                    float s = hn[0] * bf_lo(ua[e].x) + hn[1] * bf_hi(ua[e].x); s += hn[2] * bf_lo(ua[e].y) + hn[3] * bf_hi(ua[e].y); s += hn[4] * bf_lo(ua[e].z) + hn[5] * bf_hi(ua[e].z); s += hn[6] * bf_lo(ua[e].w) + hn[7] * bf_hi(ua[e].w);
                    s += hn[8] * bf_lo(ub[e].x) + hn[9] * bf_hi(ub[e].x); s += hn[10] * bf_lo(ub[e].y) + hn[11] * bf_hi(ub[e].y); s += hn[12] * bf_lo(ub[e].z) + hn[13] * bf_hi(ub[e].z); s += hn[14] * bf_lo(ub[e].w) + hn[15] * bf_hi(ub[e].w);
                    p[e] = s; }
                float w4[4], w2[2], w1;
                { const bool up = (lane & 32) != 0;
#pragma unroll
                  for (int i = 0; i < 4; ++i) { const float keep = up ? p[4 + i] : p[i], send = up ? p[i] : p[4 + i]; w4[i] = keep + __shfl_xor(send, 32); } }
                { const bool up = (lane & 16) != 0;
#pragma unroll
                  for (int i = 0; i < 2; ++i) { const float keep = up ? w4[2 + i] : w4[i], send = up ? w4[i] : w4[2 + i]; w2[i] = keep + __shfl_xor(send, 16); } }
                { const bool up = (lane & 8) != 0; const float keep = up ? w2[1] : w2[0], send = up ? w2[0] : w2[1]; w1 = keep + __shfl_xor(send, 8); }
                w1 += __shfl_xor(w1, 4); w1 += __shfl_xor(w1, 2); w1 += __shfl_xor(w1, 1);
                const float coef = __shfl(gv, b8 * 8 + (lane >> 3)) * gelu_tanh(w1);
#pragma unroll
                for (int e = 0; e < 8; ++e) { const bf16* vp = VT + (size_t)id[e] * DM; ua[e] = *(const v4u*)(vp + d0); ub[e] = *(const v4u*)(vp + d1); }
#pragma unroll
                for (int e = 0; e < 8; ++e) { const float ce = __builtin_bit_cast(float, __builtin_amdgcn_readlane(__builtin_bit_cast(int, coef), 8 * e));
                    acc[0] += ce * bf_lo(ua[e].x); acc[1] += ce * bf_hi(ua[e].x); acc[2] += ce * bf_lo(ua[e].y); acc[3] += ce * bf_hi(ua[e].y); acc[4] += ce * bf_lo(ua[e].z); acc[5] += ce * bf_hi(ua[e].z); acc[6] += ce * bf_lo(ua[e].w); acc[7] += ce * bf_hi(ua[e].w);
                    acc[8] += ce * bf_lo(ub[e].x); acc[9] += ce * bf_hi(ub[e].x); acc[10] += ce * bf_lo(ub[e].y); acc[11] += ce * bf_hi(ub[e].y); acc[12] += ce * bf_lo(ub[e].z); acc[13] += ce * bf_hi(ub[e].z); acc[14] += ce * bf_lo(ub[e].w); acc[15] += ce * bf_hi(ub[e].w); }
            }
        }
        float s2 = 0.f;
#pragma unroll
        for (int i = 0; i < 16; ++i) { x[i] += acc[i]; s2 += x[i] * x[i]; }
        const float r2 = 1.f / sqrtf(wave_sum(s2) * (1.f / DM) + EPS);
        float y[16];
#pragma unroll
        for (int i = 0; i < 16; ++i) y[i] = x[i] * r2 * gnext[(i < 8 ? d0 : d1 - 8) + i];
        if (layer == 0) {
            *(f32x4*)(XR + (size_t)t * DM + d0) = (f32x4){x[0], x[1], x[2], x[3]}; *(f32x4*)(XR + (size_t)t * DM + d0 + 4) = (f32x4){x[4], x[5], x[6], x[7]};
            *(f32x4*)(XR + (size_t)t * DM + d1) = (f32x4){x[8], x[9], x[10], x[11]}; *(f32x4*)(XR + (size_t)t * DM + d1 + 4) = (f32x4){x[12], x[13], x[14], x[15]};
            *(v4u*)(HN + (size_t)t * DM + d0) = (v4u){pk2(y[0], y[1]), pk2(y[2], y[3]), pk2(y[4], y[5]), pk2(y[6], y[7])};
            *(v4u*)(HN + (size_t)t * DM + d1) = (v4u){pk2(y[8], y[9]), pk2(y[10], y[11]), pk2(y[12], y[13]), pk2(y[14], y[15])};
        } else {
            *(f32x4*)(XR + (size_t)t * DM + d0) = (f32x4){y[0], y[1], y[2], y[3]}; *(f32x4*)(XR + (size_t)t * DM + d0 + 4) = (f32x4){y[4], y[5], y[6], y[7]};
            *(f32x4*)(XR + (size_t)t * DM + d1) = (f32x4){y[8], y[9], y[10], y[11]}; *(f32x4*)(XR + (size_t)t * DM + d1 + 4) = (f32x4){y[12], y[13], y[14], y[15]};
        }
    }
}
}

namespace gla {
__device__ __forceinline__ void prep_unit(Frame& F, int item) {
    const int tid = F.tid, bh = item >> 7, chunk = item & 127, b = bh >> 2, h = bh & 3;
    const int t0 = b * SEQ + 64 * chunk;
    bf16* KG = (bf16*)(F.ws + S1_K); bf16* VG = (bf16*)(F.ws + S1_V); const float* ZG = (const float*)(F.ws + S1_Z);
    float* DEC = (float*)(F.ws + WS_DEC);
    LAS float* TOT = (LAS float*)F.lds;
    LAS bf16* VL = (LAS bf16*)(F.lds + 4096);
    const int dk = tid & 127, seg = tid >> 7;
    float w2r[16];
#pragma unroll
    for (int j = 0; j < 16; ++j) w2r[j] = F.in[I_WG2][j * 512 + h * 128 + dk];
    const float b2 = F.in[I_BG2][h * 128 + dk];
    float cum[16], kv[16]; float run = 0.f;
#pragma unroll
    for (int j = 0; j < 16; ++j) { const int s = 16 * seg + j; const float* zp = ZG + (size_t)(t0 + s) * 16;
        const f32x4 z0 = *(const f32x4*)zp, z1 = *(const f32x4*)(zp + 4), z2 = *(const f32x4*)(zp + 8), z3 = *(const f32x4*)(zp + 12);
        float xg = b2 + z0.x * w2r[0] + z0.y * w2r[1] + z0.z * w2r[2] + z0.w * w2r[3] + z1.x * w2r[4] + z1.y * w2r[5] + z1.z * w2r[6] + z1.w * w2r[7]
                      + z2.x * w2r[8] + z2.y * w2r[9] + z2.z * w2r[10] + z2.w * w2r[11] + z3.x * w2r[12] + z3.y * w2r[13] + z3.z * w2r[14] + z3.w * w2r[15];
        const float la = (fminf(xg, 0.f) - log1pf(expf(-fabsf(xg)))) * (1.f / 16.f);
        run += la; cum[j] = run; kv[j] = bf2f(KG[(size_t)(t0 + s) * 512 + h * 128 + dk]); }
    TOT[seg * 128 + dk] = run;
#pragma unroll
    for (int i = 0; i < 4; ++i) { const int q = tid + 512 * i, s = q >> 5, cc = q & 31; const v4u v = *(const v4u*)(VG + (size_t)(t0 + s) * 1024 + h * 256 + 8 * cc);
        *(LAS v2u*)(VL + s * 264 + 8 * cc) = (v2u){v.x, v.y}; *(LAS v2u*)(VL + s * 264 + 8 * cc + 4) = (v2u){v.z, v.w}; }
    __syncthreads();
    float off = 0.f, total = 0.f;
#pragma unroll
    for (int g = 0; g < 4; ++g) { const float tg = TOT[g * 128 + dk]; total += tg; if (g < seg) off += tg; }
    unsigned pk[8];
#pragma unroll
    for (int j = 0; j < 16; j += 2) pk[j >> 1] = pk2(kv[j] * expf(total - (off + cum[j])), kv[j + 1] * expf(total - (off + cum[j + 1])));
    bf16* kd = KG + (size_t)(t0 + (dk >> 1)) * 512 + h * 128 + (dk & 1) * 64 + 16 * seg;
    *(v4u*)kd = (v4u){pk[0], pk[1], pk[2], pk[3]}; *(v4u*)(kd + 8) = (v4u){pk[4], pk[5], pk[6], pk[7]};
    if (seg == 0) DEC[(size_t)item * 128 + dk] = expf(total);
#pragma unroll
    for (int i = 0; i < 4; ++i) { const int o = tid + 512 * i, dv = o >> 3, sb = o & 7; unsigned w[4];
#pragma unroll
        for (int j = 0; j < 4; ++j) w[j] = (unsigned)VL[(8 * sb + 2 * j) * 264 + dv] | ((unsigned)VL[(8 * sb + 2 * j + 1) * 264 + dv] << 16);
        *(v4u*)(VG + (size_t)(t0 + (dv >> 2)) * 1024 + h * 256 + (dv & 3) * 64 + 8 * sb) = (v4u){w[0], w[1], w[2], w[3]}; }
    __syncthreads();
}
__device__ __forceinline__ int crow(int r, int hi) { return (r & 3) + 8 * (r >> 2) + 4 * hi; }
__device__ __forceinline__ void scan_task(Frame& F, int bh, int w) {
    const int lane = F.lane, r32 = lane & 31, hi = lane >> 5, b = bh >> 2, h = bh & 3;
    const bf16* QG = (const bf16*)(F.ws + S1_Q); const bf16* KG = (const bf16*)(F.ws + S1_K); const bf16* VG = (const bf16*)(F.ws + S1_V);
    const float* DEC = (const float*)(F.ws + WS_DEC); bf16* OUT = (bf16*)(F.ws + WS_HN);
    f32x16 st[4];
#pragma unroll
    for (int d = 0; d < 4; ++d)
#pragma unroll
        for (int r = 0; r < 16; ++r) st[d][r] = 0.f;
    const unsigned lv = (unsigned)((r32 >> 2) * 1024 + (r32 & 3) * 64 + 8 * hi);
    const unsigned lk = (unsigned)((r32 >> 1) * 512 + (r32 & 1) * 64 + 8 * hi);
    const unsigned lq = (unsigned)(r32 * 512 + 4 * hi);
    const unsigned lo = (unsigned)(4 * hi * 1024 + r32);
    const unsigned ld = (unsigned)(4 * hi);
#pragma unroll 1
    for (int chunk = 0; chunk < 128; ++chunk) {
        const int t0 = b * SEQ + 64 * chunk;
        const bf16* vb = VG + (size_t)(t0 + 8 * w) * 1024 + h * 256;
        const bf16* kb = KG + (size_t)t0 * 512 + h * 128;
        const bf16* qb = QG + (size_t)t0 * 512 + h * 128;
        bf16* ob = OUT + (size_t)t0 * 1024 + h * 256 + 32 * w;
        const float* dc = DEC + (size_t)(bh * 128 + chunk) * 128;
        bf16x8 bu[4];
#pragma unroll
        for (int ks = 0; ks < 4; ++ks) bu[ks] = *(const bf16x8*)(vb + 16 * ks + lv);
#pragma unroll
        for (int db = 0; db < 4; ++db) {
            bf16x8 au[4];
#pragma unroll
            for (int ks = 0; ks < 4; ++ks) au[ks] = *(const bf16x8*)(kb + (size_t)(16 * db) * 512 + 16 * ks + lk);
#pragma unroll
            for (int rg = 0; rg < 4; ++rg) { const f32x4 d4 = *(const f32x4*)(dc + 32 * db + 8 * rg + ld);
                st[db][4 * rg] *= d4.x; st[db][4 * rg + 1] *= d4.y; st[db][4 * rg + 2] *= d4.z; st[db][4 * rg + 3] *= d4.w; }
#pragma unroll
            for (int ks = 0; ks < 4; ++ks) st[db] = __builtin_amdgcn_mfma_f32_32x32x16_bf16(au[ks], bu[ks], st[db], 0, 0, 0);
            asm volatile("" ::: "memory");
        }
#pragma unroll
        for (int sb = 0; sb < 2; ++sb) {
            f32x16 oa;
#pragma unroll
            for (int r = 0; r < 16; ++r) oa[r] = 0.f;
#pragma unroll
            for (int db = 0; db < 4; ++db)
#pragma unroll
                for (int hs = 0; hs < 2; ++hs) {
                    const bf16* qp = qb + (size_t)(32 * sb) * 512 + 32 * db + 16 * hs;
                    const v2u qa = *(const v2u*)(qp + lq), qc = *(const v2u*)(qp + 8 + lq);
                    const v4u aw = {qa.x, qa.y, qc.x, qc.y};
                    const v4u bw = {pk2(st[db][8 * hs], st[db][8 * hs + 1]), pk2(st[db][8 * hs + 2], st[db][8 * hs + 3]), pk2(st[db][8 * hs + 4], st[db][8 * hs + 5]), pk2(st[db][8 * hs + 6], st[db][8 * hs + 7])};
                    oa = __builtin_amdgcn_mfma_f32_32x32x16_bf16(__builtin_bit_cast(bf16x8, aw), __builtin_bit_cast(bf16x8, bw), oa, 0, 0, 0);
                }
#pragma unroll
            for (int r = 0; r < 16; ++r) ob[(size_t)(32 * sb + (r & 3) + 8 * (r >> 2)) * 1024 + lo] = f2bf(oa[r]);
            asm volatile("" ::: "memory");
        }
    }
}
__device__ __forceinline__ void scan_phase(Frame& F) {
    if (F.wave == 0) {
        int a = (F.G == 256) ? (((F.vcu & 31) < 16) ? ((F.vcu >> 5) * 16 + (F.vcu & 31)) : 128) : F.vcu;
        const int stride = (F.G == 256) ? 128 : F.G;
#pragma unroll 1
        for (; a < 128; a += stride) scan_task(F, a >> 3, a & 7);
    }
}
__device__ __forceinline__ void post_phase(Frame& F) {
    const int lane = F.lane; bf16* OUT = (bf16*)(F.ws + WS_HN); const bf16* GG = (const bf16*)(F.ws + S1_G);
    const float* gn = F.in[I_GLAG] + (lane & 15) * 16;
    float g[16];
#pragma unroll
    for (int i = 0; i < 16; ++i) g[i] = gn[i];
    const int gw = F.vcu * NWAVES + F.wave, NGW = F.G * NWAVES;
    for (int t = gw; t < NT; t += NGW) {
        const v4u o0 = *(const v4u*)(OUT + (size_t)t * 1024 + 16 * lane), o1 = *(const v4u*)(OUT + (size_t)t * 1024 + 16 * lane + 8);
        const v4u g0 = *(const v4u*)(GG + (size_t)t * 1024 + 16 * lane), g1 = *(const v4u*)(GG + (size_t)t * 1024 + 16 * lane + 8);
        float o[16], sg[16];
        o[0] = bf_lo(o0.x); o[1] = bf_hi(o0.x); o[2] = bf_lo(o0.y); o[3] = bf_hi(o0.y); o[4] = bf_lo(o0.z); o[5] = bf_hi(o0.z); o[6] = bf_lo(o0.w); o[7] = bf_hi(o0.w);
        o[8] = bf_lo(o1.x); o[9] = bf_hi(o1.x); o[10] = bf_lo(o1.y); o[11] = bf_hi(o1.y); o[12] = bf_lo(o1.z); o[13] = bf_hi(o1.z); o[14] = bf_lo(o1.w); o[15] = bf_hi(o1.w);
        sg[0] = bf_lo(g0.x); sg[1] = bf_hi(g0.x); sg[2] = bf_lo(g0.y); sg[3] = bf_hi(g0.y); sg[4] = bf_lo(g0.z); sg[5] = bf_hi(g0.z); sg[6] = bf_lo(g0.w); sg[7] = bf_hi(g0.w);
        sg[8] = bf_lo(g1.x); sg[9] = bf_hi(g1.x); sg[10] = bf_lo(g1.y); sg[11] = bf_hi(g1.y); sg[12] = bf_lo(g1.z); sg[13] = bf_hi(g1.z); sg[14] = bf_lo(g1.w); sg[15] = bf_hi(g1.w);
        float ss = 0.f;
#pragma unroll
        for (int i = 0; i < 16; ++i) ss += o[i] * o[i];
        ss += __shfl_xor(ss, 1); ss += __shfl_xor(ss, 2); ss += __shfl_xor(ss, 4); ss += __shfl_xor(ss, 8);
        const float rs = 1.f / sqrtf(ss * (1.f / 256.f) + EPS);
        float y[16];
#pragma unroll
        for (int i = 0; i < 16; ++i) y[i] = o[i] * rs * g[i] * sg[i];
        *(v4u*)(OUT + (size_t)t * 1024 + 16 * lane) = (v4u){pk2(y[0], y[1]), pk2(y[2], y[3]), pk2(y[4], y[5]), pk2(y[6], y[7])};
        *(v4u*)(OUT + (size_t)t * 1024 + 16 * lane + 8) = (v4u){pk2(y[8], y[9]), pk2(y[10], y[11]), pk2(y[12], y[13]), pk2(y[14], y[15])};
    }
}
}

constexpr int CW_BAR = 4096;
constexpr int N_PHASES = 15;
struct Args { const float* in[25]; float* out; unsigned char* ws; int ph_lo, ph_hi; };
__global__ void __launch_bounds__(NTHREADS, 2) fwd_kernel(Args args) {
    extern __shared__ __attribute__((aligned(16))) unsigned char lds_raw[];
    Frame F;
    F.lds = (LAS unsigned char*)lds_raw;
    F.MISC = (volatile LAS unsigned*)(F.lds + MISC_OFF);
    F.tid = threadIdx.x; F.lane = F.tid & 63; F.wave = __builtin_amdgcn_readfirstlane(F.tid >> 6);
    F.G = gridDim.x; { const int bx = blockIdx.x; F.vcu = (F.G % 8 == 0) ? (bx % 8) * (F.G / 8) + bx / 8 : bx; }
    F.in = (const float* const __attribute__((address_space(4)))*)__builtin_amdgcn_kernarg_segment_ptr();
    F.out = args.out; F.ws = args.ws; F.ctl = (unsigned*)(args.ws + WS_CTL);
    if (F.tid < 64) ((LAS unsigned*)(F.lds + MISC_OFF))[F.tid] = 0u;
    __syncthreads();
    const int lo = args.ph_lo, hi = args.ph_hi;
    const bool multi = (hi - lo) > 1;
    XcdBarrier bar; bar.bar = F.ctl + CW_BAR; bar.x = 0; bar.st = nullptr;
    if (multi) bar = xcd_barrier_post(F.ctl + CW_BAR, F.MISC + 8);
#ifndef PH_MASK
#define PH_MASK 0x7fff
#endif
#define IN(k) ((((PH_MASK) >> (k)) & 1) && lo <= (k) && (k) < hi)
#define SEAM(k) do { if (IN((k) + 1)) xcd_barrier(bar); } while (0)
    bf16* HN = (bf16*)(F.ws + WS_HN);
    if (IN(0)) { p0_prologue(F); SEAM(0); }
    if (IN(1)) { pg8::Gemm g{HN, (const bf16*)(F.ws + WS_WIN0), NT, EVEN_IN, DM}; pg8::StaticOrder S; S.init(NT, EVEN_IN, F.G, (int)blockIdx.x);
        EpiIn0 E{(bf16*)(F.ws + S0_Q), (bf16*)(F.ws + S0_K), (bf16*)(F.ws + S0_VT), (bf16*)(F.ws + S0_GLU)};
        pg8::gemm_phase<EpiIn0, pg8::StaticOrder, true, true>(F.lds, g, S, E); SEAM(1); }
    if (IN(2)) { att::p2_attn_conv(F); SEAM(2); }
    if (IN(3)) { pg8::Gemm g{(const bf16*)(F.ws + S0_CAT), (const bf16*)(F.ws + WS_WOUT0), NT, DM, DM}; pg8::StaticOrder S; S.init(NT, DM, F.G, (int)blockIdx.x);
        EpiRes E{F.in[I_X], F.out, HN, (float*)(F.ws + WS_ROWSQ0)};
        pg8::gemm_phase<EpiRes, pg8::StaticOrder, true, true>(F.lds, g, S, E); SEAM(3); }
    if (IN(4)) { pg8::Gemm g{HN, (const bf16*)(F.ws + WS_WQ0), NT, PQ_N, DM}; pg8::StaticOrder S; S.init(NT, PQ_N, F.G, (int)blockIdx.x);
        EpiPq E{(bf16*)(F.ws + SP_PQ), (const float*)(F.ws + WS_ROWSQ0)};
        pg8::gemm_phase<EpiPq, pg8::StaticOrder, true, true>(F.lds, g, S, E); SEAM(4); }
    if (IN(5)) { peer::topk_phase(F, 0); SEAM(5); }
    if (IN(6)) { peer::experts_phase(F, 0); SEAM(6); }
    if (IN(7)) { pg8::Gemm g{HN, (const bf16*)(F.ws + WS_WIN1), NT, ODD_IN_PAD, DM}; pg8::StaticOrder S; S.init(NT, ODD_IN_PAD, F.G, (int)blockIdx.x);
        EpiIn1 E{(bf16*)(F.ws + S1_Q), (bf16*)(F.ws + S1_K), (bf16*)(F.ws + S1_V), (bf16*)(F.ws + S1_G), (float*)(F.ws + S1_Z)};
        pg8::gemm_phase<EpiIn1, pg8::StaticOrder, true, true>(F.lds, g, S, E); SEAM(7); }
    if (IN(8)) { for (int a = F.vcu; a < 2048; a += F.G) gla::prep_unit(F, a); SEAM(8); }
    if (IN(9)) { gla::scan_phase(F); SEAM(9); }
    if (IN(10)) { gla::post_phase(F); SEAM(10); }
    if (IN(11)) { pg8::Gemm g{HN, (const bf16*)(F.ws + WS_WOUT1), NT, DM, DM}; pg8::StaticOrder S; S.init(NT, DM, F.G, (int)blockIdx.x);
        EpiRes E{F.out, F.out, (bf16*)(F.ws + S1_G), (float*)(F.ws + WS_ROWSQ1)};
        pg8::gemm_phase<EpiRes, pg8::StaticOrder, true, true>(F.lds, g, S, E); SEAM(11); }
    if (IN(12)) { pg8::Gemm g{(const bf16*)(F.ws + S1_G), (const bf16*)(F.ws + WS_WQ1), NT, PQ_N, DM}; pg8::StaticOrder S; S.init(NT, PQ_N, F.G, (int)blockIdx.x);
        EpiPq E{(bf16*)(F.ws + SP_PQ), (const float*)(F.ws + WS_ROWSQ1)};
        pg8::gemm_phase<EpiPq, pg8::StaticOrder, true, true>(F.lds, g, S, E); SEAM(12); }
    if (IN(13)) { peer::topk_phase(F, 1); SEAM(13); }
    if (IN(14)) { peer::experts_phase(F, 1); }
#undef IN
#undef SEAM
}

#ifndef N_LAUNCH_SPLIT
#define N_LAUNCH_SPLIT 1
#endif
extern "C" void kernel_launch(void* const* d_in, const int* in_sizes, int n_in, void* d_out, int out_size, void* d_ws, size_t ws_size, hipStream_t stream) {
    static int grid = 0;
    if (grid == 0) {
        if (n_in != 25 || out_size != NT * DM || ws_size < WS_END) { fprintf(stderr, "kernel_launch: unexpected shapes (n_in %d out %d ws %zu)\n", n_in, out_size, ws_size); grid = -1; return; }
        int dev = 0, cus = 0;
        if (hipGetDevice(&dev) != hipSuccess || hipDeviceGetAttribute(&cus, hipDeviceAttributeMultiprocessorCount, dev) != hipSuccess) { grid = -1; return; }
        if (hipFuncSetAttribute((const void*)fwd_kernel, hipFuncAttributeMaxDynamicSharedMemorySize, LDS_BYTES) != hipSuccess) { fprintf(stderr, "kernel_launch: hipFuncSetAttribute failed\n"); grid = -1; return; }
        int per_cu = 0;
        if (hipOccupancyMaxActiveBlocksPerMultiprocessor(&per_cu, (const void*)fwd_kernel, NTHREADS, LDS_BYTES) != hipSuccess || per_cu < 1) fprintf(stderr, "kernel_launch: occupancy query says %d\n", per_cu);
        (void)hipGetLastError();
        grid = cus;
    }
    if (grid < 0) return;
    (void)hipMemsetAsync((char*)d_ws + WS_CTL, 0, CTL_ZERO_BYTES, stream);
    Args a{};
    for (int i = 0; i < 25; ++i) a.in[i] = (const float*)d_in[i];
    a.out = (float*)d_out; a.ws = (unsigned char*)d_ws;
#if N_LAUNCH_SPLIT
    for (int p = 0; p < N_PHASES; ++p) { a.ph_lo = p; a.ph_hi = p + 1; hipLaunchKernelGGL(fwd_kernel, dim3(grid), dim3(NTHREADS), LDS_BYTES, stream, a); }
#else
    a.ph_lo = 0; a.ph_hi = N_PHASES; hipLaunchKernelGGL(fwd_kernel, dim3(grid), dim3(NTHREADS), LDS_BYTES, stream, a);
#endif
}
```

```cpp
#include <hip/hip_runtime.h>
#include <cstdio>
#include <cstdint>
namespace pg8 {
#define PG8_LAS __attribute__((address_space(3)))
typedef unsigned short bf16_t;
typedef short bf16x8 __attribute__((ext_vector_type(8)));
typedef float f32x4 __attribute__((ext_vector_type(4)));
typedef unsigned u32x4 __attribute__((ext_vector_type(4)));
constexpr int BM = 256, BK = 64, HALF = 128, HTB = HALF * BK * 2  , STAGE_BYTES = 8 * HTB, NXCD = 8, WGM = 8;

__host__ __device__ __forceinline__ int lds_byte(int r, int c) { const int st = (r >> 4) * 2 + (c >> 5), rr = r & 15, cc = c & 31, ob = rr * 64 + cc * 2; return st * 1024 + (ob ^ (((ob >> 9) & 1) << 5)); }
__host__ __device__ __forceinline__ void stage_rc(int b, int& R, int& C) { const int st = b / 1024, sb = b % 1024, swz = sb ^ (((sb >> 9) & 1) << 5); R = (st >> 1) * 16 + swz / 64; C = (st & 1) * 32 + (swz % 64) / 2; }
__host__ __device__ __forceinline__ int perm32(int rho) { const int n = rho >> 4, i = rho & 15; return 8 * (i >> 2) + 4 * n + (i & 3); }

struct Unit { int pm, pn; };
struct Gemm { const bf16_t* A; const bf16_t* Bt; int M, N, K; };

struct StaticOrder {
    int nM, nN, nwg, G, c;
    __host__ __device__ void init(int M, int N, int G_, int c_) { nM = M / BM; nN = N / BM; nwg = nM * nN; G = G_; c = c_; }
    __host__ __device__ bool next(int i, Unit& u) const {
        const long L = (long)i * G + c; if (L >= nwg) return false;
        int wgid = (int)L; { const int q = nwg / NXCD, r = nwg % NXCD, xcd = wgid % NXCD, off = wgid / NXCD; wgid = (xcd < r ? xcd * (q + 1) : r * (q + 1) + (xcd - r) * q) + off; }
        const int nig = WGM * nN, gid = wgid / nig, fm = gid * WGM, gsz = (nM - fm) < WGM ? (nM - fm) : WGM;
        u.pm = fm + ((wgid % nig) % gsz); u.pn = (wgid % nig) / gsz; return true;
    }
    __device__ __forceinline__ void a_ready(const Unit&) const {}
    __device__ __forceinline__ void done(const Unit&) const {}
};
__device__ __forceinline__ unsigned cvt_pk_bf16(float lo, float hi) { unsigned r; asm volatile("v_cvt_pk_bf16_f32 %0, %1, %2" : "=v"(r) : "v"(lo), "v"(hi)); return r; }
template <class Epi, class Sched, bool ALIGN_EPI = false, bool SP2 = false>
__device__ __forceinline__ void gemm_phase(PG8_LAS unsigned char* lds, const Gemm g, const Sched& S, const Epi& E) {
    const int tid = threadIdx.x, wid = __builtin_amdgcn_readfirstlane(tid >> 6), lane = tid & 63, wr = wid >> 2, wc = wid & 3, fr = lane & 15, fq = lane >> 4;
    const int K = g.K, nt = K / BK;
    unsigned voffA[2], voffB[2];
#pragma unroll
    for (int i = 0; i < 2; ++i) { int R, C; stage_rc(tid * 16 + i * 8192, R, C); const int Rb = Epi::PERM ? ((R & ~31) + perm32(R & 31)) : R;
        voffA[i] = (unsigned)(R * K + C) * 2u; voffB[i] = (unsigned)(Rb * K + C) * 2u; }
    const size_t kstep = (size_t)(BK * 2);
    const size_t hstep = (size_t)HALF * K * 2;
    const size_t tstep = 2 * hstep;
    const unsigned ldsw = (unsigned)wid * 1024u;
    const int aoff = lds_byte(wr * 64 + fr, fq * 8), boff = lds_byte(wc * 32 + fr, fq * 8);
#define PG8_SA(b, h) (((b) * 2 + (h)) * HTB)
#define PG8_SB(b, h) ((4 + (b) * 2 + (h)) * HTB)
#define PG8_STAGE(bufoff, gbase, voff) do { _Pragma("unroll") for (int _i = 0; _i < 2; ++_i) \
        __builtin_amdgcn_global_load_lds((const unsigned*)((const char*)(gbase) + (voff)[_i]), (PG8_LAS unsigned*)(lds + (bufoff) + ldsw + _i * 8192), 16, 0, 0); } while (0)
#define PG8_LDA(dst, b, h) do { _Pragma("unroll") for (int m = 0; m < 4; ++m) _Pragma("unroll") for (int k = 0; k < 2; ++k) dst[m][k] = *(const PG8_LAS bf16x8*)(lds + PG8_SA(b, h) + aoff + m * 2048 + k * 1024); } while (0)
#define PG8_LDB(dst, b, h) do { _Pragma("unroll") for (int n = 0; n < 2; ++n) _Pragma("unroll") for (int k = 0; k < 2; ++k) dst[n][k] = *(const PG8_LAS bf16x8*)(lds + PG8_SB(b, h) + boff + n * 2048 + k * 1024); } while (0)
#define PG8_MMA(ai, bj, At, Bt) do { __builtin_amdgcn_s_setprio(1); _Pragma("unroll") for (int m = 0; m < 4; ++m) _Pragma("unroll") for (int n = 0; n < 2; ++n) _Pragma("unroll") for (int k = 0; k < 2; ++k) \
        acc[ai][bj][m][n] = __builtin_amdgcn_mfma_f32_16x16x32_bf16(Bt[n][k], At[m][k], acc[ai][bj][m][n], 0, 0, 0); __builtin_amdgcn_s_setprio(0); } while (0)
#define PG8_WAIT_V(n) asm volatile("s_waitcnt vmcnt(" #n ")" ::: "memory")
#define PG8_WAIT_L(n) asm volatile("s_waitcnt lgkmcnt(" #n ")" ::: "memory")
#define PG8_BAR __builtin_amdgcn_s_barrier()
#define PG8_SCHED __builtin_amdgcn_sched_barrier(0)
    Unit cur, nxt; int ui = 0;
    if (!S.next(0, cur)) return;
    f32x4 acc[2][2][4][2];
#pragma unroll
    for (int a = 0; a < 2; ++a)
#pragma unroll
        for (int b = 0; b < 2; ++b)
#pragma unroll
            for (int m = 0; m < 4; ++m)
#pragma unroll
                for (int n = 0; n < 2; ++n) acc[a][b][m][n] = (f32x4){0.f, 0.f, 0.f, 0.f};
    bf16x8 At[4][2], B0[2][2], B1[2][2];
    const char* cA = (const char*)g.A + (size_t)cur.pm * tstep; const char* cB = (const char*)g.Bt + (size_t)cur.pn * tstep;
    S.a_ready(cur);
    if constexpr (SP2) {
        PG8_STAGE(PG8_SB(0, 0), cB, voffB); PG8_STAGE(PG8_SB(0, 1), cB + hstep, voffB); PG8_STAGE(PG8_SA(0, 0), cA, voffA); PG8_STAGE(PG8_SA(0, 1), cA + hstep, voffA);
        if (wr == 1) PG8_BAR;
        PG8_WAIT_V(2); PG8_BAR;
        PG8_STAGE(PG8_SB(1, 0), cB + kstep, voffB); PG8_STAGE(PG8_SA(1, 0), cA + kstep, voffA); PG8_STAGE(PG8_SB(1, 1), cB + hstep + kstep, voffB);
        PG8_WAIT_V(6); PG8_BAR;
    } else {
        PG8_STAGE(PG8_SB(0, 0), cB, voffB); PG8_STAGE(PG8_SA(0, 0), cA, voffA); PG8_STAGE(PG8_SB(0, 1), cB + hstep, voffB); PG8_STAGE(PG8_SA(0, 1), cA + hstep, voffA);
        if (wr == 1) PG8_BAR;
        PG8_WAIT_V(4); PG8_BAR;
        PG8_STAGE(PG8_SB(1, 0), cB + kstep, voffB); PG8_STAGE(PG8_SA(1, 0), cA + kstep, voffA); PG8_STAGE(PG8_SB(1, 1), cB + hstep + kstep, voffB);
        PG8_WAIT_V(6); PG8_BAR;
    }
    for (;;) {
        const bool has_next = S.next(ui + 1, nxt);
        const char* nA = has_next ? (const char*)g.A + (size_t)nxt.pm * tstep : cA; const char* nB = has_next ? (const char*)g.Bt + (size_t)nxt.pn * tstep : cB;
        for (int t = 0; t < nt; t += 2) {
            const bool last = (t == nt - 2);
            const char* a1 = cA + (size_t)(t + 1) * kstep;
            const char* a2 = last ? nA : cA + (size_t)(t + 2) * kstep; const char* b2 = last ? nB : cB + (size_t)(t + 2) * kstep;
            const char* a3 = a2 + kstep; const char* b3 = b2 + kstep;
            if (last && has_next) S.a_ready(nxt);
            if constexpr (SP2) {
            PG8_LDB(B0, 0, 0); PG8_LDB(B1, 0, 1); PG8_SCHED; PG8_LDA(At, 0, 0); PG8_STAGE(PG8_SA(1, 1), a1 + hstep, voffA);
            PG8_WAIT_V(8); PG8_WAIT_L(0); PG8_BAR; PG8_MMA(0, 0, At, B0); PG8_MMA(0, 1, At, B1); PG8_BAR; PG8_SCHED;
            PG8_LDA(At, 0, 1); PG8_STAGE(PG8_SB(0, 0), b2, voffB); PG8_STAGE(PG8_SB(0, 1), b2 + hstep, voffB); PG8_STAGE(PG8_SA(0, 0), a2, voffA);
            PG8_WAIT_V(8); PG8_WAIT_L(0); PG8_BAR; PG8_MMA(1, 0, At, B0); PG8_MMA(1, 1, At, B1); PG8_BAR; PG8_SCHED;
            PG8_LDB(B0, 1, 0); PG8_LDB(B1, 1, 1); PG8_SCHED; PG8_LDA(At, 1, 0); PG8_STAGE(PG8_SA(0, 1), a2 + hstep, voffA);
            PG8_WAIT_V(8); PG8_WAIT_L(0); PG8_BAR; PG8_MMA(0, 0, At, B0); PG8_MMA(0, 1, At, B1); PG8_BAR; PG8_SCHED;
            PG8_LDA(At, 1, 1); PG8_STAGE(PG8_SB(1, 0), b3, voffB); PG8_STAGE(PG8_SB(1, 1), b3 + hstep, voffB); PG8_STAGE(PG8_SA(1, 0), a3, voffA);
            PG8_WAIT_V(8); PG8_WAIT_L(0); PG8_BAR; PG8_MMA(1, 0, At, B0); PG8_MMA(1, 1, At, B1); PG8_BAR; PG8_SCHED;
            } else {
            PG8_LDB(B0, 0, 0); PG8_SCHED; PG8_LDA(At, 0, 0); PG8_STAGE(PG8_SA(1, 1), a1 + hstep, voffA);
            PG8_WAIT_L(8); PG8_BAR; PG8_WAIT_L(0); PG8_MMA(0, 0, At, B0); PG8_BAR; PG8_SCHED;
            PG8_LDB(B1, 0, 1); PG8_STAGE(PG8_SB(0, 0), b2, voffB);
            PG8_BAR; PG8_WAIT_L(0); PG8_MMA(0, 1, At, B1); PG8_BAR;
            PG8_LDA(At, 0, 1); PG8_STAGE(PG8_SA(0, 0), a2, voffA);
            PG8_BAR; PG8_WAIT_L(0); PG8_MMA(1, 0, At, B0); PG8_BAR; PG8_SCHED;
            PG8_STAGE(PG8_SB(0, 1), b2 + hstep, voffB);
            PG8_WAIT_V(6); PG8_BAR; PG8_MMA(1, 1, At, B1); PG8_BAR;
            PG8_LDB(B0, 1, 0); PG8_SCHED; PG8_LDA(At, 1, 0); PG8_STAGE(PG8_SA(0, 1), a2 + hstep, voffA);
            PG8_WAIT_L(8); PG8_BAR; PG8_WAIT_L(0); PG8_MMA(0, 0, At, B0); PG8_BAR; PG8_SCHED;
            PG8_LDB(B1, 1, 1); PG8_STAGE(PG8_SB(1, 0), b3, voffB);
            PG8_BAR; PG8_WAIT_L(0); PG8_MMA(0, 1, At, B1); PG8_BAR;
            PG8_LDA(At, 1, 1); PG8_STAGE(PG8_SA(1, 0), a3, voffA);
            PG8_BAR; PG8_WAIT_L(0); PG8_MMA(1, 0, At, B0); PG8_BAR; PG8_SCHED;
            PG8_STAGE(PG8_SB(1, 1), b3 + hstep, voffB);
            PG8_WAIT_V(6); PG8_BAR; PG8_MMA(1, 1, At, B1); PG8_BAR;
            }
        }
        if constexpr (ALIGN_EPI) { if (wr == 0) PG8_BAR; }
        if constexpr (!Epi::AFTER_DRAIN) { E(acc, cur, wr, wc, fr, fq); S.done(cur); }
        if (!has_next) break;
#pragma unroll
        for (int a = 0; a < 2; ++a)
#pragma unroll
            for (int b = 0; b < 2; ++b)
#pragma unroll
                for (int m = 0; m < 4; ++m)
#pragma unroll
                    for (int n = 0; n < 2; ++n) acc[a][b][m][n] = (f32x4){0.f, 0.f, 0.f, 0.f};
        cur = nxt; cA = nA; cB = nB; ++ui;
        if constexpr (ALIGN_EPI) { if (wr == 1) PG8_BAR; }
    }
    PG8_WAIT_V(0);
    if constexpr (!ALIGN_EPI) { if (wr == 0) PG8_BAR; }
    PG8_BAR;
    if constexpr (Epi::AFTER_DRAIN) { E.fused(acc, cur, wr, wc, fr, fq, lds, wid, lane); S.done(cur); }
#undef PG8_SA
#undef PG8_SB
#undef PG8_STAGE
#undef PG8_LDA
#undef PG8_LDB
#undef PG8_MMA
#undef PG8_WAIT_V
#undef PG8_WAIT_L
#undef PG8_BAR
#undef PG8_SCHED
}
}

constexpr int NB = 4, SEQ = 8192, DM = 1024, NT = NB * SEQ;
constexpr int EVEN_IN = 2560, ODD_IN = 3088, ODD_IN_PAD = 3328, PQ_N = 2048;
constexpr int NEXP = 16384;
constexpr float EPS = 1e-6f;
constexpr float LOG2E = 1.4426950408889634f;
constexpr float QSCALE_ATT = 0.125f * LOG2E;
constexpr float QSCALE_GLA = 0.08838834764831845f;
constexpr float LAM_INIT0 = 0.2f;

constexpr size_t MiB = 1u << 20;
constexpr size_t WS_CTL = 0, CTL_ZERO_BYTES = 1 * MiB;
constexpr size_t WS_ROWSQ0 = 27 * MiB, WS_ROWSQ1 = 29 * MiB;
constexpr size_t WS_DEC = 1 * MiB;
constexpr size_t WS_WIN0 = 2 * MiB, WS_WOUT0 = 7 * MiB, WS_WIN1 = 9 * MiB, WS_WOUT1 = 16 * MiB, WS_WQ0 = 18 * MiB, WS_WQ1 = 22 * MiB, WS_SK = 26 * MiB;
constexpr size_t WS_UT = 32 * MiB, WS_VT = 96 * MiB;
constexpr size_t WS_HN = 160 * MiB;
constexpr size_t WS_IDS = 224 * MiB, WS_GATE = 240 * MiB;
constexpr size_t WS_SCR = 256 * MiB;
constexpr size_t S0_Q = WS_SCR, S0_K = WS_SCR + 32 * MiB, S0_VT = WS_SCR + 64 * MiB, S0_GLU = WS_SCR + 96 * MiB, S0_CAT = WS_SCR + 128 * MiB;
constexpr size_t SP_PQ = WS_SCR;
constexpr size_t S1_Q = WS_SCR, S1_K = WS_SCR + 32 * MiB, S1_V = WS_SCR + 64 * MiB, S1_G = WS_SCR + 128 * MiB, S1_Z = WS_SCR + 192 * MiB;
constexpr size_t WS_END = 456 * MiB;

constexpr int LDS_BYTES = 155648;
constexpr int MISC_OFF = LDS_BYTES - 256;
constexpr int NWAVES = 8, NTHREADS = 512;

#define GAS __attribute__((address_space(1)))
#define LAS __attribute__((address_space(3)))
typedef unsigned short bf16;
typedef unsigned v4u __attribute__((ext_vector_type(4)));
typedef unsigned v2u __attribute__((ext_vector_type(2)));
typedef float f32x4 __attribute__((ext_vector_type(4)));
typedef float f32x16 __attribute__((ext_vector_type(16)));
typedef short bf16x8 __attribute__((ext_vector_type(8)));
typedef float f32x2_t __attribute__((ext_vector_type(2)));
typedef __bf16 bf16x2_t __attribute__((ext_vector_type(2)));
#define LDS_WAIT() asm volatile("s_waitcnt lgkmcnt(0)" ::: "memory")
#define VM_WAIT() asm volatile("s_waitcnt vmcnt(0)" ::: "memory")
__device__ __forceinline__ unsigned pk2(float lo, float hi) { f32x2_t v = {lo, hi}; bf16x2_t b = __builtin_convertvector(v, bf16x2_t); return __builtin_bit_cast(unsigned, b); }
__device__ __forceinline__ float bf_lo(unsigned w) { return __builtin_bit_cast(float, w << 16); }
__device__ __forceinline__ float bf_hi(unsigned w) { return __builtin_bit_cast(float, w & 0xffff0000u); }
__device__ __forceinline__ float bf2f(bf16 v) { return __builtin_bit_cast(float, (unsigned)v << 16); }
__device__ __forceinline__ bf16 f2bf(float f) { return (bf16)(pk2(f, 0.f) & 0xffffu); }
__device__ __forceinline__ float wave_sum(float v) {
#pragma unroll
    for (int o = 1; o < 64; o <<= 1) v += __shfl_xor(v, o);
    return v;
}
__device__ __forceinline__ float fast_exp2(float x) { return __builtin_amdgcn_exp2f(x); }
__device__ __forceinline__ float fast_rcp(float x) { return __builtin_amdgcn_rcpf(x); }
__device__ __forceinline__ float sigmoidf_(float x) { return fast_rcp(1.f + fast_exp2(-x * LOG2E)); }
__device__ __forceinline__ float siluf_(float x) { return x * sigmoidf_(x); }
#define XB_TMO      128
#define XB_XCNT(j)  (256  + 64 * (j))
#define XB_XSUB(j)  (1280 + 64 * (j))
#define XB_XGEN(j)  (2304 + 64 * (j))
#define XB_TOP      3328
#define XB_TOPGEN   3392
#define XCD_BAR_WORDS 3456
#define XB_SPIN_CAP (1u << 18)

__device__ __forceinline__ unsigned xb_ld(unsigned* p)              { return __hip_atomic_load(p, __ATOMIC_RELAXED, __HIP_MEMORY_SCOPE_AGENT); }
__device__ __forceinline__ unsigned xb_add(unsigned* p, unsigned v) { return __hip_atomic_fetch_add(p, v, __ATOMIC_RELAXED, __HIP_MEMORY_SCOPE_AGENT); }
__device__ __forceinline__ unsigned xb_xcc_id() { return (unsigned)__builtin_amdgcn_s_getreg((3 << 11) | 20) & 0xFu; }
#define XB_SPIN(cond, bar) do { unsigned _sp = 0; while (cond) { __builtin_amdgcn_s_sleep(1); \
    if ((++_sp & 255u) == 0u) { if (xb_ld(&(bar)[XB_TMO])) break; if (_sp > XB_SPIN_CAP) { atomicAdd(&(bar)[XB_TMO], 1u); break; } } } } while (0)

struct XcdBarrier {
    unsigned* bar; unsigned x;
    volatile LAS unsigned* st;
};

__device__ __forceinline__ XcdBarrier xcd_barrier_post(unsigned* bar, volatile LAS unsigned* st) {
    XcdBarrier b; b.bar = bar; b.x = xb_xcc_id(); b.st = st;
    if (threadIdx.x == 0) (void)xb_add(&bar[XB_XCNT(b.x)], 1u);
    return b;
}
__device__ __forceinline__ void xcd_barrier_complete(unsigned* bar, unsigned x, unsigned& nloc, unsigned& nx) {
    const unsigned G = gridDim.x * gridDim.y * gridDim.z;
    unsigned sum, cnt, mine, sp = 0u;
    for (;;) {
        sum = 0u; cnt = 0u; mine = 0u;
#pragma unroll
        for (unsigned j = 0; j < 16; ++j) { const unsigned c = xb_ld(&bar[XB_XCNT(j)]); sum += c; cnt += (c > 0u) ? 1u : 0u; mine = (j == x) ? c : mine; }
        if (sum == G) break;
        __builtin_amdgcn_s_sleep(1);
        if ((++sp & 255u) == 0u) { if (xb_ld(&bar[XB_TMO])) break; if (sp > XB_SPIN_CAP) { atomicAdd(&bar[XB_TMO], 1u); break; } }
    }
    nloc = mine > 0u ? mine : 1u; nx = cnt > 0u ? cnt : 1u;
}

__device__ __forceinline__ void xcd_barrier(const XcdBarrier& b) {
    asm volatile("s_waitcnt vmcnt(0)" ::: "memory");
    __syncthreads();
    if (threadIdx.x == 0) {
        unsigned* bar = b.bar;
        __builtin_amdgcn_s_waitcnt(0);
        unsigned nloc = b.st[0], nx = b.st[1];
        if (nloc == 0u) { xcd_barrier_complete(bar, b.x, nloc, nx); b.st[0] = nloc; b.st[1] = nx; }
        const unsigned old = xb_add(&bar[XB_XSUB(b.x)], 1u);
        const unsigned gen = old / nloc;
        if (old + 1u == (gen + 1u) * nloc) {
            __builtin_amdgcn_fence(__ATOMIC_RELEASE, "agent");
            asm volatile("s_waitcnt vmcnt(0)" ::: "memory");
            const unsigned og = xb_add(&bar[XB_TOP], 1u);
            const unsigned tg = og / nx;
            if (og + 1u == (tg + 1u) * nx) xb_add(&bar[XB_TOPGEN], 1u);
            else XB_SPIN(xb_ld(&bar[XB_TOPGEN]) == tg, bar);
            __builtin_amdgcn_fence(__ATOMIC_ACQUIRE, "agent");
            xb_add(&bar[XB_XGEN(b.x)], 1u);
            asm volatile("s_waitcnt vmcnt(0)" ::: "memory");
        } else {
            XB_SPIN(xb_ld(&bar[XB_XGEN(b.x)]) == gen, bar);
            __builtin_amdgcn_fence(__ATOMIC_ACQUIRE, "agent");
            asm volatile("s_waitcnt vmcnt(0)" ::: "memory");
        }
    }
    __syncthreads();
}

struct Frame {
    LAS unsigned char* lds;
    volatile LAS unsigned* MISC;
    unsigned* ctl;
    int tid, lane, wave;
    int vcu, G;
    const float* const __attribute__((address_space(4)))* in;
    float* out;
    unsigned char* ws;
};
enum { I_X = 0, I_RELB, I_LNMIX, I_LNFFN, I_EWIN, I_LQ1, I_LK1, I_LQ2, I_LK2, I_SUBLN, I_CONVW, I_CONVB, I_CLNG, I_CLNB, I_EWOUT, I_OWIN, I_WG2, I_BG2, I_GLAG, I_OWOUT, I_PWQ, I_PSK, I_PU, I_PV, I_LNF };

__device__ __forceinline__ void p0_transpose_item(const float* W, int Nsrc, bf16* WT, int kb, int dstrow0, int srccol0, const float* gain, LAS float* scr, int lane) {
    const int k0 = 64 * kb; const int col = srccol0 + (lane & 31); const bool ok = col < Nsrc;
#pragma unroll 8
    for (int i = 0; i < 32; ++i) { const int kk = 2 * i + (lane >> 5); float v = ok ? W[(size_t)(k0 + kk) * Nsrc + col] : 0.f; if (gain) v *= gain[k0 + kk]; scr[kk * 33 + (lane & 31)] = v; }
    LDS_WAIT(); asm volatile("" ::: "memory");
    const int c = lane & 7;
#pragma unroll
    for (int j = 0; j < 4; ++j) { const int n = (lane >> 3) + 8 * j; const LAS float* s = scr + (8 * c) * 33 + n;
        v4u o; o.x = pk2(s[0 * 33], s[1 * 33]); o.y = pk2(s[2 * 33], s[3 * 33]); o.z = pk2(s[4 * 33], s[5 * 33]); o.w = pk2(s[6 * 33], s[7 * 33]);
        *(v4u*)(WT + (size_t)(dstrow0 + n) * 1024 + k0 + 8 * c) = o; }
    LDS_WAIT(); asm volatile("" ::: "memory");
}
__device__ __forceinline__ int win0_src(int dstrow) { if (dstrow < 1536) return dstrow; const int r = dstrow - 1536, j = r >> 8, half = (r >> 7) & 1, i = r & 127; return 1536 + 512 * half + 128 * j + i; }

__device__ __forceinline__ void rms_row_to_bf16(const float* xrow, const float* g, bf16* orow, int lane) {
    const f32x4* xr = (const f32x4*)xrow + lane; const f32x4* gr = (const f32x4*)g + lane;
    f32x4 v[4]; float s = 0.f;
#pragma unroll
    for (int j = 0; j < 4; ++j) { v[j] = xr[64 * j]; s += (v[j].x * v[j].x + v[j].y * v[j].y) + (v[j].z * v[j].z + v[j].w * v[j].w); }
    const float r = 1.f / sqrtf(wave_sum(s) * (1.f / DM) + EPS);
    v2u* o8 = (v2u*)orow + lane;
#pragma unroll
    for (int j = 0; j < 4; ++j) { const f32x4 gg = gr[64 * j]; v2u w; w.x = pk2(v[j].x * r * gg.x, v[j].y * r * gg.y); w.y = pk2(v[j].z * r * gg.z, v[j].w * r * gg.w); o8[64 * j] = w; }
}
__device__ __forceinline__ void cvt_stream_bf16(const float* src, bf16* dst, size_t n, int gtid, int gthreads) {
    const size_t n8 = n >> 3;
    for (size_t i = gtid; i < n8; i += gthreads) { const f32x4 a = ((const f32x4*)src)[2 * i], b = ((const f32x4*)src)[2 * i + 1];
        v4u o; o.x = pk2(a.x, a.y); o.y = pk2(a.z, a.w); o.z = pk2(b.x, b.y); o.w = pk2(b.z, b.w); ((v4u*)dst)[i] = o; }
}
__device__ __forceinline__ void p0_prologue(Frame& F) {
    LAS float* scr = (LAS float*)(F.lds + F.wave * 8704);
    const int gw = F.vcu * NWAVES + F.wave, NGW = F.G * NWAVES;
    bf16* WIN0 = (bf16*)(F.ws + WS_WIN0); bf16* WOUT0 = (bf16*)(F.ws + WS_WOUT0); bf16* WIN1 = (bf16*)(F.ws + WS_WIN1); bf16* WOUT1 = (bf16*)(F.ws + WS_WOUT1);
    bf16* WQ0 = (bf16*)(F.ws + WS_WQ0); bf16* WQ1 = (bf16*)(F.ws + WS_WQ1);
    constexpr int I0 = 16 * (EVEN_IN / 32), I1 = 16 * (DM / 32), I2 = 16 * (ODD_IN_PAD / 32), I3 = I1, I4 = 16 * (PQ_N / 32), I5 = I4;
    constexpr int NITEMS = I0 + I1 + I2 + I3 + I4 + I5;
    for (int it = gw; it < NITEMS; it += NGW) {
        int r = it;
        if (r < I0) { const int nb = r % (EVEN_IN / 32), kb = r / (EVEN_IN / 32); p0_transpose_item(F.in[I_EWIN], EVEN_IN, WIN0, kb, 32 * nb, win0_src(32 * nb), nullptr, scr, F.lane); continue; } r -= I0;
        if (r < I1) { const int nb = r % (DM / 32), kb = r / (DM / 32); p0_transpose_item(F.in[I_EWOUT], DM, WOUT0, kb, 32 * nb, 32 * nb, nullptr, scr, F.lane); continue; } r -= I1;
        if (r < I2) { const int nb = r % (ODD_IN_PAD / 32), kb = r / (ODD_IN_PAD / 32); p0_transpose_item(F.in[I_OWIN], ODD_IN, WIN1, kb, 32 * nb, 32 * nb, nullptr, scr, F.lane); continue; } r -= I2;
        if (r < I3) { const int nb = r % (DM / 32), kb = r / (DM / 32); p0_transpose_item(F.in[I_OWOUT], DM, WOUT1, kb, 32 * nb, 32 * nb, nullptr, scr, F.lane); continue; } r -= I3;
        if (r < I4) { const int nb = r % (PQ_N / 32), kb = r / (PQ_N / 32); p0_transpose_item(F.in[I_PWQ], PQ_N, WQ0, kb, 32 * nb, 32 * nb, F.in[I_LNFFN], scr, F.lane); continue; } r -= I4;
        { const int nb = r % (PQ_N / 32), kb = r / (PQ_N / 32); p0_transpose_item(F.in[I_PWQ] + (size_t)DM * PQ_N, PQ_N, WQ1, kb, 32 * nb, 32 * nb, F.in[I_LNFFN] + DM, scr, F.lane); }
    }
    const int gtid = F.vcu * NTHREADS + F.tid, gthreads = F.G * NTHREADS;
    cvt_stream_bf16(F.in[I_PSK], (bf16*)(F.ws + WS_SK), (size_t)2 * 8 * 2 * 128 * 128, gtid, gthreads);
    cvt_stream_bf16(F.in[I_PU], (bf16*)(F.ws + WS_UT), (size_t)2 * NEXP * DM, gtid, gthreads);
    cvt_stream_bf16(F.in[I_PV], (bf16*)(F.ws + WS_VT), (size_t)2 * NEXP * DM, gtid, gthreads);
    bf16* HN = (bf16*)(F.ws + WS_HN);
    for (int m = gw; m < NT; m += NGW) rms_row_to_bf16(F.in[I_X] + (size_t)m * DM, F.in[I_LNMIX], HN + (size_t)m * DM, F.lane);
}

struct EpiIn0 {
    static constexpr bool PERM = false, AFTER_DRAIN = false;
    bf16* Q; bf16* K; bf16* Vt; bf16* GLU;
    __device__ __forceinline__ void operator()(const pg8::f32x4 (&acc)[2][2][4][2], const pg8::Unit& u, int wr, int wc, int fr, int fq) const {
        const int pn = u.pn;
#pragma unroll
        for (int ai = 0; ai < 2; ++ai)
#pragma unroll
            for (int m = 0; m < 4; ++m) {
                const int row = u.pm * 256 + ai * 128 + wr * 64 + m * 16 + fr; const int b = row >> 13, s = row & 8191;
                if (pn < 4) {
                    bf16* base = (pn < 2) ? Q : K; const float sc = (pn < 2) ? QSCALE_ATT : 1.f;
#pragma unroll
                    for (int bj = 0; bj < 2; ++bj)
#pragma unroll
                        for (int n = 0; n < 2; ++n) { const int c = (pn & 1) * 256 + bj * 128 + wc * 32 + n * 16 + fq * 4; const int h = c >> 7, mp = (c >> 6) & 1, d = c & 63;
                            const pg8::f32x4 v = acc[ai][bj][m][n] * sc; v2u w; w.x = pk2(v[0], v[1]); w.y = pk2(v[2], v[3]);
                            *(v2u*)(base + ((((size_t)(b * 4 + h) * 2 + mp) * SEQ + s) * 64 + d)) = w; }
                } else if (pn < 6) {
#pragma unroll
                    for (int bj = 0; bj < 2; ++bj)
#pragma unroll
                        for (int n = 0; n < 2; ++n) { const int c = (pn - 4) * 256 + bj * 128 + wc * 32 + n * 16 + fq * 4; const int h = c >> 7, d = c & 127;
                            bf16* p = Vt + ((size_t)(b * 4 + h) * 128 + d) * SEQ + s; const pg8::f32x4 v = acc[ai][bj][m][n];
                            p[0] = f2bf(v[0]); p[SEQ] = f2bf(v[1]); p[2 * SEQ] = f2bf(v[2]); p[3 * SEQ] = f2bf(v[3]); }
                } else {
#pragma unroll
                    for (int n = 0; n < 2; ++n) { const int ch = (pn - 6) * 128 + wc * 32 + n * 16 + fq * 4; const pg8::f32x4 a = acc[ai][0][m][n], g = acc[ai][1][m][n];
                        v2u w; w.x = pk2(a[0] * sigmoidf_(g[0]), a[1] * sigmoidf_(g[1])); w.y = pk2(a[2] * sigmoidf_(g[2]), a[3] * sigmoidf_(g[3]));
                        *(v2u*)(GLU + (size_t)row * 512 + ch) = w; }
                }
            }
    }
};
struct EpiRes {
    static constexpr bool PERM = false, AFTER_DRAIN = false;
    const float* base; float* out; bf16* xb; float* rowsq;
    __device__ __forceinline__ void operator()(const pg8::f32x4 (&acc)[2][2][4][2], const pg8::Unit& u, int wr, int wc, int fr, int fq) const {
#pragma unroll
        for (int ai = 0; ai < 2; ++ai)
#pragma unroll
            for (int m = 0; m < 4; ++m) {
                const int row = u.pm * 256 + ai * 128 + wr * 64 + m * 16 + fr; float ss = 0.f;
#pragma unroll
                for (int bj = 0; bj < 2; ++bj)
#pragma unroll
                    for (int n = 0; n < 2; ++n) { const size_t off = (size_t)row * DM + u.pn * 256 + bj * 128 + wc * 32 + n * 16 + fq * 4;
                        const pg8::f32x4 o = *(const pg8::f32x4*)(base + off) + acc[ai][bj][m][n];
                        *(pg8::f32x4*)(out + off) = o; v2u w; w.x = pk2(o[0], o[1]); w.y = pk2(o[2], o[3]); *(v2u*)(xb + off) = w;
                        ss += (o[0] * o[0] + o[1] * o[1]) + (o[2] * o[2] + o[3] * o[3]); }
                ss += __shfl_xor(ss, 16); ss += __shfl_xor(ss, 32);
                if (fq == 0) rowsq[(size_t)row * 16 + u.pn * 4 + wc] = ss;
            }
    }
};
struct EpiPq {
    static constexpr bool PERM = false, AFTER_DRAIN = false;
    bf16* PQ; const float* rowsq;
    __device__ __forceinline__ void operator()(const pg8::f32x4 (&acc)[2][2][4][2], const pg8::Unit& u, int wr, int wc, int fr, int fq) const {
#pragma unroll
        for (int ai = 0; ai < 2; ++ai)
#pragma unroll
            for (int m = 0; m < 4; ++m) {
                const int row = u.pm * 256 + ai * 128 + wr * 64 + m * 16 + fr; const f32x4 q0 = *(const f32x4*)(rowsq + (size_t)row * 16), q1 = *(const f32x4*)(rowsq + (size_t)row * 16 + 4), q2 = *(const f32x4*)(rowsq + (size_t)row * 16 + 8), q3 = *(const f32x4*)(rowsq + (size_t)row * 16 + 12);
                const float rs = 1.f / sqrtf(((((q0.x + q0.y) + (q0.z + q0.w)) + ((q1.x + q1.y) + (q1.z + q1.w))) + (((q2.x + q2.y) + (q2.z + q2.w)) + ((q3.x + q3.y) + (q3.z + q3.w)))) * (1.f / DM) + EPS);
#pragma unroll
                for (int bj = 0; bj < 2; ++bj)
#pragma unroll
                    for (int n = 0; n < 2; ++n) { const size_t off = (size_t)row * PQ_N + u.pn * 256 + bj * 128 + wc * 32 + n * 16 + fq * 4;
                        const pg8::f32x4 v = acc[ai][bj][m][n] * rs; v2u w; w.x = pk2(v[0], v[1]); w.y = pk2(v[2], v[3]); *(v2u*)(PQ + off) = w; }
            }
    }
};
struct EpiIn1 {
    static constexpr bool PERM = false, AFTER_DRAIN = false;
    bf16* Q; bf16* K; bf16* V; bf16* G; float* Z;
    __device__ __forceinline__ void operator()(const pg8::f32x4 (&acc)[2][2][4][2], const pg8::Unit& u, int wr, int wc, int fr, int fq) const {
        const int pn = u.pn;
#pragma unroll
        for (int ai = 0; ai < 2; ++ai)
#pragma unroll
            for (int m = 0; m < 4; ++m) {
                const int row = u.pm * 256 + ai * 128 + wr * 64 + m * 16 + fr;
#pragma unroll
                for (int bj = 0; bj < 2; ++bj)
#pragma unroll
                    for (int n = 0; n < 2; ++n) { const int c = pn * 256 + bj * 128 + wc * 32 + n * 16 + fq * 4; pg8::f32x4 v = acc[ai][bj][m][n];
                        if (pn < 2) { v = v * QSCALE_GLA; v2u w; w.x = pk2(v[0], v[1]); w.y = pk2(v[2], v[3]); *(v2u*)(Q + (size_t)row * 512 + c) = w; }
                        else if (pn < 4) { v2u w; w.x = pk2(v[0], v[1]); w.y = pk2(v[2], v[3]); *(v2u*)(K + (size_t)row * 512 + (c - 512)) = w; }
                        else if (pn < 8) { v2u w; w.x = pk2(v[0], v[1]); w.y = pk2(v[2], v[3]); *(v2u*)(V + (size_t)row * 1024 + (c - 1024)) = w; }
                        else if (pn < 12) { v2u w; w.x = pk2(siluf_(v[0]), siluf_(v[1])); w.y = pk2(siluf_(v[2]), siluf_(v[3])); *(v2u*)(G + (size_t)row * 1024 + (c - 2048)) = w; }
                        else { const int cz = c - 3072; if (cz < 16) *(pg8::f32x4*)(Z + (size_t)row * 16 + cz) = v; } }
            }
    }
};

namespace att {
constexpr int KSTR = 144, VSTR = 136;
constexpr int OFF_K1 = 0, OFF_K2 = 64 * KSTR, OFF_V = 2 * 64 * KSTR, BUFB = OFF_V + 128 * VSTR;
constexpr int OFF_TB = 2 * BUFB;
constexpr float THR = 8.f;
__device__ __forceinline__ int t5_bucket(int rel) {
    const int n = rel < 0 ? -rel : rel; int v;
    if (n < 8) v = n; else { v = 8 + (31 - __clz(n * n)) - 6; if (v > 15) v = 15; }
    return (rel > 0 ? 16 : 0) + v;
}
__device__ __forceinline__ void attn_unit(Frame& F, int bh, int qb, float lam) {
    const int tid = F.tid, lane = F.lane, wid = F.wave, r32 = lane & 31, hi = lane >> 5;
    const int mp = wid >> 2, wq = wid & 3, h = bh & 3;
    const int q0 = qb * 128, qw = q0 + 32 * wq;
    LAS unsigned char* lds = F.lds;
    const bf16* Qg = (const bf16*)(F.ws + S0_Q); const bf16* Kg = (const bf16*)(F.ws + S0_K); const bf16* Vg = (const bf16*)(F.ws + S0_VT);
    LAS float* tb = (LAS float*)(lds + OFF_TB);
    const float* relb = F.in[I_RELB];
    for (int i = tid; i < 320; i += NTHREADS) tb[i] = relb[t5_bucket(i - 255) * 4 + h] * LOG2E;
    const float c15 = relb[15 * 4 + h] * LOG2E;
    const bf16* Qp = Qg + (((size_t)(bh * 2 + mp) * SEQ) + qw + r32) * 64 + 8 * hi;
    bf16x8 qf[4];
#pragma unroll
    for (int s = 0; s < 4; ++s) qf[s] = *(const bf16x8*)(Qp + 16 * s);
    const int nt_unit = 2 * qb + 2, nt_wave = (qw >> 6) + 1;
    const int krow = tid >> 3, kch = tid & 7;
    const bf16* k1src = Kg + (((size_t)(bh * 2 + 0) * SEQ) + krow) * 64 + kch * 8;
    const bf16* k2src = Kg + (((size_t)(bh * 2 + 1) * SEQ) + krow) * 64 + kch * 8;
    const bf16* vsrc = Vg + ((size_t)bh * 128 + krow) * SEQ + kch * 8;
    const int kdst = krow * KSTR + kch * 16, vdst = krow * VSTR + kch * 16;
    v4u rk1, rk2, rv0, rv1;
#define ATT_LOAD(t) do { rk1 = *(const v4u*)(k1src + (size_t)(t) * 4096); rk2 = *(const v4u*)(k2src + (size_t)(t) * 4096); rv0 = *(const v4u*)(vsrc + (t) * 64); rv1 = *(const v4u*)(vsrc + (size_t)64 * SEQ + (t) * 64); } while (0)
#define ATT_STORE(bf) do { LAS unsigned char* bb = lds + (bf) * BUFB; *(LAS v4u*)(bb + OFF_K1 + kdst) = rk1; *(LAS v4u*)(bb + OFF_K2 + kdst) = rk2; \
        *(LAS v2u*)(bb + OFF_V + vdst) = (v2u){rv0.x, rv0.y}; *(LAS v2u*)(bb + OFF_V + vdst + 8) = (v2u){rv0.z, rv0.w}; \
        *(LAS v2u*)(bb + OFF_V + 64 * VSTR + vdst) = (v2u){rv1.x, rv1.y}; *(LAS v2u*)(bb + OFF_V + 64 * VSTR + vdst + 8) = (v2u){rv1.z, rv1.w}; } while (0)
    ATT_LOAD(0); ATT_STORE(0);
    __syncthreads();
    f32x16 o[4];
#pragma unroll
    for (int d = 0; d < 4; ++d)
#pragma unroll
        for (int r = 0; r < 16; ++r) o[d][r] = 0.f;
    float m_run = -INFINITY, l_run = 0.f;
    for (int t = 0; t < nt_unit; ++t) {
        const int buf = t & 1;
        if (t + 1 < nt_unit) ATT_LOAD(t + 1);
        if (t < nt_wave) {
            const LAS unsigned char* kb = lds + buf * BUFB + (mp ? OFF_K2 : OFF_K1) + r32 * KSTR + hi * 16;
            f32x16 p0, p1;
#pragma unroll
            for (int r = 0; r < 16; ++r) { p0[r] = 0.f; p1[r] = 0.f; }
#pragma unroll
            for (int s = 0; s < 4; ++s) { const bf16x8 a0 = *(const LAS bf16x8*)(kb + s * 32), a1 = *(const LAS bf16x8*)(kb + 32 * KSTR + s * 32);
                p0 = __builtin_amdgcn_mfma_f32_32x32x16_bf16(a0, qf[s], p0, 0, 0, 0); p1 = __builtin_amdgcn_mfma_f32_32x32x16_bf16(a1, qf[s], p1, 0, 0, 0); }
            if (64 * t + 154 <= qw) {
#pragma unroll
                for (int r = 0; r < 16; ++r) { p0[r] += c15; p1[r] += c15; }
            } else {
                const int base = 64 * t - (qw + r32) + 255 + 4 * hi;
#pragma unroll
                for (int r = 0; r < 16; ++r) { const int idx = base + (r & 3) + 8 * (r >> 2); p0[r] += tb[idx]; p1[r] += tb[idx + 32]; }
            }
            float rm = fmaxf(p0[0], p1[0]);
#pragma unroll
            for (int r = 1; r < 16; ++r) rm = fmaxf(rm, fmaxf(p0[r], p1[r]));
            rm = fmaxf(rm, __shfl_xor(rm, 32));
            if (__any(rm > m_run + THR)) {
                const float mn = fmaxf(m_run, rm), al = fast_exp2(m_run - mn);
#pragma unroll
                for (int d = 0; d < 4; ++d)
#pragma unroll
                    for (int r = 0; r < 16; ++r) o[d][r] *= al;
                l_run *= al; m_run = mn;
            }
            float ls = 0.f;
#pragma unroll
            for (int r = 0; r < 16; ++r) { p0[r] = fast_exp2(p0[r] - m_run); p1[r] = fast_exp2(p1[r] - m_run); ls += p0[r] + p1[r]; }
            l_run += ls;
            bf16x8 pb[4];
            { v4u w;
              w.x = pk2(p0[0], p0[1]); w.y = pk2(p0[2], p0[3]); w.z = pk2(p0[4], p0[5]); w.w = pk2(p0[6], p0[7]); pb[0] = __builtin_bit_cast(bf16x8, w);
              w.x = pk2(p0[8], p0[9]); w.y = pk2(p0[10], p0[11]); w.z = pk2(p0[12], p0[13]); w.w = pk2(p0[14], p0[15]); pb[1] = __builtin_bit_cast(bf16x8, w);
              w.x = pk2(p1[0], p1[1]); w.y = pk2(p1[2], p1[3]); w.z = pk2(p1[4], p1[5]); w.w = pk2(p1[6], p1[7]); pb[2] = __builtin_bit_cast(bf16x8, w);
              w.x = pk2(p1[8], p1[9]); w.y = pk2(p1[10], p1[11]); w.z = pk2(p1[12], p1[13]); w.w = pk2(p1[14], p1[15]); pb[3] = __builtin_bit_cast(bf16x8, w); }
            const LAS unsigned char* vb = lds + buf * BUFB + OFF_V + r32 * VSTR + hi * 8;
#pragma unroll
            for (int d = 0; d < 4; ++d)
#pragma unroll
                for (int s = 0; s < 4; ++s) { const v2u lo = *(const LAS v2u*)(vb + d * 32 * VSTR + s * 32), h8 = *(const LAS v2u*)(vb + d * 32 * VSTR + s * 32 + 16);
                    const v4u aw = {lo.x, lo.y, h8.x, h8.y};
                    o[d] = __builtin_amdgcn_mfma_f32_32x32x16_bf16(__builtin_bit_cast(bf16x8, aw), pb[s], o[d], 0, 0, 0); }
        }
        if (t + 1 < nt_unit) ATT_STORE(buf ^ 1);
        __syncthreads();
    }
#undef ATT_LOAD
#undef ATT_STORE
    l_run += __shfl_xor(l_run, 32);
    const float inv = 1.f / l_run;
    LAS float* X = (LAS float*)lds + (size_t)(wq * 64) * 64 + lane;
    if (mp == 1) {
#pragma unroll
        for (int d = 0; d < 4; ++d)
#pragma unroll
            for (int r = 0; r < 16; ++r) X[(d * 16 + r) * 64] = o[d][r] * inv;
    }
    __syncthreads();
    if (mp == 0) {
        float ss = 0.f;
#pragma unroll
        for (int d = 0; d < 4; ++d)
#pragma unroll
            for (int r = 0; r < 16; ++r) { const float v = o[d][r] * inv - lam * X[(d * 16 + r) * 64]; o[d][r] = v; ss += v * v; }
        ss += __shfl_xor(ss, 32);
        const float rn = (1.f - LAM_INIT0) / sqrtf(ss * (1.f / 128.f) + EPS);
        bf16* CAT = (bf16*)(F.ws + S0_CAT) + ((size_t)(bh >> 2) * SEQ + qw + r32) * DM + h * 128;
        const float* sg = F.in[I_SUBLN];
#pragma unroll
        for (int d = 0; d < 4; ++d)
#pragma unroll
            for (int rg = 0; rg < 4; ++rg) { const int dd = 32 * d + 8 * rg + 4 * hi; const f32x4 g4 = *(const f32x4*)(sg + dd);
                v2u w; w.x = pk2(o[d][4 * rg] * rn * g4.x, o[d][4 * rg + 1] * rn * g4.y); w.y = pk2(o[d][4 * rg + 2] * rn * g4.z, o[d][4 * rg + 3] * rn * g4.w);
                *(v2u*)(CAT + dd) = w; }
    }
    __syncthreads();
}
__device__ __forceinline__ void conv_unit(Frame& F, int tile) {
    const int c = F.tid, t0 = tile * 32, s0 = t0 & (SEQ - 1);
    const bf16* GLU = (const bf16*)(F.ws + S0_GLU);
    const float* cw = F.in[I_CONVW];
    float w[31];
#pragma unroll
    for (int j = 0; j < 31; ++j) w[j] = cw[j * 512 + c];
    const float bias = F.in[I_CONVB][c];
    float u[62];
#pragma unroll
    for (int i = 0; i < 62; ++i) { const int s = s0 - 30 + i; u[i] = (s >= 0) ? bf2f(GLU[(size_t)(t0 - 30 + i) * 512 + c]) : 0.f; }
    LAS float* Y = (LAS float*)F.lds;
#pragma unroll
    for (int tt = 0; tt < 32; ++tt) { float y = bias;
#pragma unroll
        for (int j = 0; j < 31; ++j) y += w[j] * u[tt + j];
        Y[tt * 516 + c] = y; }
    __syncthreads();
    const float* lg = F.in[I_CLNG]; const float* lb = F.in[I_CLNB];
    bf16* CAT = (bf16*)(F.ws + S0_CAT);
#pragma unroll
    for (int k = 0; k < 4; ++k) { const int tt = 4 * F.wave + k;
        const f32x4 a = *(const LAS f32x4*)(Y + tt * 516 + F.lane * 8), b = *(const LAS f32x4*)(Y + tt * 516 + F.lane * 8 + 4);
        const float mean = wave_sum((a.x + a.y) + (a.z + a.w) + (b.x + b.y) + (b.z + b.w)) * (1.f / 512.f);
        const f32x4 da = a - mean, db = b - mean;
        const float var = wave_sum((da.x * da.x + da.y * da.y) + (da.z * da.z + da.w * da.w) + (db.x * db.x + db.y * db.y) + (db.z * db.z + db.w * db.w)) * (1.f / 512.f);
        const float rs = 1.f / sqrtf(var + EPS);
        const f32x4 g0 = *(const f32x4*)(lg + F.lane * 8), g1 = *(const f32x4*)(lg + F.lane * 8 + 4), b0 = *(const f32x4*)(lb + F.lane * 8), b1 = *(const f32x4*)(lb + F.lane * 8 + 4);
        const f32x4 y0 = da * rs * g0 + b0, y1 = db * rs * g1 + b1;
        v4u o; o.x = pk2(siluf_(y0.x), siluf_(y0.y)); o.y = pk2(siluf_(y0.z), siluf_(y0.w)); o.z = pk2(siluf_(y1.x), siluf_(y1.y)); o.w = pk2(siluf_(y1.z), siluf_(y1.w));
        *(v4u*)(CAT + (size_t)(t0 + tt) * DM + 512 + F.lane * 8) = o; }
    __syncthreads();
}
__device__ __forceinline__ void p2_attn_conv(Frame& F) {
    const float d1 = wave_sum(F.in[I_LQ1][F.lane] * F.in[I_LK1][F.lane]), d2 = wave_sum(F.in[I_LQ2][F.lane] * F.in[I_LK2][F.lane]);
    const float lam = expf(d1) - expf(d2) + LAM_INIT0;
    for (int a = F.vcu; a < 1024; a += F.G) { const int i = a >> 8, v = a & 255, x = v >> 5, j = v & 31; attn_unit(F, 2 * x + (i >> 1), (i & 1) ? (63 - j) : j, lam); }
    for (int a = F.vcu; a < NT / 32; a += F.G) conv_unit(F, a);
}
}

namespace peer {
constexpr int SSTR = 136;
__device__ __forceinline__ unsigned mono(float f) { const unsigned u = __builtin_bit_cast(unsigned, f); return u ^ ((unsigned)((int)u >> 31) | 0x80000000u); }
__device__ __forceinline__ float unmono(unsigned m) { const unsigned u = (m & 0x80000000u) ? (m ^ 0x80000000u) : ~m; return __builtin_bit_cast(float, u); }
#define CE_DESC(a, b) do { const unsigned _x = (a), _y = (b); (a) = _x > _y ? _x : _y; (b) = _x > _y ? _y : _x; } while (0)
#define CE_ASC(a, b)  do { const unsigned _x = (a), _y = (b); (a) = _x > _y ? _y : _x; (b) = _x > _y ? _x : _y; } while (0)
__device__ __forceinline__ void merge16(unsigned (&k)[16], bool desc) {
#pragma unroll
    for (int stride = 8; stride > 0; stride >>= 1)
#pragma unroll
        for (int i = 0; i < 16; ++i) if ((i & stride) == 0) { if (desc) CE_DESC(k[i], k[i + stride]); else CE_ASC(k[i], k[i + stride]); }
}
__device__ __forceinline__ void top16_of_64(unsigned (&k)[64], unsigned (&res)[16]) {
#pragma unroll
    for (int size = 2; size <= 16; size <<= 1)
#pragma unroll
        for (int stride = size >> 1; stride > 0; stride >>= 1)
#pragma unroll
            for (int i = 0; i < 64; ++i) if ((i & stride) == 0) { if ((i & size) == 0) CE_DESC(k[i], k[i + stride]); else CE_ASC(k[i], k[i + stride]); }
    unsigned t0[16], t1[16];
#pragma unroll
    for (int i = 0; i < 16; ++i) { t0[i] = k[i] > k[16 + i] ? k[i] : k[16 + i]; t1[i] = k[32 + i] > k[48 + i] ? k[32 + i] : k[48 + i]; }
    merge16(t0, true); merge16(t1, false);
#pragma unroll
    for (int i = 0; i < 16; ++i) res[i] = t0[i] > t1[i] ? t0[i] : t1[i];
    merge16(res, true);
}
__device__ __forceinline__ void topk_unit(Frame& F, int tile, int h, int layer) {
    const int tid = F.tid, lane = F.lane, wid = F.wave;
    const bf16* PQ = (const bf16*)(F.ws + SP_PQ); const bf16* SK = (const bf16*)(F.ws + WS_SK) + (size_t)((layer * 8 + h) * 2) * 128 * 128;
    LAS float* S = (LAS float*)F.lds;
    const int t0 = tile * 256, fr = lane & 15, fq = lane >> 4;
    unsigned sel[2][16];
#pragma unroll
    for (int p = 0; p < 2; ++p) {
        {
            bf16x8 af[2][4];
#pragma unroll
            for (int mt = 0; mt < 2; ++mt)
#pragma unroll
                for (int ks = 0; ks < 4; ++ks) af[mt][ks] = *(const bf16x8*)(PQ + (size_t)(t0 + 32 * wid + 16 * mt + fr) * PQ_N + h * 256 + p * 128 + 32 * ks + 8 * fq);
            const bf16* SKp = SK + (size_t)p * 128 * 128;
#pragma unroll 2
            for (int nt = 0; nt < 8; ++nt) {
                f32x4 a0 = {0.f, 0.f, 0.f, 0.f}, a1 = {0.f, 0.f, 0.f, 0.f};
#pragma unroll
                for (int ks = 0; ks < 4; ++ks) { const bf16x8 bfr = *(const bf16x8*)(SKp + (size_t)(16 * nt + fr) * 128 + 32 * ks + 8 * fq);
                    a0 = __builtin_amdgcn_mfma_f32_16x16x32_bf16(af[0][ks], bfr, a0, 0, 0, 0); a1 = __builtin_amdgcn_mfma_f32_16x16x32_bf16(af[1][ks], bfr, a1, 0, 0, 0); }
                const int key = 16 * nt + fr, col = key + ((key >> 6) << 2);
#pragma unroll
                for (int r = 0; r < 4; ++r) { S[(32 * wid + 4 * fq + r) * SSTR + col] = a0[r]; S[(32 * wid + 16 + 4 * fq + r) * SSTR + col] = a1[r]; }
            }
        }
        __syncthreads();
        {
            const int row = tid >> 1, kh = tid & 1;
            unsigned k[64];
#pragma unroll
            for (int i = 0; i < 16; ++i) { const f32x4 v = *(const LAS f32x4*)(S + row * SSTR + 68 * kh + 4 * i);
#pragma unroll
                for (int e = 0; e < 4; ++e) k[4 * i + e] = (mono(v[e]) & ~127u) | (unsigned)(127 - (64 * kh + 4 * i + e)); }
            unsigned mine[16];
            top16_of_64(k, mine);
#pragma unroll
            for (int i = 0; i < 16; ++i) { const unsigned other = (unsigned)__shfl_xor((int)mine[15 - i], 1); sel[p][i] = mine[i] > other ? mine[i] : other; }
            merge16(sel[p], true);
        }
        __syncthreads();
    }
    float v1[16], v2[16]; int i1[16], i2[16];
#pragma unroll
    for (int i = 0; i < 16; ++i) { v1[i] = unmono(sel[0][i] & ~127u); i1[i] = 127 - (int)(sel[0][i] & 127u); v2[i] = unmono(sel[1][i] & ~127u); i2[i] = 127 - (int)(sel[1][i] & 127u); }
    unsigned k2[64];
    {
        int n = 0;
#pragma unroll
        for (int i = 0; i < 16; ++i)
#pragma unroll
            for (int j = 0; j < 16; ++j) if ((i + 1) * (j + 1) <= 16) { k2[n] = (mono(v1[i] + v2[j]) & ~255u) | (unsigned)(255 - (i * 16 + j)); ++n; }
#pragma unroll
        for (int q = 50; q < 64; ++q) k2[q] = 0u;
    }
    unsigned top[16];
    top16_of_64(k2, top);
    const int row = tid >> 1, kh = tid & 1;
    const size_t obase = ((size_t)(t0 + row) * 8 + h) * 16;
    if (kh == 0) {
        int* IDS = (int*)(F.ws + WS_IDS) + obase;
#pragma unroll
        for (int q4 = 0; q4 < 4; ++q4) { int ev[4];
#pragma unroll
            for (int e = 0; e < 4; ++e) { const int cid = 255 - (int)(top[4 * q4 + e] & 255u), ci = cid >> 4, cj = cid & 15; int e1 = 0, e2 = 0;
#pragma unroll
                for (int i = 0; i < 16; ++i) { e1 = (ci == i) ? i1[i] : e1; e2 = (cj == i) ? i2[i] : e2; }
                ev[e] = e1 * 128 + e2; }
            *(v4u*)(IDS + 4 * q4) = (v4u){(unsigned)ev[0], (unsigned)ev[1], (unsigned)ev[2], (unsigned)ev[3]}; }
    } else {
        float* GT = (float*)(F.ws + WS_GATE) + obase;
        float cv[16]; float sum = 0.f;
        const float mx = unmono(top[0] & ~255u);
#pragma unroll
        for (int q = 0; q < 16; ++q) { cv[q] = fast_exp2((unmono(top[q] & ~255u) - mx) * LOG2E); sum += cv[q]; }
        const float inv = 1.f / sum;
#pragma unroll
        for (int q4 = 0; q4 < 4; ++q4) *(f32x4*)(GT + 4 * q4) = (f32x4){cv[4 * q4] * inv, cv[4 * q4 + 1] * inv, cv[4 * q4 + 2] * inv, cv[4 * q4 + 3] * inv};
    }
}
__device__ __forceinline__ void topk_phase(Frame& F, int layer) {
    for (int a = F.vcu; a < (NT / 256) * 8; a += F.G) topk_unit(F, a >> 3, a & 7, layer);
}
__device__ __forceinline__ float gelu_tanh(float x) { const float y = 1.5957691216057308f * (x + 0.044715f * x * x * x); return x * fast_rcp(1.f + fast_exp2(-y * LOG2E)); }
__device__ __forceinline__ void experts_phase(Frame& F, int layer) {
    const int lane = F.lane;
    const bf16* UT = (const bf16*)(F.ws + WS_UT) + (size_t)layer * NEXP * DM; const bf16* VT = (const bf16*)(F.ws + WS_VT) + (size_t)layer * NEXP * DM;
    const int* IDS = (const int*)(F.ws + WS_IDS); const float* GT = (const float*)(F.ws + WS_GATE);
    float* XR = F.out;
    const float* gffn = F.in[I_LNFFN] + layer * DM;
    const float* gnext = layer == 0 ? F.in[I_LNMIX] + DM : F.in[I_LNF];
    bf16* HN = (bf16*)(F.ws + WS_HN);
    const int gw = F.vcu * NWAVES + F.wave, NGW = F.G * NWAVES;
    const int d0 = 8 * lane, d1 = 512 + 8 * lane;
    for (int t = gw; t < NT; t += NGW) {
        float x[16], hn[16], acc[16];
        { const f32x4 a = *(const f32x4*)(XR + (size_t)t * DM + d0), b = *(const f32x4*)(XR + (size_t)t * DM + d0 + 4), c = *(const f32x4*)(XR + (size_t)t * DM + d1), d = *(const f32x4*)(XR + (size_t)t * DM + d1 + 4);
          x[0] = a.x; x[1] = a.y; x[2] = a.z; x[3] = a.w; x[4] = b.x; x[5] = b.y; x[6] = b.z; x[7] = b.w; x[8] = c.x; x[9] = c.y; x[10] = c.z; x[11] = c.w; x[12] = d.x; x[13] = d.y; x[14] = d.z; x[15] = d.w; }
        float ss = 0.f;
#pragma unroll
        for (int i = 0; i < 16; ++i) ss += x[i] * x[i];
        const float r = 1.f / sqrtf(wave_sum(ss) * (1.f / DM) + EPS);
#pragma unroll
        for (int i = 0; i < 16; ++i) { hn[i] = x[i] * r * gffn[(i < 8 ? d0 : d1 - 8) + i]; acc[i] = 0.f; }
        const int idv0 = IDS[(size_t)t * 128 + lane], idv1 = IDS[(size_t)t * 128 + 64 + lane];
        const float gv0 = GT[(size_t)t * 128 + lane], gv1 = GT[(size_t)t * 128 + 64 + lane];
#pragma unroll
        for (int half = 0; half < 2; ++half) {
            const int idv = half ? idv1 : idv0; const float gv = half ? gv1 : gv0;
            for (int b8 = 0; b8 < 8; ++b8) {
                int id[8]; float p[8];
#pragma unroll
                for (int e = 0; e < 8; ++e) id[e] = __builtin_amdgcn_readlane(idv, b8 * 8 + e);
                v4u ua[8], ub[8];
#pragma unroll
                for (int e = 0; e < 8; ++e) { const bf16* up = UT + (size_t)id[e] * DM; ua[e] = *(const v4u*)(up + d0); ub[e] = *(const v4u*)(up + d1); }
#pragma unroll
                for (int e = 0; e < 8; ++e) {
                    float s = hn[0] * bf_lo(ua[e].x) + hn[1] * bf_hi(ua[e].x); s += hn[2] * bf_lo(ua[e].y) + hn[3] * bf_hi(ua[e].y); s += hn[4] * bf_lo(ua[e].z) + hn[5] * bf_hi(ua[e].z); s += hn[6] * bf_lo(ua[e].w) + hn[7] * bf_hi(ua[e].w);
                    s += hn[8] * bf_lo(ub[e].x) + hn[9] * bf_hi(ub[e].x); s += hn[10] * bf_lo(ub[e].y) + hn[11] * bf_hi(ub[e].y); s += hn[12] * bf_lo(ub[e].z) + hn[13] * bf_hi(ub[e].z); s += hn[14] * bf_lo(ub[e].w) + hn[15] * bf_hi(ub[e].w);
                    p[e] = s; }
                float w4[4], w2[2], w1;
                { const bool up = (lane & 32) != 0;
#pragma unroll
                  for (int i = 0; i < 4; ++i) { const float keep = up ? p[4 + i] : p[i], send = up ? p[i] : p[4 + i]; w4[i] = keep + __shfl_xor(send, 32); } }
                { const bool up = (lane & 16) != 0;
#pragma unroll
                  for (int i = 0; i < 2; ++i) { const float keep = up ? w4[2 + i] : w4[i], send = up ? w4[i] : w4[2 + i]; w2[i] = keep + __shfl_xor(send, 16); } }
                { const bool up = (lane & 8) != 0; const float keep = up ? w2[1] : w2[0], send = up ? w2[0] : w2[1]; w1 = keep + __shfl_xor(send, 8); }
                w1 += __shfl_xor(w1, 4); w1 += __shfl_xor(w1, 2); w1 += __shfl_xor(w1, 1);
                const float coef = __shfl(gv, b8 * 8 + (lane >> 3)) * gelu_tanh(w1);
#pragma unroll
                for (int e = 0; e < 8; ++e) { const bf16* vp = VT + (size_t)id[e] * DM; ua[e] = *(const v4u*)(vp + d0); ub[e] = *(const v4u*)(vp + d1); }
#pragma unroll
                for (int e = 0; e < 8; ++e) { const float ce = __builtin_bit_cast(float, __builtin_amdgcn_readlane(__builtin_bit_cast(int, coef), 8 * e));
                    acc[0] += ce * bf_lo(ua[e].x); acc[1] += ce * bf_hi(ua[e].x); acc[2] += ce * bf_lo(ua[e].y); acc[3] += ce * bf_hi(ua[e].y); acc[4] += ce * bf_lo(ua[e].z); acc[5] += ce * bf_hi(ua[e].z); acc[6] += ce * bf_lo(ua[e].w); acc[7] += ce * bf_hi(ua[e].w);
                    acc[8] += ce * bf_lo(ub[e].x); acc[9] += ce * bf_hi(ub[e].x); acc[10] += ce * bf_lo(ub[e].y); acc[11] += ce * bf_hi(ub[e].y); acc[12] += ce * bf_lo(ub[e].z); acc[13] += ce * bf_hi(ub[e].z); acc[14] += ce * bf_lo(ub[e].w); acc[15] += ce * bf_hi(ub[e].w); }
            }
        }
        float s2 = 0.f;
#pragma unroll
        for (int i = 0; i < 16; ++i) { x[i] += acc[i]; s2 += x[i] * x[i]; }
        const float r2 = 1.f / sqrtf(wave_sum(s2) * (1.f / DM) + EPS);
        float y[16];
#pragma unroll
        for (int i = 0; i < 16; ++i) y[i] = x[i] * r2 * gnext[(i < 8 ? d0 : d1 - 8) + i];
        if (layer == 0) {
            *(f32x4*)(XR + (size_t)t * DM + d0) = (f32x4){x[0], x[1], x[2], x[3]}; *(f32x4*)(XR + (size_t)t * DM + d0 + 4) = (f32x4){x[4], x[5], x[6], x[7]};
            *(f32x4*)(XR + (size_t)t * DM + d1) = (f32x4){x[8], x[9], x[10], x[11]}; *(f32x4*)(XR + (size_t)t * DM + d1 + 4) = (f32x4){x[12], x[13], x[14], x[15]};
            *(v4u*)(HN + (size_t)t * DM + d0) = (v4u){pk2(y[0], y[1]), pk2(y[2], y[3]), pk2(y[4], y[5]), pk2(y[6], y[7])};
            *(v4u*)(HN + (size_t)t * DM + d1) = (v4u){pk2(y[8], y[9]), pk2(y[10], y[11]), pk2(y[12], y[13]), pk2(y[14], y[15])};
        } else {
            *(f32x4*)(XR + (size_t)t * DM + d0) = (f32x4){y[0], y[1], y[2], y[3]}; *(f32x4*)(XR + (size_t)t * DM + d0 + 4) = (f32x4){y[4], y[5], y[6], y[7]};
            *(f32x4*)(XR + (size_t)t * DM + d1) = (f32x4){y[8], y[9], y[10], y[11]}; *(f32x4*)(XR + (size_t)t * DM + d1 + 4) = (f32x4){y[12], y[13], y[14], y[15]};
        }
    }
}
}

namespace gla {
__device__ __forceinline__ void prep_unit(Frame& F, int item) {
    const int tid = F.tid, bh = item >> 7, chunk = item & 127, b = bh >> 2, h = bh & 3;
    const int t0 = b * SEQ + 64 * chunk;
    bf16* KG = (bf16*)(F.ws + S1_K); bf16* VG = (bf16*)(F.ws + S1_V); const float* ZG = (const float*)(F.ws + S1_Z);
    float* DEC = (float*)(F.ws + WS_DEC);
    LAS float* TOT = (LAS float*)F.lds;
    LAS bf16* VL = (LAS bf16*)(F.lds + 4096);
    const int dk = tid & 127, seg = tid >> 7;
    float w2r[16];
#pragma unroll
    for (int j = 0; j < 16; ++j) w2r[j] = F.in[I_WG2][j * 512 + h * 128 + dk];
    const float b2 = F.in[I_BG2][h * 128 + dk];
    float cum[16], kv[16]; float run = 0.f;
#pragma unroll
    for (int j = 0; j < 16; ++j) { const int s = 16 * seg + j; const float* zp = ZG + (size_t)(t0 + s) * 16;
        const f32x4 z0 = *(const f32x4*)zp, z1 = *(const f32x4*)(zp + 4), z2 = *(const f32x4*)(zp + 8), z3 = *(const f32x4*)(zp + 12);
        float xg = b2 + z0.x * w2r[0] + z0.y * w2r[1] + z0.z * w2r[2] + z0.w * w2r[3] + z1.x * w2r[4] + z1.y * w2r[5] + z1.z * w2r[6] + z1.w * w2r[7]
                      + z2.x * w2r[8] + z2.y * w2r[9] + z2.z * w2r[10] + z2.w * w2r[11] + z3.x * w2r[12] + z3.y * w2r[13] + z3.z * w2r[14] + z3.w * w2r[15];
        const float la = (fminf(xg, 0.f) - log1pf(expf(-fabsf(xg)))) * (1.f / 16.f);
        run += la; cum[j] = run; kv[j] = bf2f(KG[(size_t)(t0 + s) * 512 + h * 128 + dk]); }
    TOT[seg * 128 + dk] = run;
#pragma unroll
    for (int i = 0; i < 4; ++i) { const int q = tid + 512 * i, s = q >> 5, cc = q & 31; const v4u v = *(const v4u*)(VG + (size_t)(t0 + s) * 1024 + h * 256 + 8 * cc);
        *(LAS v2u*)(VL + s * 264 + 8 * cc) = (v2u){v.x, v.y}; *(LAS v2u*)(VL + s * 264 + 8 * cc + 4) = (v2u){v.z, v.w}; }
    __syncthreads();
    float off = 0.f, total = 0.f;
#pragma unroll
    for (int g = 0; g < 4; ++g) { const float tg = TOT[g * 128 + dk]; total += tg; if (g < seg) off += tg; }
    unsigned pk[8];
#pragma unroll
    for (int j = 0; j < 16; j += 2) pk[j >> 1] = pk2(kv[j] * expf(total - (off + cum[j])), kv[j + 1] * expf(total - (off + cum[j + 1])));
    bf16* kd = KG + (size_t)(t0 + (dk >> 1)) * 512 + h * 128 + (dk & 1) * 64 + 16 * seg;
    *(v4u*)kd = (v4u){pk[0], pk[1], pk[2], pk[3]}; *(v4u*)(kd + 8) = (v4u){pk[4], pk[5], pk[6], pk[7]};
    if (seg == 0) DEC[(size_t)item * 128 + dk] = expf(total);
#pragma unroll
    for (int i = 0; i < 4; ++i) { const int o = tid + 512 * i, dv = o >> 3, sb = o & 7; unsigned w[4];
#pragma unroll
        for (int j = 0; j < 4; ++j) w[j] = (unsigned)VL[(8 * sb + 2 * j) * 264 + dv] | ((unsigned)VL[(8 * sb + 2 * j + 1) * 264 + dv] << 16);
        *(v4u*)(VG + (size_t)(t0 + (dv >> 2)) * 1024 + h * 256 + (dv & 3) * 64 + 8 * sb) = (v4u){w[0], w[1], w[2], w[3]}; }
    __syncthreads();
}
__device__ __forceinline__ int crow(int r, int hi) { return (r & 3) + 8 * (r >> 2) + 4 * hi; }
__device__ __forceinline__ void scan_task(Frame& F, int bh, int w) {
    const int lane = F.lane, r32 = lane & 31, hi = lane >> 5, b = bh >> 2, h = bh & 3;
    const bf16* QG = (const bf16*)(F.ws + S1_Q); const bf16* KG = (const bf16*)(F.ws + S1_K); const bf16* VG = (const bf16*)(F.ws + S1_V);
    const float* DEC = (const float*)(F.ws + WS_DEC); bf16* OUT = (bf16*)(F.ws + WS_HN);
    f32x16 st[4];
#pragma unroll
    for (int d = 0; d < 4; ++d)
#pragma unroll
        for (int r = 0; r < 16; ++r) st[d][r] = 0.f;
    const unsigned lv = (unsigned)((r32 >> 2) * 1024 + (r32 & 3) * 64 + 8 * hi);
    const unsigned lk = (unsigned)((r32 >> 1) * 512 + (r32 & 1) * 64 + 8 * hi);
    const unsigned lq = (unsigned)(r32 * 512 + 4 * hi);
    const unsigned lo = (unsigned)(4 * hi * 1024 + r32);
    const unsigned ld = (unsigned)(4 * hi);
#pragma unroll 1
    for (int chunk = 0; chunk < 128; ++chunk) {
        const int t0 = b * SEQ + 64 * chunk;
        const bf16* vb = VG + (size_t)(t0 + 8 * w) * 1024 + h * 256;
        const bf16* kb = KG + (size_t)t0 * 512 + h * 128;
        const bf16* qb = QG + (size_t)t0 * 512 + h * 128;
        bf16* ob = OUT + (size_t)t0 * 1024 + h * 256 + 32 * w;
        const float* dc = DEC + (size_t)(bh * 128 + chunk) * 128;
        bf16x8 bu[4];
#pragma unroll
        for (int ks = 0; ks < 4; ++ks) bu[ks] = *(const bf16x8*)(vb + 16 * ks + lv);
#pragma unroll
        for (int db = 0; db < 4; ++db) {
            bf16x8 au[4];
#pragma unroll
            for (int ks = 0; ks < 4; ++ks) au[ks] = *(const bf16x8*)(kb + (size_t)(16 * db) * 512 + 16 * ks + lk);
#pragma unroll
            for (int rg = 0; rg < 4; ++rg) { const f32x4 d4 = *(const f32x4*)(dc + 32 * db + 8 * rg + ld);
                st[db][4 * rg] *= d4.x; st[db][4 * rg + 1] *= d4.y; st[db][4 * rg + 2] *= d4.z; st[db][4 * rg + 3] *= d4.w; }
#pragma unroll
            for (int ks = 0; ks < 4; ++ks) st[db] = __builtin_amdgcn_mfma_f32_32x32x16_bf16(au[ks], bu[ks], st[db], 0, 0, 0);
            asm volatile("" ::: "memory");
        }
#pragma unroll
        for (int sb = 0; sb < 2; ++sb) {
            f32x16 oa;
#pragma unroll
            for (int r = 0; r < 16; ++r) oa[r] = 0.f;
#pragma unroll
            for (int db = 0; db < 4; ++db)
#pragma unroll
                for (int hs = 0; hs < 2; ++hs) {
                    const bf16* qp = qb + (size_t)(32 * sb) * 512 + 32 * db + 16 * hs;
                    const v2u qa = *(const v2u*)(qp + lq), qc = *(const v2u*)(qp + 8 + lq);
                    const v4u aw = {qa.x, qa.y, qc.x, qc.y};
                    const v4u bw = {pk2(st[db][8 * hs], st[db][8 * hs + 1]), pk2(st[db][8 * hs + 2], st[db][8 * hs + 3]), pk2(st[db][8 * hs + 4], st[db][8 * hs + 5]), pk2(st[db][8 * hs + 6], st[db][8 * hs + 7])};
                    oa = __builtin_amdgcn_mfma_f32_32x32x16_bf16(__builtin_bit_cast(bf16x8, aw), __builtin_bit_cast(bf16x8, bw), oa, 0, 0, 0);
                }
#pragma unroll
            for (int r = 0; r < 16; ++r) ob[(size_t)(32 * sb + (r & 3) + 8 * (r >> 2)) * 1024 + lo] = f2bf(oa[r]);
            asm volatile("" ::: "memory");
        }
    }
}
__device__ __forceinline__ void scan_phase(Frame& F) {
    if (F.wave == 0) {
        int a = (F.G == 256) ? (((F.vcu & 31) < 16) ? ((F.vcu >> 5) * 16 + (F.vcu & 31)) : 128) : F.vcu;
        const int stride = (F.G == 256) ? 128 : F.G;
#pragma unroll 1
        for (; a < 128; a += stride) scan_task(F, a >> 3, a & 7);
    }
}
__device__ __forceinline__ void post_phase(Frame& F) {
    const int lane = F.lane; bf16* OUT = (bf16*)(F.ws + WS_HN); const bf16* GG = (const bf16*)(F.ws + S1_G);
    const float* gn = F.in[I_GLAG] + (lane & 15) * 16;
    float g[16];
#pragma unroll
    for (int i = 0; i < 16; ++i) g[i] = gn[i];
    const int gw = F.vcu * NWAVES + F.wave, NGW = F.G * NWAVES;
    for (int t = gw; t < NT; t += NGW) {
        const v4u o0 = *(const v4u*)(OUT + (size_t)t * 1024 + 16 * lane), o1 = *(const v4u*)(OUT + (size_t)t * 1024 + 16 * lane + 8);
        const v4u g0 = *(const v4u*)(GG + (size_t)t * 1024 + 16 * lane), g1 = *(const v4u*)(GG + (size_t)t * 1024 + 16 * lane + 8);
        float o[16], sg[16];
        o[0] = bf_lo(o0.x); o[1] = bf_hi(o0.x); o[2] = bf_lo(o0.y); o[3] = bf_hi(o0.y); o[4] = bf_lo(o0.z); o[5] = bf_hi(o0.z); o[6] = bf_lo(o0.w); o[7] = bf_hi(o0.w);
        o[8] = bf_lo(o1.x); o[9] = bf_hi(o1.x); o[10] = bf_lo(o1.y); o[11] = bf_hi(o1.y); o[12] = bf_lo(o1.z); o[13] = bf_hi(o1.z); o[14] = bf_lo(o1.w); o[15] = bf_hi(o1.w);
        sg[0] = bf_lo(g0.x); sg[1] = bf_hi(g0.x); sg[2] = bf_lo(g0.y); sg[3] = bf_hi(g0.y); sg[4] = bf_lo(g0.z); sg[5] = bf_hi(g0.z); sg[6] = bf_lo(g0.w); sg[7] = bf_hi(g0.w);
        sg[8] = bf_lo(g1.x); sg[9] = bf_hi(g1.x); sg[10] = bf_lo(g1.y); sg[11] = bf_hi(g1.y); sg[12] = bf_lo(g1.z); sg[13] = bf_hi(g1.z); sg[14] = bf_lo(g1.w); sg[15] = bf_hi(g1.w);
        float ss = 0.f;
#pragma unroll
        for (int i = 0; i < 16; ++i) ss += o[i] * o[i];
        ss += __shfl_xor(ss, 1); ss += __shfl_xor(ss, 2); ss += __shfl_xor(ss, 4); ss += __shfl_xor(ss, 8);
        const float rs = 1.f / sqrtf(ss * (1.f / 256.f) + EPS);
        float y[16];
#pragma unroll
        for (int i = 0; i < 16; ++i) y[i] = o[i] * rs * g[i] * sg[i];
        *(v4u*)(OUT + (size_t)t * 1024 + 16 * lane) = (v4u){pk2(y[0], y[1]), pk2(y[2], y[3]), pk2(y[4], y[5]), pk2(y[6], y[7])};
        *(v4u*)(OUT + (size_t)t * 1024 + 16 * lane + 8) = (v4u){pk2(y[8], y[9]), pk2(y[10], y[11]), pk2(y[12], y[13]), pk2(y[14], y[15])};
    }
}
}

constexpr int CW_BAR = 4096;
constexpr int N_PHASES = 15;
struct Args { const float* in[25]; float* out; unsigned char* ws; int ph_lo, ph_hi; };
__global__ void __launch_bounds__(NTHREADS, 2) fwd_kernel(Args args) {
    extern __shared__ __attribute__((aligned(16))) unsigned char lds_raw[];
    Frame F;
    F.lds = (LAS unsigned char*)lds_raw;
    F.MISC = (volatile LAS unsigned*)(F.lds + MISC_OFF);
    F.tid = threadIdx.x; F.lane = F.tid & 63; F.wave = __builtin_amdgcn_readfirstlane(F.tid >> 6);
    F.G = gridDim.x; { const int bx = blockIdx.x; F.vcu = (F.G % 8 == 0) ? (bx % 8) * (F.G / 8) + bx / 8 : bx; }
    F.in = (const float* const __attribute__((address_space(4)))*)__builtin_amdgcn_kernarg_segment_ptr();
    F.out = args.out; F.ws = args.ws; F.ctl = (unsigned*)(args.ws + WS_CTL);
    if (F.tid < 64) ((LAS unsigned*)(F.lds + MISC_OFF))[F.tid] = 0u;
    __syncthreads();
    const int lo = args.ph_lo, hi = args.ph_hi;
    const bool multi = (hi - lo) > 1;
    XcdBarrier bar; bar.bar = F.ctl + CW_BAR; bar.x = 0; bar.st = nullptr;
    if (multi) bar = xcd_barrier_post(F.ctl + CW_BAR, F.MISC + 8);
#ifndef PH_MASK
#define PH_MASK 0x7fff
#endif
#define IN(k) ((((PH_MASK) >> (k)) & 1) && lo <= (k) && (k) < hi)
#define SEAM(k) do { if (IN((k) + 1)) xcd_barrier(bar); } while (0)
    bf16* HN = (bf16*)(F.ws + WS_HN);
    if (IN(0)) { p0_prologue(F); SEAM(0); }
    if (IN(1)) { pg8::Gemm g{HN, (const bf16*)(F.ws + WS_WIN0), NT, EVEN_IN, DM}; pg8::StaticOrder S; S.init(NT, EVEN_IN, F.G, (int)blockIdx.x);
        EpiIn0 E{(bf16*)(F.ws + S0_Q), (bf16*)(F.ws + S0_K), (bf16*)(F.ws + S0_VT), (bf16*)(F.ws + S0_GLU)};
        pg8::gemm_phase<EpiIn0, pg8::StaticOrder, true, true>(F.lds, g, S, E); SEAM(1); }
    if (IN(2)) { att::p2_attn_conv(F); SEAM(2); }
    if (IN(3)) { pg8::Gemm g{(const bf16*)(F.ws + S0_CAT), (const bf16*)(F.ws + WS_WOUT0), NT, DM, DM}; pg8::StaticOrder S; S.init(NT, DM, F.G, (int)blockIdx.x);
        EpiRes E{F.in[I_X], F.out, HN, (float*)(F.ws + WS_ROWSQ0)};
        pg8::gemm_phase<EpiRes, pg8::StaticOrder, true, true>(F.lds, g, S, E); SEAM(3); }
    if (IN(4)) { pg8::Gemm g{HN, (const bf16*)(F.ws + WS_WQ0), NT, PQ_N, DM}; pg8::StaticOrder S; S.init(NT, PQ_N, F.G, (int)blockIdx.x);
        EpiPq E{(bf16*)(F.ws + SP_PQ), (const float*)(F.ws + WS_ROWSQ0)};
        pg8::gemm_phase<EpiPq, pg8::StaticOrder, true, true>(F.lds, g, S, E); SEAM(4); }
    if (IN(5)) { peer::topk_phase(F, 0); SEAM(5); }
    if (IN(6)) { peer::experts_phase(F, 0); SEAM(6); }
    if (IN(7)) { pg8::Gemm g{HN, (const bf16*)(F.ws + WS_WIN1), NT, ODD_IN_PAD, DM}; pg8::StaticOrder S; S.init(NT, ODD_IN_PAD, F.G, (int)blockIdx.x);
        EpiIn1 E{(bf16*)(F.ws + S1_Q), (bf16*)(F.ws + S1_K), (bf16*)(F.ws + S1_V), (bf16*)(F.ws + S1_G), (float*)(F.ws + S1_Z)};
        pg8::gemm_phase<EpiIn1, pg8::StaticOrder, true, true>(F.lds, g, S, E); SEAM(7); }
    if (IN(8)) { for (int a = F.vcu; a < 2048; a += F.G) gla::prep_unit(F, a); SEAM(8); }
    if (IN(9)) { gla::scan_phase(F); SEAM(9); }
    if (IN(10)) { gla::post_phase(F); SEAM(10); }
    if (IN(11)) { pg8::Gemm g{HN, (const bf16*)(F.ws + WS_WOUT1), NT, DM, DM}; pg8::StaticOrder S; S.init(NT, DM, F.G, (int)blockIdx.x);
        EpiRes E{F.out, F.out, (bf16*)(F.ws + S1_G), (float*)(F.ws + WS_ROWSQ1)};
        pg8::gemm_phase<EpiRes, pg8::StaticOrder, true, true>(F.lds, g, S, E); SEAM(11); }
    if (IN(12)) { pg8::Gemm g{(const bf16*)(F.ws + S1_G), (const bf16*)(F.ws + WS_WQ1), NT, PQ_N, DM}; pg8::StaticOrder S; S.init(NT, PQ_N, F.G, (int)blockIdx.x);
        EpiPq E{(bf16*)(F.ws + SP_PQ), (const float*)(F.ws + WS_ROWSQ1)};
        pg8::gemm_phase<EpiPq, pg8::StaticOrder, true, true>(F.lds, g, S, E); SEAM(12); }
    if (IN(13)) { peer::topk_phase(F, 1); SEAM(13); }
    if (IN(14)) { peer::experts_phase(F, 1); }
#undef IN
#undef SEAM
}

#ifndef N_LAUNCH_SPLIT
#define N_LAUNCH_SPLIT 0
#endif
extern "C" void kernel_launch(void* const* d_in, const int* in_sizes, int n_in, void* d_out, int out_size, void* d_ws, size_t ws_size, hipStream_t stream) {
    static int grid = 0;
    if (grid == 0) {
        if (n_in != 25 || out_size != NT * DM || ws_size < WS_END) { fprintf(stderr, "kernel_launch: unexpected shapes (n_in %d out %d ws %zu)\n", n_in, out_size, ws_size); grid = -1; return; }
        int dev = 0, cus = 0;
        if (hipGetDevice(&dev) != hipSuccess || hipDeviceGetAttribute(&cus, hipDeviceAttributeMultiprocessorCount, dev) != hipSuccess) { grid = -1; return; }
        if (hipFuncSetAttribute((const void*)fwd_kernel, hipFuncAttributeMaxDynamicSharedMemorySize, LDS_BYTES) != hipSuccess) { fprintf(stderr, "kernel_launch: hipFuncSetAttribute failed\n"); grid = -1; return; }
        int per_cu = 0;
        if (hipOccupancyMaxActiveBlocksPerMultiprocessor(&per_cu, (const void*)fwd_kernel, NTHREADS, LDS_BYTES) != hipSuccess || per_cu < 1) fprintf(stderr, "kernel_launch: occupancy query says %d\n", per_cu);
        (void)hipGetLastError();
        grid = cus;
    }
    if (grid < 0) return;
    (void)hipMemsetAsync((char*)d_ws + WS_CTL, 0, CTL_ZERO_BYTES, stream);
    Args a{};
    for (int i = 0; i < 25; ++i) a.in[i] = (const float*)d_in[i];
    a.out = (float*)d_out; a.ws = (unsigned char*)d_ws;
#if N_LAUNCH_SPLIT
    for (int p = 0; p < N_PHASES; ++p) { a.ph_lo = p; a.ph_hi = p + 1; hipLaunchKernelGGL(fwd_kernel, dim3(grid), dim3(NTHREADS), LDS_BYTES, stream, a); }
#else
    a.ph_lo = 0; a.ph_hi = N_PHASES; hipLaunchKernelGGL(fwd_kernel, dim3(grid), dim3(NTHREADS), LDS_BYTES, stream, a);
#endif
}
```

```cpp
#include <hip/hip_runtime.h>
#include <cstdio>
#include <cstdint>
namespace pg8 {
#define PG8_LAS __attribute__((address_space(3)))
typedef unsigned short bf16_t;
typedef short bf16x8 __attribute__((ext_vector_type(8)));
typedef float f32x4 __attribute__((ext_vector_type(4)));
typedef unsigned u32x4 __attribute__((ext_vector_type(4)));
constexpr int BM = 256, BK = 64, HALF = 128, HTB = HALF * BK * 2  , STAGE_BYTES = 8 * HTB, NXCD = 8, WGM = 8;

__host__ __device__ __forceinline__ int lds_byte(int r, int c) { const int st = (r >> 4) * 2 + (c >> 5), rr = r & 15, cc = c & 31, ob = rr * 64 + cc * 2; return st * 1024 + (ob ^ (((ob >> 9) & 1) << 5)); }
__host__ __device__ __forceinline__ void stage_rc(int b, int& R, int& C) { const int st = b / 1024, sb = b % 1024, swz = sb ^ (((sb >> 9) & 1) << 5); R = (st >> 1) * 16 + swz / 64; C = (st & 1) * 32 + (swz % 64) / 2; }
__host__ __device__ __forceinline__ int perm32(int rho) { const int n = rho >> 4, i = rho & 15; return 8 * (i >> 2) + 4 * n + (i & 3); }

struct Unit { int pm, pn; };
struct Gemm { const bf16_t* A; const bf16_t* Bt; int M, N, K; };

struct StaticOrder {
    int nM, nN, nwg, G, c;
    __host__ __device__ void init(int M, int N, int G_, int c_) { nM = M / BM; nN = N / BM; nwg = nM * nN; G = G_; c = c_; }
    __host__ __device__ bool next(int i, Unit& u) const {
        const long L = (long)i * G + c; if (L >= nwg) return false;
        int wgid = (int)L; { const int q = nwg / NXCD, r = nwg % NXCD, xcd = wgid % NXCD, off = wgid / NXCD; wgid = (xcd < r ? xcd * (q + 1) : r * (q + 1) + (xcd - r) * q) + off; }
        const int nig = WGM * nN, gid = wgid / nig, fm = gid * WGM, gsz = (nM - fm) < WGM ? (nM - fm) : WGM;
        u.pm = fm + ((wgid % nig) % gsz); u.pn = (wgid % nig) / gsz; return true;
    }
    __device__ __forceinline__ void a_ready(const Unit&) const {}
    __device__ __forceinline__ void done(const Unit&) const {}
};
__device__ __forceinline__ unsigned cvt_pk_bf16(float lo, float hi) { unsigned r; asm volatile("v_cvt_pk_bf16_f32 %0, %1, %2" : "=v"(r) : "v"(lo), "v"(hi)); return r; }
template <class Epi, class Sched, bool ALIGN_EPI = false, bool SP2 = false>
__device__ __forceinline__ void gemm_phase(PG8_LAS unsigned char* lds, const Gemm g, const Sched& S, const Epi& E) {
    const int tid = threadIdx.x, wid = __builtin_amdgcn_readfirstlane(tid >> 6), lane = tid & 63, wr = wid >> 2, wc = wid & 3, fr = lane & 15, fq = lane >> 4;
    const int K = g.K, nt = K / BK;
    unsigned voffA[2], voffB[2];
#pragma unroll
    for (int i = 0; i < 2; ++i) { int R, C; stage_rc(tid * 16 + i * 8192, R, C); const int Rb = Epi::PERM ? ((R & ~31) + perm32(R & 31)) : R;
        voffA[i] = (unsigned)(R * K + C) * 2u; voffB[i] = (unsigned)(Rb * K + C) * 2u; }
    const size_t kstep = (size_t)(BK * 2);
    const size_t hstep = (size_t)HALF * K * 2;
    const size_t tstep = 2 * hstep;
    const unsigned ldsw = (unsigned)wid * 1024u;
    const int aoff = lds_byte(wr * 64 + fr, fq * 8), boff = lds_byte(wc * 32 + fr, fq * 8);
#define PG8_SA(b, h) (((b) * 2 + (h)) * HTB)
#define PG8_SB(b, h) ((4 + (b) * 2 + (h)) * HTB)
#define PG8_STAGE(bufoff, gbase, voff) do { _Pragma("unroll") for (int _i = 0; _i < 2; ++_i) \
        __builtin_amdgcn_global_load_lds((const unsigned*)((const char*)(gbase) + (voff)[_i]), (PG8_LAS unsigned*)(lds + (bufoff) + ldsw + _i * 8192), 16, 0, 0); } while (0)
#define PG8_LDA(dst, b, h) do { _Pragma("unroll") for (int m = 0; m < 4; ++m) _Pragma("unroll") for (int k = 0; k < 2; ++k) dst[m][k] = *(const PG8_LAS bf16x8*)(lds + PG8_SA(b, h) + aoff + m * 2048 + k * 1024); } while (0)
#define PG8_LDB(dst, b, h) do { _Pragma("unroll") for (int n = 0; n < 2; ++n) _Pragma("unroll") for (int k = 0; k < 2; ++k) dst[n][k] = *(const PG8_LAS bf16x8*)(lds + PG8_SB(b, h) + boff + n * 2048 + k * 1024); } while (0)
#define PG8_MMA(ai, bj, At, Bt) do { __builtin_amdgcn_s_setprio(1); _Pragma("unroll") for (int m = 0; m < 4; ++m) _Pragma("unroll") for (int n = 0; n < 2; ++n) _Pragma("unroll") for (int k = 0; k < 2; ++k) \
        acc[ai][bj][m][n] = __builtin_amdgcn_mfma_f32_16x16x32_bf16(Bt[n][k], At[m][k], acc[ai][bj][m][n], 0, 0, 0); __builtin_amdgcn_s_setprio(0); } while (0)
#define PG8_WAIT_V(n) asm volatile("s_waitcnt vmcnt(" #n ")" ::: "memory")
#define PG8_WAIT_L(n) asm volatile("s_waitcnt lgkmcnt(" #n ")" ::: "memory")
#define PG8_BAR __builtin_amdgcn_s_barrier()
#define PG8_SCHED __builtin_amdgcn_sched_barrier(0)
    Unit cur, nxt; int ui = 0;
    if (!S.next(0, cur)) return;
    f32x4 acc[2][2][4][2];
#pragma unroll
    for (int a = 0; a < 2; ++a)
#pragma unroll
        for (int b = 0; b < 2; ++b)
#pragma unroll
            for (int m = 0; m < 4; ++m)
#pragma unroll
                for (int n = 0; n < 2; ++n) acc[a][b][m][n] = (f32x4){0.f, 0.f, 0.f, 0.f};
    bf16x8 At[4][2], B0[2][2], B1[2][2];
    const char* cA = (const char*)g.A + (size_t)cur.pm * tstep; const char* cB = (const char*)g.Bt + (size_t)cur.pn * tstep;
    S.a_ready(cur);
    if constexpr (SP2) {
        PG8_STAGE(PG8_SB(0, 0), cB, voffB); PG8_STAGE(PG8_SB(0, 1), cB + hstep, voffB); PG8_STAGE(PG8_SA(0, 0), cA, voffA); PG8_STAGE(PG8_SA(0, 1), cA + hstep, voffA);
        if (wr == 1) PG8_BAR;
        PG8_WAIT_V(2); PG8_BAR;
        PG8_STAGE(PG8_SB(1, 0), cB + kstep, voffB); PG8_STAGE(PG8_SA(1, 0), cA + kstep, voffA); PG8_STAGE(PG8_SB(1, 1), cB + hstep + kstep, voffB);
        PG8_WAIT_V(6); PG8_BAR;
    } else {
        PG8_STAGE(PG8_SB(0, 0), cB, voffB); PG8_STAGE(PG8_SA(0, 0), cA, voffA); PG8_STAGE(PG8_SB(0, 1), cB + hstep, voffB); PG8_STAGE(PG8_SA(0, 1), cA + hstep, voffA);
        if (wr == 1) PG8_BAR;
        PG8_WAIT_V(4); PG8_BAR;
        PG8_STAGE(PG8_SB(1, 0), cB + kstep, voffB); PG8_STAGE(PG8_SA(1, 0), cA + kstep, voffA); PG8_STAGE(PG8_SB(1, 1), cB + hstep + kstep, voffB);
        PG8_WAIT_V(6); PG8_BAR;
    }
    for (;;) {
        const bool has_next = S.next(ui + 1, nxt);
        const char* nA = has_next ? (const char*)g.A + (size_t)nxt.pm * tstep : cA; const char* nB = has_next ? (const char*)g.Bt + (size_t)nxt.pn * tstep : cB;
        for (int t = 0; t < nt; t += 2) {
            const bool last = (t == nt - 2);
            const char* a1 = cA + (size_t)(t + 1) * kstep;
            const char* a2 = last ? nA : cA + (size_t)(t + 2) * kstep; const char* b2 = last ? nB : cB + (size_t)(t + 2) * kstep;
            const char* a3 = a2 + kstep; const char* b3 = b2 + kstep;
            if (last && has_next) S.a_ready(nxt);
            if constexpr (SP2) {
            PG8_LDB(B0, 0, 0); PG8_LDB(B1, 0, 1); PG8_SCHED; PG8_LDA(At, 0, 0); PG8_STAGE(PG8_SA(1, 1), a1 + hstep, voffA);
            PG8_WAIT_V(8); PG8_WAIT_L(0); PG8_BAR; PG8_MMA(0, 0, At, B0); PG8_MMA(0, 1, At, B1); PG8_BAR; PG8_SCHED;
            PG8_LDA(At, 0, 1); PG8_STAGE(PG8_SB(0, 0), b2, voffB); PG8_STAGE(PG8_SB(0, 1), b2 + hstep, voffB); PG8_STAGE(PG8_SA(0, 0), a2, voffA);
            PG8_WAIT_V(8); PG8_WAIT_L(0); PG8_BAR; PG8_MMA(1, 0, At, B0); PG8_MMA(1, 1, At, B1); PG8_BAR; PG8_SCHED;
            PG8_LDB(B0, 1, 0); PG8_LDB(B1, 1, 1); PG8_SCHED; PG8_LDA(At, 1, 0); PG8_STAGE(PG8_SA(0, 1), a2 + hstep, voffA);
            PG8_WAIT_V(8); PG8_WAIT_L(0); PG8_BAR; PG8_MMA(0, 0, At, B0); PG8_MMA(0, 1, At, B1); PG8_BAR; PG8_SCHED;
            PG8_LDA(At, 1, 1); PG8_STAGE(PG8_SB(1, 0), b3, voffB); PG8_STAGE(PG8_SB(1, 1), b3 + hstep, voffB); PG8_STAGE(PG8_SA(1, 0), a3, voffA);
            PG8_WAIT_V(8); PG8_WAIT_L(0); PG8_BAR; PG8_MMA(1, 0, At, B0); PG8_MMA(1, 1, At, B1); PG8_BAR; PG8_SCHED;
            } else {
            PG8_LDB(B0, 0, 0); PG8_SCHED; PG8_LDA(At, 0, 0); PG8_STAGE(PG8_SA(1, 1), a1 + hstep, voffA);
            PG8_WAIT_L(8); PG8_BAR; PG8_WAIT_L(0); PG8_MMA(0, 0, At, B0); PG8_BAR; PG8_SCHED;
            PG8_LDB(B1, 0, 1); PG8_STAGE(PG8_SB(0, 0), b2, voffB);
            PG8_BAR; PG8_WAIT_L(0); PG8_MMA(0, 1, At, B1); PG8_BAR;
            PG8_LDA(At, 0, 1); PG8_STAGE(PG8_SA(0, 0), a2, voffA);
            PG8_BAR; PG8_WAIT_L(0); PG8_MMA(1, 0, At, B0); PG8_BAR; PG8_SCHED;
            PG8_STAGE(PG8_SB(0, 1), b2 + hstep, voffB);
            PG8_WAIT_V(6); PG8_BAR; PG8_MMA(1, 1, At, B1); PG8_BAR;
            PG8_LDB(B0, 1, 0); PG8_SCHED; PG8_LDA(At, 1, 0); PG8_STAGE(PG8_SA(0, 1), a2 + hstep, voffA);
            PG8_WAIT_L(8); PG8_BAR; PG8_WAIT_L(0); PG8_MMA(0, 0, At, B0); PG8_BAR; PG8_SCHED;
            PG8_LDB(B1, 1, 1); PG8_STAGE(PG8_SB(1, 0), b3, voffB);
            PG8_BAR; PG8_WAIT_L(0); PG8_MMA(0, 1, At, B1); PG8_BAR;
            PG8_LDA(At, 1, 1); PG8_STAGE(PG8_SA(1, 0), a3, voffA);
            PG8_BAR; PG8_WAIT_L(0); PG8_MMA(1, 0, At, B0); PG8_BAR; PG8_SCHED;
            PG8_STAGE(PG8_SB(1, 1), b3 + hstep, voffB);
            PG8_WAIT_V(6); PG8_BAR; PG8_MMA(1, 1, At, B1); PG8_BAR;
            }
        }
        if constexpr (ALIGN_EPI) { if (wr == 0) PG8_BAR; }
        if constexpr (!Epi::AFTER_DRAIN) { E(acc, cur, wr, wc, fr, fq); S.done(cur); }
        if (!has_next) break;
#pragma unroll
        for (int a = 0; a < 2; ++a)
#pragma unroll
            for (int b = 0; b < 2; ++b)
#pragma unroll
                for (int m = 0; m < 4; ++m)
#pragma unroll
                    for (int n = 0; n < 2; ++n) acc[a][b][m][n] = (f32x4){0.f, 0.f, 0.f, 0.f};
        cur = nxt; cA = nA; cB = nB; ++ui;
        if constexpr (ALIGN_EPI) { if (wr == 1) PG8_BAR; }
    }
    PG8_WAIT_V(0);
    if constexpr (!ALIGN_EPI) { if (wr == 0) PG8_BAR; }
    PG8_BAR;
    if constexpr (Epi::AFTER_DRAIN) { E.fused(acc, cur, wr, wc, fr, fq, lds, wid, lane); S.done(cur); }
#undef PG8_SA
#undef PG8_SB
#undef PG8_STAGE
#undef PG8_LDA
#undef PG8_LDB
#undef PG8_MMA
#undef PG8_WAIT_V
#undef PG8_WAIT_L
#undef PG8_BAR
#undef PG8_SCHED
}
}

constexpr int NB = 4, SEQ = 8192, DM = 1024, NT = NB * SEQ;
constexpr int EVEN_IN = 2560, ODD_IN = 3088, ODD_IN_PAD = 3328, PQ_N = 2048;
constexpr int NEXP = 16384;
constexpr float EPS = 1e-6f;
constexpr float LOG2E = 1.4426950408889634f;
constexpr float QSCALE_ATT = 0.125f * LOG2E;
constexpr float QSCALE_GLA = 0.08838834764831845f;
constexpr float LAM_INIT0 = 0.2f;
constexpr float U_SCALE = 1024.f, V_SCALE = 128.f;

constexpr size_t MiB = 1u << 20;
constexpr size_t WS_CTL = 0, CTL_ZERO_BYTES = 1 * MiB;
constexpr size_t WS_ROWSQ0 = 27 * MiB, WS_ROWSQ1 = 29 * MiB;
constexpr size_t WS_DEC = 1 * MiB;
constexpr size_t WS_WIN0 = 2 * MiB, WS_WOUT0 = 7 * MiB, WS_WIN1 = 9 * MiB, WS_WOUT1 = 16 * MiB, WS_WQ0 = 18 * MiB, WS_WQ1 = 22 * MiB, WS_SK = 26 * MiB;
constexpr size_t WS_UT = 32 * MiB, WS_VT = 96 * MiB;
constexpr size_t WS_HN = 160 * MiB;
constexpr size_t WS_IDS = 224 * MiB, WS_GATE = 240 * MiB;
constexpr size_t WS_SCR = 256 * MiB;
constexpr size_t S0_Q = WS_SCR, S0_K = WS_SCR + 32 * MiB, S0_VT = WS_SCR + 64 * MiB, S0_GLU = WS_SCR + 96 * MiB, S0_CAT = WS_SCR + 128 * MiB;
constexpr size_t SP_PQ = WS_SCR;
constexpr size_t S1_Q = WS_SCR, S1_K = WS_SCR + 32 * MiB, S1_V = WS_SCR + 64 * MiB, S1_G = WS_SCR + 128 * MiB, S1_Z = WS_SCR + 192 * MiB;
constexpr size_t WS_END = 456 * MiB;

constexpr int LDS_BYTES = 155648;
constexpr int MISC_OFF = LDS_BYTES - 256;
constexpr int NWAVES = 8, NTHREADS = 512;

#define GAS __attribute__((address_space(1)))
#define LAS __attribute__((address_space(3)))
typedef unsigned short bf16;
typedef unsigned v4u __attribute__((ext_vector_type(4)));
typedef unsigned v2u __attribute__((ext_vector_type(2)));
typedef float f32x4 __attribute__((ext_vector_type(4)));
typedef float f32x16 __attribute__((ext_vector_type(16)));
typedef short bf16x8 __attribute__((ext_vector_type(8)));
typedef float f32x2_t __attribute__((ext_vector_type(2)));
typedef __bf16 bf16x2_t __attribute__((ext_vector_type(2)));
#define LDS_WAIT() asm volatile("s_waitcnt lgkmcnt(0)" ::: "memory")
#define VM_WAIT() asm volatile("s_waitcnt vmcnt(0)" ::: "memory")
__device__ __forceinline__ unsigned pk2(float lo, float hi) { f32x2_t v = {lo, hi}; bf16x2_t b = __builtin_convertvector(v, bf16x2_t); return __builtin_bit_cast(unsigned, b); }
__device__ __forceinline__ float bf_lo(unsigned w) { return __builtin_bit_cast(float, w << 16); }
__device__ __forceinline__ float bf_hi(unsigned w) { return __builtin_bit_cast(float, w & 0xffff0000u); }
__device__ __forceinline__ float bf2f(bf16 v) { return __builtin_bit_cast(float, (unsigned)v << 16); }
__device__ __forceinline__ bf16 f2bf(float f) { return (bf16)(pk2(f, 0.f) & 0xffffu); }
__device__ __forceinline__ float wave_sum(float v) {
#pragma unroll
    for (int o = 1; o < 64; o <<= 1) v += __shfl_xor(v, o);
    return v;
}
__device__ __forceinline__ float fast_exp2(float x) { return __builtin_amdgcn_exp2f(x); }
__device__ __forceinline__ float fast_rcp(float x) { return __builtin_amdgcn_rcpf(x); }
__device__ __forceinline__ float sigmoidf_(float x) { return fast_rcp(1.f + fast_exp2(-x * LOG2E)); }
__device__ __forceinline__ float siluf_(float x) { return x * sigmoidf_(x); }
#define XB_TMO      128
#define XB_XCNT(j)  (256  + 64 * (j))
#define XB_XSUB(j)  (1280 + 64 * (j))
#define XB_XGEN(j)  (2304 + 64 * (j))
#define XB_TOP      3328
#define XB_TOPGEN   3392
#define XCD_BAR_WORDS 3456
#define XB_SPIN_CAP (1u << 18)

__device__ __forceinline__ unsigned xb_ld(unsigned* p)              { return __hip_atomic_load(p, __ATOMIC_RELAXED, __HIP_MEMORY_SCOPE_AGENT); }
__device__ __forceinline__ unsigned xb_add(unsigned* p, unsigned v) { return __hip_atomic_fetch_add(p, v, __ATOMIC_RELAXED, __HIP_MEMORY_SCOPE_AGENT); }
__device__ __forceinline__ unsigned xb_xcc_id() { return (unsigned)__builtin_amdgcn_s_getreg((3 << 11) | 20) & 0xFu; }
#define XB_SPIN(cond, bar) do { unsigned _sp = 0; while (cond) { __builtin_amdgcn_s_sleep(1); \
    if ((++_sp & 255u) == 0u) { if (xb_ld(&(bar)[XB_TMO])) break; if (_sp > XB_SPIN_CAP) { atomicAdd(&(bar)[XB_TMO], 1u); break; } } } } while (0)

struct XcdBarrier {
    unsigned* bar; unsigned x;
    volatile LAS unsigned* st;
};

__device__ __forceinline__ XcdBarrier xcd_barrier_post(unsigned* bar, volatile LAS unsigned* st) {
    XcdBarrier b; b.bar = bar; b.x = xb_xcc_id(); b.st = st;
    if (threadIdx.x == 0) (void)xb_add(&bar[XB_XCNT(b.x)], 1u);
    return b;
}
__device__ __forceinline__ void xcd_barrier_complete(unsigned* bar, unsigned x, unsigned& nloc, unsigned& nx) {
    const unsigned G = gridDim.x * gridDim.y * gridDim.z;
    unsigned sum, cnt, mine, sp = 0u;
    for (;;) {
        sum = 0u; cnt = 0u; mine = 0u;
#pragma unroll
        for (unsigned j = 0; j < 16; ++j) { const unsigned c = xb_ld(&bar[XB_XCNT(j)]); sum += c; cnt += (c > 0u) ? 1u : 0u; mine = (j == x) ? c : mine; }
        if (sum == G) break;
        __builtin_amdgcn_s_sleep(1);
        if ((++sp & 255u) == 0u) { if (xb_ld(&bar[XB_TMO])) break; if (sp > XB_SPIN_CAP) { atomicAdd(&bar[XB_TMO], 1u); break; } }
    }
    nloc = mine > 0u ? mine : 1u; nx = cnt > 0u ? cnt : 1u;
}

__device__ __forceinline__ void xcd_barrier(const XcdBarrier& b) {
    asm volatile("s_waitcnt vmcnt(0)" ::: "memory");
    __syncthreads();
    if (threadIdx.x == 0) {
        unsigned* bar = b.bar;
        __builtin_amdgcn_s_waitcnt(0);
        unsigned nloc = b.st[0], nx = b.st[1];
        if (nloc == 0u) { xcd_barrier_complete(bar, b.x, nloc, nx); b.st[0] = nloc; b.st[1] = nx; }
        const unsigned old = xb_add(&bar[XB_XSUB(b.x)], 1u);
        const unsigned gen = old / nloc;
        if (old + 1u == (gen + 1u) * nloc) {
            __builtin_amdgcn_fence(__ATOMIC_RELEASE, "agent");
            asm volatile("s_waitcnt vmcnt(0)" ::: "memory");
            const unsigned og = xb_add(&bar[XB_TOP], 1u);
            const unsigned tg = og / nx;
            if (og + 1u == (tg + 1u) * nx) xb_add(&bar[XB_TOPGEN], 1u);
            else XB_SPIN(xb_ld(&bar[XB_TOPGEN]) == tg, bar);
            __builtin_amdgcn_fence(__ATOMIC_ACQUIRE, "agent");
            xb_add(&bar[XB_XGEN(b.x)], 1u);
            asm volatile("s_waitcnt vmcnt(0)" ::: "memory");
        } else {
            XB_SPIN(xb_ld(&bar[XB_XGEN(b.x)]) == gen, bar);
            __builtin_amdgcn_fence(__ATOMIC_ACQUIRE, "agent");
            asm volatile("s_waitcnt vmcnt(0)" ::: "memory");
        }
    }
    __syncthreads();
}

struct Frame {
    LAS unsigned char* lds;
    volatile LAS unsigned* MISC;
    unsigned* ctl;
    int tid, lane, wave;
    int vcu, G;
    const float* const __attribute__((address_space(4)))* in;
    float* out;
    unsigned char* ws;
};
enum { I_X = 0, I_RELB, I_LNMIX, I_LNFFN, I_EWIN, I_LQ1, I_LK1, I_LQ2, I_LK2, I_SUBLN, I_CONVW, I_CONVB, I_CLNG, I_CLNB, I_EWOUT, I_OWIN, I_WG2, I_BG2, I_GLAG, I_OWOUT, I_PWQ, I_PSK, I_PU, I_PV, I_LNF };

__device__ __forceinline__ void p0_transpose_item(const float* W, int Nsrc, bf16* WT, int kb, int dstrow0, int srccol0, const float* gain, LAS float* scr, int lane) {
    const int k0 = 64 * kb; const int col = srccol0 + (lane & 31); const bool ok = col < Nsrc;
#pragma unroll 8
    for (int i = 0; i < 32; ++i) { const int kk = 2 * i + (lane >> 5); float v = ok ? W[(size_t)(k0 + kk) * Nsrc + col] : 0.f; if (gain) v *= gain[k0 + kk]; scr[kk * 33 + (lane & 31)] = v; }
    LDS_WAIT(); asm volatile("" ::: "memory");
    const int c = lane & 7;
#pragma unroll
    for (int j = 0; j < 4; ++j) { const int n = (lane >> 3) + 8 * j; const LAS float* s = scr + (8 * c) * 33 + n;
        v4u o; o.x = pk2(s[0 * 33], s[1 * 33]); o.y = pk2(s[2 * 33], s[3 * 33]); o.z = pk2(s[4 * 33], s[5 * 33]); o.w = pk2(s[6 * 33], s[7 * 33]);
        *(v4u*)(WT + (size_t)(dstrow0 + n) * 1024 + k0 + 8 * c) = o; }
    LDS_WAIT(); asm volatile("" ::: "memory");
}
__device__ __forceinline__ int win0_src(int dstrow) { if (dstrow < 1536) return dstrow; const int r = dstrow - 1536, j = r >> 8, half = (r >> 7) & 1, i = r & 127; return 1536 + 512 * half + 128 * j + i; }

__device__ __forceinline__ void rms_row_to_bf16(const float* xrow, const float* g, bf16* orow, int lane) {
    const f32x4* xr = (const f32x4*)xrow + lane; const f32x4* gr = (const f32x4*)g + lane;
    f32x4 v[4]; float s = 0.f;
#pragma unroll
    for (int j = 0; j < 4; ++j) { v[j] = xr[64 * j]; s += (v[j].x * v[j].x + v[j].y * v[j].y) + (v[j].z * v[j].z + v[j].w * v[j].w); }
    const float r = 1.f / sqrtf(wave_sum(s) * (1.f / DM) + EPS);
    v2u* o8 = (v2u*)orow + lane;
#pragma unroll
    for (int j = 0; j < 4; ++j) { const f32x4 gg = gr[64 * j]; v2u w; w.x = pk2(v[j].x * r * gg.x, v[j].y * r * gg.y); w.y = pk2(v[j].z * r * gg.z, v[j].w * r * gg.w); o8[64 * j] = w; }
}
__device__ __forceinline__ void cvt_stream_bf16(const float* src, bf16* dst, size_t n, int gtid, int gthreads) {
    const size_t n8 = n >> 3;
    for (size_t i = gtid; i < n8; i += gthreads) { const f32x4 a = ((const f32x4*)src)[2 * i], b = ((const f32x4*)src)[2 * i + 1];
        v4u o; o.x = pk2(a.x, a.y); o.y = pk2(a.z, a.w); o.z = pk2(b.x, b.y); o.w = pk2(b.z, b.w); ((v4u*)dst)[i] = o; }
}
__device__ __forceinline__ unsigned pk_fp8x4(float a, float b, float c, float d) { int w = __builtin_amdgcn_cvt_pk_fp8_f32(a, b, 0, false); w = __builtin_amdgcn_cvt_pk_fp8_f32(c, d, w, true); return (unsigned)w; }
__device__ __forceinline__ void cvt_stream_fp8(const float* src, unsigned char* dst, size_t n, float sc, int gtid, int gthreads) {
    const size_t n16 = n >> 4;
    for (size_t i = gtid; i < n16; i += gthreads) { const f32x4 a = ((const f32x4*)src)[4 * i] * sc, b = ((const f32x4*)src)[4 * i + 1] * sc, c = ((const f32x4*)src)[4 * i + 2] * sc, d = ((const f32x4*)src)[4 * i + 3] * sc;
        v4u o; o.x = pk_fp8x4(a.x, a.y, a.z, a.w); o.y = pk_fp8x4(b.x, b.y, b.z, b.w); o.z = pk_fp8x4(c.x, c.y, c.z, c.w); o.w = pk_fp8x4(d.x, d.y, d.z, d.w); ((v4u*)dst)[i] = o; }
}
__device__ __forceinline__ void p0_prologue(Frame& F) {
    LAS float* scr = (LAS float*)(F.lds + F.wave * 8704);
    const int gw = F.vcu * NWAVES + F.wave, NGW = F.G * NWAVES;
    bf16* WIN0 = (bf16*)(F.ws + WS_WIN0); bf16* WOUT0 = (bf16*)(F.ws + WS_WOUT0); bf16* WIN1 = (bf16*)(F.ws + WS_WIN1); bf16* WOUT1 = (bf16*)(F.ws + WS_WOUT1);
    bf16* WQ0 = (bf16*)(F.ws + WS_WQ0); bf16* WQ1 = (bf16*)(F.ws + WS_WQ1);
    constexpr int I0 = 16 * (EVEN_IN / 32), I1 = 16 * (DM / 32), I2 = 16 * (ODD_IN_PAD / 32), I3 = I1, I4 = 16 * (PQ_N / 32), I5 = I4;
    constexpr int NITEMS = I0 + I1 + I2 + I3 + I4 + I5;
    for (int it = gw; it < NITEMS; it += NGW) {
        int r = it;
        if (r < I0) { const int nb = r % (EVEN_IN / 32), kb = r / (EVEN_IN / 32); p0_transpose_item(F.in[I_EWIN], EVEN_IN, WIN0, kb, 32 * nb, win0_src(32 * nb), nullptr, scr, F.lane); continue; } r -= I0;
        if (r < I1) { const int nb = r % (DM / 32), kb = r / (DM / 32); p0_transpose_item(F.in[I_EWOUT], DM, WOUT0, kb, 32 * nb, 32 * nb, nullptr, scr, F.lane); continue; } r -= I1;
        if (r < I2) { const int nb = r % (ODD_IN_PAD / 32), kb = r / (ODD_IN_PAD / 32); p0_transpose_item(F.in[I_OWIN], ODD_IN, WIN1, kb, 32 * nb, 32 * nb, nullptr, scr, F.lane); continue; } r -= I2;
        if (r < I3) { const int nb = r % (DM / 32), kb = r / (DM / 32); p0_transpose_item(F.in[I_OWOUT], DM, WOUT1, kb, 32 * nb, 32 * nb, nullptr, scr, F.lane); continue; } r -= I3;
        if (r < I4) { const int nb = r % (PQ_N / 32), kb = r / (PQ_N / 32); p0_transpose_item(F.in[I_PWQ], PQ_N, WQ0, kb, 32 * nb, 32 * nb, F.in[I_LNFFN], scr, F.lane); continue; } r -= I4;
        { const int nb = r % (PQ_N / 32), kb = r / (PQ_N / 32); p0_transpose_item(F.in[I_PWQ] + (size_t)DM * PQ_N, PQ_N, WQ1, kb, 32 * nb, 32 * nb, F.in[I_LNFFN] + DM, scr, F.lane); }
    }
    const int gtid = F.vcu * NTHREADS + F.tid, gthreads = F.G * NTHREADS;
    cvt_stream_bf16(F.in[I_PSK], (bf16*)(F.ws + WS_SK), (size_t)2 * 8 * 2 * 128 * 128, gtid, gthreads);
    cvt_stream_fp8(F.in[I_PU], F.ws + WS_UT, (size_t)2 * NEXP * DM, U_SCALE, gtid, gthreads);
    cvt_stream_fp8(F.in[I_PV], F.ws + WS_VT, (size_t)2 * NEXP * DM, V_SCALE, gtid, gthreads);
    bf16* HN = (bf16*)(F.ws + WS_HN);
    for (int m = gw; m < NT; m += NGW) rms_row_to_bf16(F.in[I_X] + (size_t)m * DM, F.in[I_LNMIX], HN + (size_t)m * DM, F.lane);
}

struct EpiIn0 {
    static constexpr bool PERM = false, AFTER_DRAIN = false;
    bf16* Q; bf16* K; bf16* Vt; bf16* GLU;
    __device__ __forceinline__ void operator()(const pg8::f32x4 (&acc)[2][2][4][2], const pg8::Unit& u, int wr, int wc, int fr, int fq) const {
        const int pn = u.pn;
#pragma unroll
        for (int ai = 0; ai < 2; ++ai)
#pragma unroll
            for (int m = 0; m < 4; ++m) {
                const int row = u.pm * 256 + ai * 128 + wr * 64 + m * 16 + fr; const int b = row >> 13, s = row & 8191;
                if (pn < 4) {
                    bf16* base = (pn < 2) ? Q : K; const float sc = (pn < 2) ? QSCALE_ATT : 1.f;
#pragma unroll
                    for (int bj = 0; bj < 2; ++bj)
#pragma unroll
                        for (int n = 0; n < 2; ++n) { const int c = (pn & 1) * 256 + bj * 128 + wc * 32 + n * 16 + fq * 4; const int h = c >> 7, mp = (c >> 6) & 1, d = c & 63;
                            const pg8::f32x4 v = acc[ai][bj][m][n] * sc; v2u w; w.x = pk2(v[0], v[1]); w.y = pk2(v[2], v[3]);
                            *(v2u*)(base + ((((size_t)(b * 4 + h) * 2 + mp) * SEQ + s) * 64 + d)) = w; }
                } else if (pn < 6) {
#pragma unroll
                    for (int bj = 0; bj < 2; ++bj)
#pragma unroll
                        for (int n = 0; n < 2; ++n) { const int c = (pn - 4) * 256 + bj * 128 + wc * 32 + n * 16 + fq * 4; const int h = c >> 7, d = c & 127;
                            bf16* p = Vt + ((size_t)(b * 4 + h) * 128 + d) * SEQ + s; const pg8::f32x4 v = acc[ai][bj][m][n];
                            p[0] = f2bf(v[0]); p[SEQ] = f2bf(v[1]); p[2 * SEQ] = f2bf(v[2]); p[3 * SEQ] = f2bf(v[3]); }
                } else {
#pragma unroll
                    for (int n = 0; n < 2; ++n) { const int ch = (pn - 6) * 128 + wc * 32 + n * 16 + fq * 4; const pg8::f32x4 a = acc[ai][0][m][n], g = acc[ai][1][m][n];
                        v2u w; w.x = pk2(a[0] * sigmoidf_(g[0]), a[1] * sigmoidf_(g[1])); w.y = pk2(a[2] * sigmoidf_(g[2]), a[3] * sigmoidf_(g[3]));
                        *(v2u*)(GLU + (size_t)row * 512 + ch) = w; }
                }
            }
    }
};
struct EpiRes {
    static constexpr bool PERM = false, AFTER_DRAIN = false;
    const float* base; float* out; bf16* xb; float* rowsq;
    __device__ __forceinline__ void operator()(const pg8::f32x4 (&acc)[2][2][4][2], const pg8::Unit& u, int wr, int wc, int fr, int fq) const {
#pragma unroll
        for (int ai = 0; ai < 2; ++ai)
#pragma unroll
            for (int m = 0; m < 4; ++m) {
                const int row = u.pm * 256 + ai * 128 + wr * 64 + m * 16 + fr; float ss = 0.f;
#pragma unroll
                for (int bj = 0; bj < 2; ++bj)
#pragma unroll
                    for (int n = 0; n < 2; ++n) { const size_t off = (size_t)row * DM + u.pn * 256 + bj * 128 + wc * 32 + n * 16 + fq * 4;
                        const pg8::f32x4 o = *(const pg8::f32x4*)(base + off) + acc[ai][bj][m][n];
                        *(pg8::f32x4*)(out + off) = o; v2u w; w.x = pk2(o[0], o[1]); w.y = pk2(o[2], o[3]); *(v2u*)(xb + off) = w;
                        ss += (o[0] * o[0] + o[1] * o[1]) + (o[2] * o[2] + o[3] * o[3]); }
                ss += __shfl_xor(ss, 16); ss += __shfl_xor(ss, 32);
                if (fq == 0) rowsq[(size_t)row * 16 + u.pn * 4 + wc] = ss;
            }
    }
};
struct EpiPq {
    static constexpr bool PERM = false, AFTER_DRAIN = false;
    bf16* PQ; const float* rowsq;
    __device__ __forceinline__ void operator()(const pg8::f32x4 (&acc)[2][2][4][2], const pg8::Unit& u, int wr, int wc, int fr, int fq) const {
#pragma unroll
        for (int ai = 0; ai < 2; ++ai)
#pragma unroll
            for (int m = 0; m < 4; ++m) {
                const int row = u.pm * 256 + ai * 128 + wr * 64 + m * 16 + fr; const f32x4 q0 = *(const f32x4*)(rowsq + (size_t)row * 16), q1 = *(const f32x4*)(rowsq + (size_t)row * 16 + 4), q2 = *(const f32x4*)(rowsq + (size_t)row * 16 + 8), q3 = *(const f32x4*)(rowsq + (size_t)row * 16 + 12);
                const float rs = 1.f / sqrtf(((((q0.x + q0.y) + (q0.z + q0.w)) + ((q1.x + q1.y) + (q1.z + q1.w))) + (((q2.x + q2.y) + (q2.z + q2.w)) + ((q3.x + q3.y) + (q3.z + q3.w)))) * (1.f / DM) + EPS);
#pragma unroll
                for (int bj = 0; bj < 2; ++bj)
#pragma unroll
                    for (int n = 0; n < 2; ++n) { const size_t off = (size_t)row * PQ_N + u.pn * 256 + bj * 128 + wc * 32 + n * 16 + fq * 4;
                        const pg8::f32x4 v = acc[ai][bj][m][n] * rs; v2u w; w.x = pk2(v[0], v[1]); w.y = pk2(v[2], v[3]); *(v2u*)(PQ + off) = w; }
            }
    }
};
struct EpiIn1 {
    static constexpr bool PERM = false, AFTER_DRAIN = false;
    bf16* Q; bf16* K; bf16* V; bf16* G; float* Z;
    __device__ __forceinline__ void operator()(const pg8::f32x4 (&acc)[2][2][4][2], const pg8::Unit& u, int wr, int wc, int fr, int fq) const {
        const int pn = u.pn;
#pragma unroll
        for (int ai = 0; ai < 2; ++ai)
#pragma unroll
            for (int m = 0; m < 4; ++m) {
                const int row = u.pm * 256 + ai * 128 + wr * 64 + m * 16 + fr;
#pragma unroll
                for (int bj = 0; bj < 2; ++bj)
#pragma unroll
                    for (int n = 0; n < 2; ++n) { const int c = pn * 256 + bj * 128 + wc * 32 + n * 16 + fq * 4; pg8::f32x4 v = acc[ai][bj][m][n];
                        if (pn < 2) { v = v * QSCALE_GLA; v2u w; w.x = pk2(v[0], v[1]); w.y = pk2(v[2], v[3]); *(v2u*)(Q + (size_t)row * 512 + c) = w; }
                        else if (pn < 4) { v2u w; w.x = pk2(v[0], v[1]); w.y = pk2(v[2], v[3]); *(v2u*)(K + (size_t)row * 512 + (c - 512)) = w; }
                        else if (pn < 8) { v2u w; w.x = pk2(v[0], v[1]); w.y = pk2(v[2], v[3]); *(v2u*)(V + (size_t)row * 1024 + (c - 1024)) = w; }
                        else if (pn < 12) { v2u w; w.x = pk2(siluf_(v[0]), siluf_(v[1])); w.y = pk2(siluf_(v[2]), siluf_(v[3])); *(v2u*)(G + (size_t)row * 1024 + (c - 2048)) = w; }
                        else { const int cz = c - 3072; if (cz < 16) *(pg8::f32x4*)(Z + (size_t)row * 16 + cz) = v; } }
            }
    }
};

namespace att {
constexpr int KSTR = 144, VSTR = 136;
constexpr int OFF_K1 = 0, OFF_K2 = 64 * KSTR, OFF_V = 2 * 64 * KSTR, BUFB = OFF_V + 128 * VSTR;
constexpr int OFF_TB = 2 * BUFB;
constexpr float THR = 8.f;
__device__ __forceinline__ int t5_bucket(int rel) {
    const int n = rel < 0 ? -rel : rel; int v;
    if (n < 8) v = n; else { v = 8 + (31 - __clz(n * n)) - 6; if (v > 15) v = 15; }
    return (rel > 0 ? 16 : 0) + v;
}
__device__ __forceinline__ void attn_unit(Frame& F, int bh, int qb, float lam) {
    const int tid = F.tid, lane = F.lane, wid = F.wave, r32 = lane & 31, hi = lane >> 5;
    const int mp = wid >> 2, wq = wid & 3, h = bh & 3;
    const int q0 = qb * 128, qw = q0 + 32 * wq;
    LAS unsigned char* lds = F.lds;
    const bf16* Qg = (const bf16*)(F.ws + S0_Q); const bf16* Kg = (const bf16*)(F.ws + S0_K); const bf16* Vg = (const bf16*)(F.ws + S0_VT);
    LAS float* tb = (LAS float*)(lds + OFF_TB);
    const float* relb = F.in[I_RELB];
    for (int i = tid; i < 320; i += NTHREADS) tb[i] = relb[t5_bucket(i - 255) * 4 + h] * LOG2E;
    const float c15 = relb[15 * 4 + h] * LOG2E;
    const bf16* Qp = Qg + (((size_t)(bh * 2 + mp) * SEQ) + qw + r32) * 64 + 8 * hi;
    bf16x8 qf[4];
#pragma unroll
    for (int s = 0; s < 4; ++s) qf[s] = *(const bf16x8*)(Qp + 16 * s);
    const int nt_unit = 2 * qb + 2, nt_wave = (qw >> 6) + 1;
    const int krow = tid >> 3, kch = tid & 7;
    const bf16* k1src = Kg + (((size_t)(bh * 2 + 0) * SEQ) + krow) * 64 + kch * 8;
    const bf16* k2src = Kg + (((size_t)(bh * 2 + 1) * SEQ) + krow) * 64 + kch * 8;
    const bf16* vsrc = Vg + ((size_t)bh * 128 + krow) * SEQ + kch * 8;
    const int kdst = krow * KSTR + kch * 16, vdst = krow * VSTR + kch * 16;
    v4u rk1, rk2, rv0, rv1;
#define ATT_LOAD(t) do { rk1 = *(const v4u*)(k1src + (size_t)(t) * 4096); rk2 = *(const v4u*)(k2src + (size_t)(t) * 4096); rv0 = *(const v4u*)(vsrc + (t) * 64); rv1 = *(const v4u*)(vsrc + (size_t)64 * SEQ + (t) * 64); } while (0)
#define ATT_STORE(bf) do { LAS unsigned char* bb = lds + (bf) * BUFB; *(LAS v4u*)(bb + OFF_K1 + kdst) = rk1; *(LAS v4u*)(bb + OFF_K2 + kdst) = rk2; \
        *(LAS v2u*)(bb + OFF_V + vdst) = (v2u){rv0.x, rv0.y}; *(LAS v2u*)(bb + OFF_V + vdst + 8) = (v2u){rv0.z, rv0.w}; \
        *(LAS v2u*)(bb + OFF_V + 64 * VSTR + vdst) = (v2u){rv1.x, rv1.y}; *(LAS v2u*)(bb + OFF_V + 64 * VSTR + vdst + 8) = (v2u){rv1.z, rv1.w}; } while (0)
    ATT_LOAD(0); ATT_STORE(0);
    __syncthreads();
    f32x16 o[4];
#pragma unroll
    for (int d = 0; d < 4; ++d)
#pragma unroll
        for (int r = 0; r < 16; ++r) o[d][r] = 0.f;
    float m_run = -INFINITY, l_run = 0.f;
    for (int t = 0; t < nt_unit; ++t) {
        const int buf = t & 1;
        if (t + 1 < nt_unit) ATT_LOAD(t + 1);
        if (t < nt_wave) {
            const LAS unsigned char* kb = lds + buf * BUFB + (mp ? OFF_K2 : OFF_K1) + r32 * KSTR + hi * 16;
            f32x16 p0, p1;
#pragma unroll
            for (int r = 0; r < 16; ++r) { p0[r] = 0.f; p1[r] = 0.f; }
#pragma unroll
            for (int s = 0; s < 4; ++s) { const bf16x8 a0 = *(const LAS bf16x8*)(kb + s * 32), a1 = *(const LAS bf16x8*)(kb + 32 * KSTR + s * 32);
                p0 = __builtin_amdgcn_mfma_f32_32x32x16_bf16(a0, qf[s], p0, 0, 0, 0); p1 = __builtin_amdgcn_mfma_f32_32x32x16_bf16(a1, qf[s], p1, 0, 0, 0); }
            if (64 * t + 154 <= qw) {
#pragma unroll
                for (int r = 0; r < 16; ++r) { p0[r] += c15; p1[r] += c15; }
            } else {
                const int base = 64 * t - (qw + r32) + 255 + 4 * hi;
#pragma unroll
                for (int r = 0; r < 16; ++r) { const int idx = base + (r & 3) + 8 * (r >> 2); p0[r] += tb[idx]; p1[r] += tb[idx + 32]; }
            }
            float rm = fmaxf(p0[0], p1[0]);
#pragma unroll
            for (int r = 1; r < 16; ++r) rm = fmaxf(rm, fmaxf(p0[r], p1[r]));
            rm = fmaxf(rm, __shfl_xor(rm, 32));
            if (__any(rm > m_run + THR)) {
                const float mn = fmaxf(m_run, rm), al = fast_exp2(m_run - mn);
#pragma unroll
                for (int d = 0; d < 4; ++d)
#pragma unroll
                    for (int r = 0; r < 16; ++r) o[d][r] *= al;
                l_run *= al; m_run = mn;
            }
            float ls = 0.f;
#pragma unroll
            for (int r = 0; r < 16; ++r) { p0[r] = fast_exp2(p0[r] - m_run); p1[r] = fast_exp2(p1[r] - m_run); ls += p0[r] + p1[r]; }
            l_run += ls;
            bf16x8 pb[4];
            { v4u w;
              w.x = pk2(p0[0], p0[1]); w.y = pk2(p0[2], p0[3]); w.z = pk2(p0[4], p0[5]); w.w = pk2(p0[6], p0[7]); pb[0] = __builtin_bit_cast(bf16x8, w);
              w.x = pk2(p0[8], p0[9]); w.y = pk2(p0[10], p0[11]); w.z = pk2(p0[12], p0[13]); w.w = pk2(p0[14], p0[15]); pb[1] = __builtin_bit_cast(bf16x8, w);
              w.x = pk2(p1[0], p1[1]); w.y = pk2(p1[2], p1[3]); w.z = pk2(p1[4], p1[5]); w.w = pk2(p1[6], p1[7]); pb[2] = __builtin_bit_cast(bf16x8, w);
              w.x = pk2(p1[8], p1[9]); w.y = pk2(p1[10], p1[11]); w.z = pk2(p1[12], p1[13]); w.w = pk2(p1[14], p1[15]); pb[3] = __builtin_bit_cast(bf16x8, w); }
            const LAS unsigned char* vb = lds + buf * BUFB + OFF_V + r32 * VSTR + hi * 8;
#pragma unroll
            for (int d = 0; d < 4; ++d)
#pragma unroll
                for (int s = 0; s < 4; ++s) { const v2u lo = *(const LAS v2u*)(vb + d * 32 * VSTR + s * 32), h8 = *(const LAS v2u*)(vb + d * 32 * VSTR + s * 32 + 16);
                    const v4u aw = {lo.x, lo.y, h8.x, h8.y};
                    o[d] = __builtin_amdgcn_mfma_f32_32x32x16_bf16(__builtin_bit_cast(bf16x8, aw), pb[s], o[d], 0, 0, 0); }
        }
        if (t + 1 < nt_unit) ATT_STORE(buf ^ 1);
        __syncthreads();
    }
#undef ATT_LOAD
#undef ATT_STORE
    l_run += __shfl_xor(l_run, 32);
    const float inv = 1.f / l_run;
    LAS float* X = (LAS float*)lds + (size_t)(wq * 64) * 64 + lane;
    if (mp == 1) {
#pragma unroll
        for (int d = 0; d < 4; ++d)
#pragma unroll
            for (int r = 0; r < 16; ++r) X[(d * 16 + r) * 64] = o[d][r] * inv;
    }
    __syncthreads();
    if (mp == 0) {
        float ss = 0.f;
#pragma unroll
        for (int d = 0; d < 4; ++d)
#pragma unroll
            for (int r = 0; r < 16; ++r) { const float v = o[d][r] * inv - lam * X[(d * 16 + r) * 64]; o[d][r] = v; ss += v * v; }
        ss += __shfl_xor(ss, 32);
        const float rn = (1.f - LAM_INIT0) / sqrtf(ss * (1.f / 128.f) + EPS);
        bf16* CAT = (bf16*)(F.ws + S0_CAT) + ((size_t)(bh >> 2) * SEQ + qw + r32) * DM + h * 128;
        const float* sg = F.in[I_SUBLN];
#pragma unroll
        for (int d = 0; d < 4; ++d)
#pragma unroll
            for (int rg = 0; rg < 4; ++rg) { const int dd = 32 * d + 8 * rg + 4 * hi; const f32x4 g4 = *(const f32x4*)(sg + dd);
                v2u w; w.x = pk2(o[d][4 * rg] * rn * g4.x, o[d][4 * rg + 1] * rn * g4.y); w.y = pk2(o[d][4 * rg + 2] * rn * g4.z, o[d][4 * rg + 3] * rn * g4.w);
                *(v2u*)(CAT + dd) = w; }
    }
    __syncthreads();
}
__device__ __forceinline__ void conv_unit(Frame& F, int tile) {
    const int c = F.tid, t0 = tile * 32, s0 = t0 & (SEQ - 1);
    const bf16* GLU = (const bf16*)(F.ws + S0_GLU);
    const float* cw = F.in[I_CONVW];
    float w[31];
#pragma unroll
    for (int j = 0; j < 31; ++j) w[j] = cw[j * 512 + c];
    const float bias = F.in[I_CONVB][c];
    float u[62];
#pragma unroll
    for (int i = 0; i < 62; ++i) { const int s = s0 - 30 + i; u[i] = (s >= 0) ? bf2f(GLU[(size_t)(t0 - 30 + i) * 512 + c]) : 0.f; }
    LAS float* Y = (LAS float*)F.lds;
#pragma unroll
    for (int tt = 0; tt < 32; ++tt) { float y = bias;
#pragma unroll
        for (int j = 0; j < 31; ++j) y += w[j] * u[tt + j];
        Y[tt * 516 + c] = y; }
    __syncthreads();
    const float* lg = F.in[I_CLNG]; const float* lb = F.in[I_CLNB];
    bf16* CAT = (bf16*)(F.ws + S0_CAT);
#pragma unroll
    for (int k = 0; k < 4; ++k) { const int tt = 4 * F.wave + k;
        const f32x4 a = *(const LAS f32x4*)(Y + tt * 516 + F.lane * 8), b = *(const LAS f32x4*)(Y + tt * 516 + F.lane * 8 + 4);
        const float mean = wave_sum((a.x + a.y) + (a.z + a.w) + (b.x + b.y) + (b.z + b.w)) * (1.f / 512.f);
        const f32x4 da = a - mean, db = b - mean;
        const float var = wave_sum((da.x * da.x + da.y * da.y) + (da.z * da.z + da.w * da.w) + (db.x * db.x + db.y * db.y) + (db.z * db.z + db.w * db.w)) * (1.f / 512.f);
        const float rs = 1.f / sqrtf(var + EPS);
        const f32x4 g0 = *(const f32x4*)(lg + F.lane * 8), g1 = *(const f32x4*)(lg + F.lane * 8 + 4), b0 = *(const f32x4*)(lb + F.lane * 8), b1 = *(const f32x4*)(lb + F.lane * 8 + 4);
        const f32x4 y0 = da * rs * g0 + b0, y1 = db * rs * g1 + b1;
        v4u o; o.x = pk2(siluf_(y0.x), siluf_(y0.y)); o.y = pk2(siluf_(y0.z), siluf_(y0.w)); o.z = pk2(siluf_(y1.x), siluf_(y1.y)); o.w = pk2(siluf_(y1.z), siluf_(y1.w));
        *(v4u*)(CAT + (size_t)(t0 + tt) * DM + 512 + F.lane * 8) = o; }
    __syncthreads();
}
__device__ __forceinline__ void p2_attn_conv(Frame& F) {
    const float d1 = wave_sum(F.in[I_LQ1][F.lane] * F.in[I_LK1][F.lane]), d2 = wave_sum(F.in[I_LQ2][F.lane] * F.in[I_LK2][F.lane]);
    const float lam = expf(d1) - expf(d2) + LAM_INIT0;
    for (int a = F.vcu; a < 1024; a += F.G) { const int i = a >> 8, v = a & 255, x = v >> 5, j = v & 31; attn_unit(F, 2 * x + (i >> 1), (i & 1) ? (63 - j) : j, lam); }
    for (int a = F.vcu; a < NT / 32; a += F.G) conv_unit(F, a);
}
}

namespace peer {
constexpr int SSTR = 136;
__device__ __forceinline__ unsigned mono(float f) { const unsigned u = __builtin_bit_cast(unsigned, f); return u ^ ((unsigned)((int)u >> 31) | 0x80000000u); }
__device__ __forceinline__ float unmono(unsigned m) { const unsigned u = (m & 0x80000000u) ? (m ^ 0x80000000u) : ~m; return __builtin_bit_cast(float, u); }
#define CE_DESC(a, b) do { const unsigned _x = (a), _y = (b); (a) = _x > _y ? _x : _y; (b) = _x > _y ? _y : _x; } while (0)
#define CE_ASC(a, b)  do { const unsigned _x = (a), _y = (b); (a) = _x > _y ? _y : _x; (b) = _x > _y ? _x : _y; } while (0)
__device__ __forceinline__ void merge16(unsigned (&k)[16], bool desc) {
#pragma unroll
    for (int stride = 8; stride > 0; stride >>= 1)
#pragma unroll
        for (int i = 0; i < 16; ++i) if ((i & stride) == 0) { if (desc) CE_DESC(k[i], k[i + stride]); else CE_ASC(k[i], k[i + stride]); }
}
__device__ __forceinline__ void top16_of_64(unsigned (&k)[64], unsigned (&res)[16]) {
#pragma unroll
    for (int size = 2; size <= 16; size <<= 1)
#pragma unroll
        for (int stride = size >> 1; stride > 0; stride >>= 1)
#pragma unroll
            for (int i = 0; i < 64; ++i) if ((i & stride) == 0) { if ((i & size) == 0) CE_DESC(k[i], k[i + stride]); else CE_ASC(k[i], k[i + stride]); }
    unsigned t0[16], t1[16];
#pragma unroll
    for (int i = 0; i < 16; ++i) { t0[i] = k[i] > k[16 + i] ? k[i] : k[16 + i]; t1[i] = k[32 + i] > k[48 + i] ? k[32 + i] : k[48 + i]; }
    merge16(t0, true); merge16(t1, false);
#pragma unroll
    for (int i = 0; i < 16; ++i) res[i] = t0[i] > t1[i] ? t0[i] : t1[i];
    merge16(res, true);
}
__device__ __forceinline__ void topk_unit(Frame& F, int tile, int h, int layer) {
    const int tid = F.tid, lane = F.lane, wid = F.wave;
    const bf16* PQ = (const bf16*)(F.ws + SP_PQ); const bf16* SK = (const bf16*)(F.ws + WS_SK) + (size_t)((layer * 8 + h) * 2) * 128 * 128;
    LAS float* S = (LAS float*)F.lds;
    const int t0 = tile * 256, fr = lane & 15, fq = lane >> 4;
    unsigned sel[2][16];
#pragma unroll
    for (int p = 0; p < 2; ++p) {
        {
            bf16x8 af[2][4];
#pragma unroll
            for (int mt = 0; mt < 2; ++mt)
#pragma unroll
                for (int ks = 0; ks < 4; ++ks) af[mt][ks] = *(const bf16x8*)(PQ + (size_t)(t0 + 32 * wid + 16 * mt + fr) * PQ_N + h * 256 + p * 128 + 32 * ks + 8 * fq);
            const bf16* SKp = SK + (size_t)p * 128 * 128;
#pragma unroll 2
            for (int nt = 0; nt < 8; ++nt) {
                f32x4 a0 = {0.f, 0.f, 0.f, 0.f}, a1 = {0.f, 0.f, 0.f, 0.f};
#pragma unroll
                for (int ks = 0; ks < 4; ++ks) { const bf16x8 bfr = *(const bf16x8*)(SKp + (size_t)(16 * nt + fr) * 128 + 32 * ks + 8 * fq);
                    a0 = __builtin_amdgcn_mfma_f32_16x16x32_bf16(af[0][ks], bfr, a0, 0, 0, 0); a1 = __builtin_amdgcn_mfma_f32_16x16x32_bf16(af[1][ks], bfr, a1, 0, 0, 0); }
                const int key = 16 * nt + fr, col = key + ((key >> 6) << 2);
#pragma unroll
                for (int r = 0; r < 4; ++r) { S[(32 * wid + 4 * fq + r) * SSTR + col] = a0[r]; S[(32 * wid + 16 + 4 * fq + r) * SSTR + col] = a1[r]; }
            }
        }
        __syncthreads();
        {
            const int row = tid >> 1, kh = tid & 1;
            unsigned k[64];
#pragma unroll
            for (int i = 0; i < 16; ++i) { const f32x4 v = *(const LAS f32x4*)(S + row * SSTR + 68 * kh + 4 * i);
#pragma unroll
                for (int e = 0; e < 4; ++e) k[4 * i + e] = (mono(v[e]) & ~127u) | (unsigned)(127 - (64 * kh + 4 * i + e)); }
            unsigned mine[16];
            top16_of_64(k, mine);
#pragma unroll
            for (int i = 0; i < 16; ++i) { const unsigned other = (unsigned)__shfl_xor((int)mine[15 - i], 1); sel[p][i] = mine[i] > other ? mine[i] : other; }
            merge16(sel[p], true);
        }
        __syncthreads();
    }
    float v1[16], v2[16]; int i1[16], i2[16];
#pragma unroll
    for (int i = 0; i < 16; ++i) { v1[i] = unmono(sel[0][i] & ~127u); i1[i] = 127 - (int)(sel[0][i] & 127u); v2[i] = unmono(sel[1][i] & ~127u); i2[i] = 127 - (int)(sel[1][i] & 127u); }
    unsigned k2[64];
    {
        int n = 0;
#pragma unroll
        for (int i = 0; i < 16; ++i)
#pragma unroll
            for (int j = 0; j < 16; ++j) if ((i + 1) * (j + 1) <= 16) { k2[n] = (mono(v1[i] + v2[j]) & ~255u) | (unsigned)(255 - (i * 16 + j)); ++n; }
#pragma unroll
        for (int q = 50; q < 64; ++q) k2[q] = 0u;
    }
    unsigned top[16];
    top16_of_64(k2, top);
    const int row = tid >> 1, kh = tid & 1;
    const size_t obase = ((size_t)(t0 + row) * 8 + h) * 16;
    if (kh == 0) {
        int* IDS = (int*)(F.ws + WS_IDS) + obase;
#pragma unroll
        for (int q4 = 0; q4 < 4; ++q4) { int ev[4];
#pragma unroll
            for (int e = 0; e < 4; ++e) { const int cid = 255 - (int)(top[4 * q4 + e] & 255u), ci = cid >> 4, cj = cid & 15; int e1 = 0, e2 = 0;
#pragma unroll
                for (int i = 0; i < 16; ++i) { e1 = (ci == i) ? i1[i] : e1; e2 = (cj == i) ? i2[i] : e2; }
                ev[e] = e1 * 128 + e2; }
            *(v4u*)(IDS + 4 * q4) = (v4u){(unsigned)ev[0], (unsigned)ev[1], (unsigned)ev[2], (unsigned)ev[3]}; }
    } else {
        float* GT = (float*)(F.ws + WS_GATE) + obase;
        float cv[16]; float sum = 0.f;
        const float mx = unmono(top[0] & ~255u);
#pragma unroll
        for (int q = 0; q < 16; ++q) { cv[q] = fast_exp2((unmono(top[q] & ~255u) - mx) * LOG2E); sum += cv[q]; }
        const float inv = 1.f / sum;
#pragma unroll
        for (int q4 = 0; q4 < 4; ++q4) *(f32x4*)(GT + 4 * q4) = (f32x4){cv[4 * q4] * inv, cv[4 * q4 + 1] * inv, cv[4 * q4 + 2] * inv, cv[4 * q4 + 3] * inv};
    }
}
__device__ __forceinline__ void topk_phase(Frame& F, int layer) {
    for (int a = F.vcu; a < (NT / 256) * 8; a += F.G) topk_unit(F, a >> 3, a & 7, layer);
}
__device__ __forceinline__ float gelu_tanh(float x) { const float y = 1.5957691216057308f * (x + 0.044715f * x * x * x); return x * fast_rcp(1.f + fast_exp2(-y * LOG2E)); }
__device__ __forceinline__ void fp8x16_to_f32(const v4u w, float (&o)[16]) {
#pragma unroll
    for (int i = 0; i < 4; ++i) { const f32x2_t a = __builtin_amdgcn_cvt_pk_f32_fp8((int)w[i], false), b = __builtin_amdgcn_cvt_pk_f32_fp8((int)w[i], true); o[4 * i] = a.x; o[4 * i + 1] = a.y; o[4 * i + 2] = b.x; o[4 * i + 3] = b.y; }
}
__device__ __forceinline__ void experts_phase(Frame& F, int layer) {
    const int lane = F.lane;
    const unsigned char* UT = F.ws + WS_UT + (size_t)layer * NEXP * DM; const unsigned char* VT = F.ws + WS_VT + (size_t)layer * NEXP * DM;
    const int* IDS = (const int*)(F.ws + WS_IDS); const float* GT = (const float*)(F.ws + WS_GATE);
    float* XR = F.out;
    const float* gffn = F.in[I_LNFFN] + layer * DM;
    const float* gnext = layer == 0 ? F.in[I_LNMIX] + DM : F.in[I_LNF];
    bf16* HN = (bf16*)(F.ws + WS_HN);
    const int gw = F.vcu * NWAVES + F.wave, NGW = F.G * NWAVES;
    const int d0 = 16 * lane;
    for (int t = gw; t < NT; t += NGW) {
        float x[16], hn[16], acc[16];
#pragma unroll
        for (int q = 0; q < 4; ++q) { const f32x4 a = *(const f32x4*)(XR + (size_t)t * DM + d0 + 4 * q); x[4 * q] = a.x; x[4 * q + 1] = a.y; x[4 * q + 2] = a.z; x[4 * q + 3] = a.w; }
        float ss = 0.f;
#pragma unroll
        for (int i = 0; i < 16; ++i) ss += x[i] * x[i];
        const float r = 1.f / sqrtf(wave_sum(ss) * (1.f / DM) + EPS);
#pragma unroll
        for (int i = 0; i < 16; ++i) { hn[i] = x[i] * r * gffn[d0 + i]; acc[i] = 0.f; }
        const int idv0 = IDS[(size_t)t * 128 + lane], idv1 = IDS[(size_t)t * 128 + 64 + lane];
        const float gv0 = GT[(size_t)t * 128 + lane], gv1 = GT[(size_t)t * 128 + 64 + lane];
#pragma unroll
        for (int half = 0; half < 2; ++half) {
            const int idv = half ? idv1 : idv0; const float gv = half ? gv1 : gv0;
#pragma unroll 1
            for (int b16 = 0; b16 < 4; ++b16) {
                int id[16]; float p[16];
#pragma unroll
                for (int e = 0; e < 16; ++e) id[e] = __builtin_amdgcn_readlane(idv, b16 * 16 + e);
                v4u ua[16];
#pragma unroll
                for (int e = 0; e < 16; ++e) ua[e] = *(const v4u*)(UT + (size_t)id[e] * DM + d0);
#pragma unroll
                for (int e = 0; e < 16; ++e) { float uf[16]; fp8x16_to_f32(ua[e], uf); float s = 0.f;
#pragma unroll
                    for (int i = 0; i < 16; ++i) s += hn[i] * uf[i];
                    p[e] = s; }
                float w8[8], w4[4], w2[2], w1;
                { const bool up = (lane & 32) != 0;
#pragma unroll
                  for (int i = 0; i < 8; ++i) { const float keep = up ? p[8 + i] : p[i], send = up ? p[i] : p[8 + i]; w8[i] = keep + __shfl_xor(send, 32); } }
                { const bool up = (lane & 16) != 0;
#pragma unroll
                  for (int i = 0; i < 4; ++i) { const float keep = up ? w8[4 + i] : w8[i], send = up ? w8[i] : w8[4 + i]; w4[i] = keep + __shfl_xor(send, 16); } }
                { const bool up = (lane & 8) != 0;
#pragma unroll
                  for (int i = 0; i < 2; ++i) { const float keep = up ? w4[2 + i] : w4[i], send = up ? w4[i] : w4[2 + i]; w2[i] = keep + __shfl_xor(send, 8); } }
                { const bool up = (lane & 4) != 0; const float keep = up ? w2[1] : w2[0], send = up ? w2[0] : w2[1]; w1 = keep + __shfl_xor(send, 4); }
                w1 += __shfl_xor(w1, 2); w1 += __shfl_xor(w1, 1);
                const float coef = __shfl(gv, b16 * 16 + (lane >> 2)) * gelu_tanh(w1 * (1.f / U_SCALE));
#pragma unroll
                for (int e = 0; e < 16; ++e) ua[e] = *(const v4u*)(VT + (size_t)id[e] * DM + d0);
#pragma unroll
                for (int e = 0; e < 16; ++e) { const float ce = __builtin_bit_cast(float, __builtin_amdgcn_readlane(__builtin_bit_cast(int, coef), 4 * e)); float vf[16]; fp8x16_to_f32(ua[e], vf);
#pragma unroll
                    for (int i = 0; i < 16; ++i) acc[i] += ce * vf[i]; }
            }
        }
        float s2 = 0.f;
#pragma unroll
        for (int i = 0; i < 16; ++i) { x[i] += acc[i] * (1.f / V_SCALE); s2 += x[i] * x[i]; }
        const float r2 = 1.f / sqrtf(wave_sum(s2) * (1.f / DM) + EPS);
        float y[16];
#pragma unroll
        for (int i = 0; i < 16; ++i) y[i] = x[i] * r2 * gnext[d0 + i];
        if (layer == 0) {
#pragma unroll
            for (int q = 0; q < 4; ++q) *(f32x4*)(XR + (size_t)t * DM + d0 + 4 * q) = (f32x4){x[4 * q], x[4 * q + 1], x[4 * q + 2], x[4 * q + 3]};
            *(v4u*)(HN + (size_t)t * DM + d0) = (v4u){pk2(y[0], y[1]), pk2(y[2], y[3]), pk2(y[4], y[5]), pk2(y[6], y[7])};
            *(v4u*)(HN + (size_t)t * DM + d0 + 8) = (v4u){pk2(y[8], y[9]), pk2(y[10], y[11]), pk2(y[12], y[13]), pk2(y[14], y[15])};
        } else {
#pragma unroll
            for (int q = 0; q < 4; ++q) *(f32x4*)(XR + (size_t)t * DM + d0 + 4 * q) = (f32x4){y[4 * q], y[4 * q + 1], y[4 * q + 2], y[4 * q + 3]};
        }
    }
}
}

namespace gla {
__device__ __forceinline__ void prep_unit(Frame& F, int item) {
    const int tid = F.tid, bh = item >> 7, chunk = item & 127, b = bh >> 2, h = bh & 3;
    const int t0 = b * SEQ + 64 * chunk;
    bf16* KG = (bf16*)(F.ws + S1_K); bf16* VG = (bf16*)(F.ws + S1_V); const float* ZG = (const float*)(F.ws + S1_Z);
    float* DEC = (float*)(F.ws + WS_DEC);
    LAS float* TOT = (LAS float*)F.lds;
    LAS bf16* VL = (LAS bf16*)(F.lds + 4096);
    const int dk = tid & 127, seg = tid >> 7;
    float w2r[16];
#pragma unroll
    for (int j = 0; j < 16; ++j) w2r[j] = F.in[I_WG2][j * 512 + h * 128 + dk];
    const float b2 = F.in[I_BG2][h * 128 + dk];
    float cum[16], kv[16]; float run = 0.f;
#pragma unroll
    for (int j = 0; j < 16; ++j) { const int s = 16 * seg + j; const float* zp = ZG + (size_t)(t0 + s) * 16;
        const f32x4 z0 = *(const f32x4*)zp, z1 = *(const f32x4*)(zp + 4), z2 = *(const f32x4*)(zp + 8), z3 = *(const f32x4*)(zp + 12);
        float xg = b2 + z0.x * w2r[0] + z0.y * w2r[1] + z0.z * w2r[2] + z0.w * w2r[3] + z1.x * w2r[4] + z1.y * w2r[5] + z1.z * w2r[6] + z1.w * w2r[7]
                      + z2.x * w2r[8] + z2.y * w2r[9] + z2.z * w2r[10] + z2.w * w2r[11] + z3.x * w2r[12] + z3.y * w2r[13] + z3.z * w2r[14] + z3.w * w2r[15];
        const float la = (fminf(xg, 0.f) - log1pf(expf(-fabsf(xg)))) * (1.f / 16.f);
        run += la; cum[j] = run; kv[j] = bf2f(KG[(size_t)(t0 + s) * 512 + h * 128 + dk]); }
    TOT[seg * 128 + dk] = run;
#pragma unroll
    for (int i = 0; i < 4; ++i) { const int q = tid + 512 * i, s = q >> 5, cc = q & 31; const v4u v = *(const v4u*)(VG + (size_t)(t0 + s) * 1024 + h * 256 + 8 * cc);
        *(LAS v2u*)(VL + s * 264 + 8 * cc) = (v2u){v.x, v.y}; *(LAS v2u*)(VL + s * 264 + 8 * cc + 4) = (v2u){v.z, v.w}; }
    __syncthreads();
    float off = 0.f, total = 0.f;
#pragma unroll
    for (int g = 0; g < 4; ++g) { const float tg = TOT[g * 128 + dk]; total += tg; if (g < seg) off += tg; }
    unsigned pk[8];
#pragma unroll
    for (int j = 0; j < 16; j += 2) pk[j >> 1] = pk2(kv[j] * expf(total - (off + cum[j])), kv[j + 1] * expf(total - (off + cum[j + 1])));
    bf16* kd = KG + (size_t)(t0 + (dk >> 1)) * 512 + h * 128 + (dk & 1) * 64 + 16 * seg;
    *(v4u*)kd = (v4u){pk[0], pk[1], pk[2], pk[3]}; *(v4u*)(kd + 8) = (v4u){pk[4], pk[5], pk[6], pk[7]};
    if (seg == 0) DEC[(size_t)item * 128 + dk] = expf(total);
#pragma unroll
    for (int i = 0; i < 4; ++i) { const int o = tid + 512 * i, dv = o >> 3, sb = o & 7; unsigned w[4];
#pragma unroll
        for (int j = 0; j < 4; ++j) w[j] = (unsigned)VL[(8 * sb + 2 * j) * 264 + dv] | ((unsigned)VL[(8 * sb + 2 * j + 1) * 264 + dv] << 16);
        *(v4u*)(VG + (size_t)(t0 + (dv >> 2)) * 1024 + h * 256 + (dv & 3) * 64 + 8 * sb) = (v4u){w[0], w[1], w[2], w[3]}; }
    __syncthreads();
}
__device__ __forceinline__ int crow(int r, int hi) { return (r & 3) + 8 * (r >> 2) + 4 * hi; }
__device__ __forceinline__ void scan_task(Frame& F, int bh, int w) {
    const int lane = F.lane, r32 = lane & 31, hi = lane >> 5, b = bh >> 2, h = bh & 3;
    const bf16* QG = (const bf16*)(F.ws + S1_Q); const bf16* KG = (const bf16*)(F.ws + S1_K); const bf16* VG = (const bf16*)(F.ws + S1_V);
    const float* DEC = (const float*)(F.ws + WS_DEC); bf16* OUT = (bf16*)(F.ws + WS_HN);
    f32x16 st[4];
#pragma unroll
    for (int d = 0; d < 4; ++d)
#pragma unroll
        for (int r = 0; r < 16; ++r) st[d][r] = 0.f;
    const unsigned lv = (unsigned)((r32 >> 2) * 1024 + (r32 & 3) * 64 + 8 * hi);
    const unsigned lk = (unsigned)((r32 >> 1) * 512 + (r32 & 1) * 64 + 8 * hi);
    const unsigned lq = (unsigned)(r32 * 512 + 4 * hi);
    const unsigned lo = (unsigned)(4 * hi * 1024 + r32);
    const unsigned ld = (unsigned)(4 * hi);
#pragma unroll 1
    for (int chunk = 0; chunk < 128; ++chunk) {
        const int t0 = b * SEQ + 64 * chunk;
        const bf16* vb = VG + (size_t)(t0 + 8 * w) * 1024 + h * 256;
        const bf16* kb = KG + (size_t)t0 * 512 + h * 128;
        const bf16* qb = QG + (size_t)t0 * 512 + h * 128;
        bf16* ob = OUT + (size_t)t0 * 1024 + h * 256 + 32 * w;
        const float* dc = DEC + (size_t)(bh * 128 + chunk) * 128;
        bf16x8 bu[4];
#pragma unroll
        for (int ks = 0; ks < 4; ++ks) bu[ks] = *(const bf16x8*)(vb + 16 * ks + lv);
#pragma unroll
        for (int db = 0; db < 4; ++db) {
            bf16x8 au[4];
#pragma unroll
            for (int ks = 0; ks < 4; ++ks) au[ks] = *(const bf16x8*)(kb + (size_t)(16 * db) * 512 + 16 * ks + lk);
#pragma unroll
            for (int rg = 0; rg < 4; ++rg) { const f32x4 d4 = *(const f32x4*)(dc + 32 * db + 8 * rg + ld);
                st[db][4 * rg] *= d4.x; st[db][4 * rg + 1] *= d4.y; st[db][4 * rg + 2] *= d4.z; st[db][4 * rg + 3] *= d4.w; }
#pragma unroll
            for (int ks = 0; ks < 4; ++ks) st[db] = __builtin_amdgcn_mfma_f32_32x32x16_bf16(au[ks], bu[ks], st[db], 0, 0, 0);
            asm volatile("" ::: "memory");
        }
#pragma unroll
        for (int sb = 0; sb < 2; ++sb) {
            f32x16 oa;
#pragma unroll
            for (int r = 0; r < 16; ++r) oa[r] = 0.f;
#pragma unroll
            for (int db = 0; db < 4; ++db)
#pragma unroll
                for (int hs = 0; hs < 2; ++hs) {
                    const bf16* qp = qb + (size_t)(32 * sb) * 512 + 32 * db + 16 * hs;
                    const v2u qa = *(const v2u*)(qp + lq), qc = *(const v2u*)(qp + 8 + lq);
                    const v4u aw = {qa.x, qa.y, qc.x, qc.y};
                    const v4u bw = {pk2(st[db][8 * hs], st[db][8 * hs + 1]), pk2(st[db][8 * hs + 2], st[db][8 * hs + 3]), pk2(st[db][8 * hs + 4], st[db][8 * hs + 5]), pk2(st[db][8 * hs + 6], st[db][8 * hs + 7])};
                    oa = __builtin_amdgcn_mfma_f32_32x32x16_bf16(__builtin_bit_cast(bf16x8, aw), __builtin_bit_cast(bf16x8, bw), oa, 0, 0, 0);
                }
#pragma unroll
            for (int r = 0; r < 16; ++r) ob[(size_t)(32 * sb + (r & 3) + 8 * (r >> 2)) * 1024 + lo] = f2bf(oa[r]);
            asm volatile("" ::: "memory");
        }
    }
}
__device__ __forceinline__ void scan_phase(Frame& F) {
    if (F.wave == 0) {
        int a = (F.G == 256) ? (((F.vcu & 31) < 16) ? ((F.vcu >> 5) * 16 + (F.vcu & 31)) : 128) : F.vcu;
        const int stride = (F.G == 256) ? 128 : F.G;
#pragma unroll 1
        for (; a < 128; a += stride) scan_task(F, a >> 3, a & 7);
    }
}
__device__ __forceinline__ void post_phase(Frame& F) {
    const int lane = F.lane; bf16* OUT = (bf16*)(F.ws + WS_HN); const bf16* GG = (const bf16*)(F.ws + S1_G);
    const float* gn = F.in[I_GLAG] + (lane & 15) * 16;
    float g[16];
#pragma unroll
    for (int i = 0; i < 16; ++i) g[i] = gn[i];
    const int gw = F.vcu * NWAVES + F.wave, NGW = F.G * NWAVES;
    for (int t = gw; t < NT; t += NGW) {
        const v4u o0 = *(const v4u*)(OUT + (size_t)t * 1024 + 16 * lane), o1 = *(const v4u*)(OUT + (size_t)t * 1024 + 16 * lane + 8);
        const v4u g0 = *(const v4u*)(GG + (size_t)t * 1024 + 16 * lane), g1 = *(const v4u*)(GG + (size_t)t * 1024 + 16 * lane + 8);
        float o[16], sg[16];
        o[0] = bf_lo(o0.x); o[1] = bf_hi(o0.x); o[2] = bf_lo(o0.y); o[3] = bf_hi(o0.y); o[4] = bf_lo(o0.z); o[5] = bf_hi(o0.z); o[6] = bf_lo(o0.w); o[7] = bf_hi(o0.w);
        o[8] = bf_lo(o1.x); o[9] = bf_hi(o1.x); o[10] = bf_lo(o1.y); o[11] = bf_hi(o1.y); o[12] = bf_lo(o1.z); o[13] = bf_hi(o1.z); o[14] = bf_lo(o1.w); o[15] = bf_hi(o1.w);
        sg[0] = bf_lo(g0.x); sg[1] = bf_hi(g0.x); sg[2] = bf_lo(g0.y); sg[3] = bf_hi(g0.y); sg[4] = bf_lo(g0.z); sg[5] = bf_hi(g0.z); sg[6] = bf_lo(g0.w); sg[7] = bf_hi(g0.w);
        sg[8] = bf_lo(g1.x); sg[9] = bf_hi(g1.x); sg[10] = bf_lo(g1.y); sg[11] = bf_hi(g1.y); sg[12] = bf_lo(g1.z); sg[13] = bf_hi(g1.z); sg[14] = bf_lo(g1.w); sg[15] = bf_hi(g1.w);
        float ss = 0.f;
#pragma unroll
        for (int i = 0; i < 16; ++i) ss += o[i] * o[i];
        ss += __shfl_xor(ss, 1); ss += __shfl_xor(ss, 2); ss += __shfl_xor(ss, 4); ss += __shfl_xor(ss, 8);
        const float rs = 1.f / sqrtf(ss * (1.f / 256.f) + EPS);
        float y[16];
#pragma unroll
        for (int i = 0; i < 16; ++i) y[i] = o[i] * rs * g[i] * sg[i];
        *(v4u*)(OUT + (size_t)t * 1024 + 16 * lane) = (v4u){pk2(y[0], y[1]), pk2(y[2], y[3]), pk2(y[4], y[5]), pk2(y[6], y[7])};
        *(v4u*)(OUT + (size_t)t * 1024 + 16 * lane + 8) = (v4u){pk2(y[8], y[9]), pk2(y[10], y[11]), pk2(y[12], y[13]), pk2(y[14], y[15])};
    }
}
}

constexpr int CW_BAR = 4096;
constexpr int N_PHASES = 15;
struct Args { const float* in[25]; float* out; unsigned char* ws; int ph_lo, ph_hi; };
__global__ void __launch_bounds__(NTHREADS, 2) fwd_kernel(Args args) {
    extern __shared__ __attribute__((aligned(16))) unsigned char lds_raw[];
    Frame F;
    F.lds = (LAS unsigned char*)lds_raw;
    F.MISC = (volatile LAS unsigned*)(F.lds + MISC_OFF);
    F.tid = threadIdx.x; F.lane = F.tid & 63; F.wave = __builtin_amdgcn_readfirstlane(F.tid >> 6);
    F.G = gridDim.x; { const int bx = blockIdx.x; F.vcu = (F.G % 8 == 0) ? (bx % 8) * (F.G / 8) + bx / 8 : bx; }
    F.in = (const float* const __attribute__((address_space(4)))*)__builtin_amdgcn_kernarg_segment_ptr();
    F.out = args.out; F.ws = args.ws; F.ctl = (unsigned*)(args.ws + WS_CTL);
    if (F.tid < 64) ((LAS unsigned*)(F.lds + MISC_OFF))[F.tid] = 0u;
    __syncthreads();
    const int lo = args.ph_lo, hi = args.ph_hi;
    const bool multi = (hi - lo) > 1;
    XcdBarrier bar; bar.bar = F.ctl + CW_BAR; bar.x = 0; bar.st = nullptr;
    if (multi) bar = xcd_barrier_post(F.ctl + CW_BAR, F.MISC + 8);
#ifndef PH_MASK
#define PH_MASK 0x7fff
#endif
#define IN(k) ((((PH_MASK) >> (k)) & 1) && lo <= (k) && (k) < hi)
#define SEAM(k) do { if (IN((k) + 1)) xcd_barrier(bar); } while (0)
    bf16* HN = (bf16*)(F.ws + WS_HN);
    if (IN(0)) { p0_prologue(F); SEAM(0); }
    if (IN(1)) { pg8::Gemm g{HN, (const bf16*)(F.ws + WS_WIN0), NT, EVEN_IN, DM}; pg8::StaticOrder S; S.init(NT, EVEN_IN, F.G, (int)blockIdx.x);
        EpiIn0 E{(bf16*)(F.ws + S0_Q), (bf16*)(F.ws + S0_K), (bf16*)(F.ws + S0_VT), (bf16*)(F.ws + S0_GLU)};
        pg8::gemm_phase<EpiIn0, pg8::StaticOrder, true, true>(F.lds, g, S, E); SEAM(1); }
    if (IN(2)) { att::p2_attn_conv(F); SEAM(2); }
    if (IN(3)) { pg8::Gemm g{(const bf16*)(F.ws + S0_CAT), (const bf16*)(F.ws + WS_WOUT0), NT, DM, DM}; pg8::StaticOrder S; S.init(NT, DM, F.G, (int)blockIdx.x);
        EpiRes E{F.in[I_X], F.out, HN, (float*)(F.ws + WS_ROWSQ0)};
        pg8::gemm_phase<EpiRes, pg8::StaticOrder, true, true>(F.lds, g, S, E); SEAM(3); }
    if (IN(4)) { pg8::Gemm g{HN, (const bf16*)(F.ws + WS_WQ0), NT, PQ_N, DM}; pg8::StaticOrder S; S.init(NT, PQ_N, F.G, (int)blockIdx.x);
        EpiPq E{(bf16*)(F.ws + SP_PQ), (const float*)(F.ws + WS_ROWSQ0)};
        pg8::gemm_phase<EpiPq, pg8::StaticOrder, true, true>(F.lds, g, S, E); SEAM(4); }
    if (IN(5)) { peer::topk_phase(F, 0); SEAM(5); }
    if (IN(6)) { peer::experts_phase(F, 0); SEAM(6); }
    if (IN(7)) { pg8::Gemm g{HN, (const bf16*)(F.ws + WS_WIN1), NT, ODD_IN_PAD, DM}; pg8::StaticOrder S; S.init(NT, ODD_IN_PAD, F.G, (int)blockIdx.x);
        EpiIn1 E{(bf16*)(F.ws + S1_Q), (bf16*)(F.ws + S1_K), (bf16*)(F.ws + S1_V), (bf16*)(F.ws + S1_G), (float*)(F.ws + S1_Z)};
        pg8::gemm_phase<EpiIn1, pg8::StaticOrder, true, true>(F.lds, g, S, E); SEAM(7); }
    if (IN(8)) { for (int a = F.vcu; a < 2048; a += F.G) gla::prep_unit(F, a); SEAM(8); }
    if (IN(9)) { gla::scan_phase(F); SEAM(9); }
    if (IN(10)) { gla::post_phase(F); SEAM(10); }
    if (IN(11)) { pg8::Gemm g{HN, (const bf16*)(F.ws + WS_WOUT1), NT, DM, DM}; pg8::StaticOrder S; S.init(NT, DM, F.G, (int)blockIdx.x);
        EpiRes E{F.out, F.out, (bf16*)(F.ws + S1_G), (float*)(F.ws + WS_ROWSQ1)};
        pg8::gemm_phase<EpiRes, pg8::StaticOrder, true, true>(F.lds, g, S, E); SEAM(11); }
    if (IN(12)) { pg8::Gemm g{(const bf16*)(F.ws + S1_G), (const bf16*)(F.ws + WS_WQ1), NT, PQ_N, DM}; pg8::StaticOrder S; S.init(NT, PQ_N, F.G, (int)blockIdx.x);
        EpiPq E{(bf16*)(F.ws + SP_PQ), (const float*)(F.ws + WS_ROWSQ1)};
        pg8::gemm_phase<EpiPq, pg8::StaticOrder, true, true>(F.lds, g, S, E); SEAM(12); }
    if (IN(13)) { peer::topk_phase(F, 1); SEAM(13); }
    if (IN(14)) { peer::experts_phase(F, 1); }
#undef IN
#undef SEAM
}

#ifndef N_LAUNCH_SPLIT
#define N_LAUNCH_SPLIT 0
#endif
extern "C" void kernel_launch(void* const* d_in, const int* in_sizes, int n_in, void* d_out, int out_size, void* d_ws, size_t ws_size, hipStream_t stream) {
    static int grid = 0;
    if (grid == 0) {
        if (n_in != 25 || out_size != NT * DM || ws_size < WS_END) { fprintf(stderr, "kernel_launch: unexpected shapes (n_in %d out %d ws %zu)\n", n_in, out_size, ws_size); grid = -1; return; }
        int dev = 0, cus = 0;
        if (hipGetDevice(&dev) != hipSuccess || hipDeviceGetAttribute(&cus, hipDeviceAttributeMultiprocessorCount, dev) != hipSuccess) { grid = -1; return; }
        if (hipFuncSetAttribute((const void*)fwd_kernel, hipFuncAttributeMaxDynamicSharedMemorySize, LDS_BYTES) != hipSuccess) { fprintf(stderr, "kernel_launch: hipFuncSetAttribute failed\n"); grid = -1; return; }
        int per_cu = 0;
        if (hipOccupancyMaxActiveBlocksPerMultiprocessor(&per_cu, (const void*)fwd_kernel, NTHREADS, LDS_BYTES) != hipSuccess || per_cu < 1) fprintf(stderr, "kernel_launch: occupancy query says %d\n", per_cu);
        (void)hipGetLastError();
        grid = cus;
    }
    if (grid < 0) return;
    (void)hipMemsetAsync((char*)d_ws + WS_CTL, 0, CTL_ZERO_BYTES, stream);
    Args a{};
    for (int i = 0; i < 25; ++i) a.in[i] = (const float*)d_in[i];
    a.out = (float*)d_out; a.ws = (unsigned char*)d_ws;
#if N_LAUNCH_SPLIT
    for (int p = 0; p < N_PHASES; ++p) { a.ph_lo = p; a.ph_hi = p + 1; hipLaunchKernelGGL(fwd_kernel, dim3(grid), dim3(NTHREADS), LDS_BYTES, stream, a); }
#else
    a.ph_lo = 0; a.ph_hi = N_PHASES; hipLaunchKernelGGL(fwd_kernel, dim3(grid), dim3(NTHREADS), LDS_BYTES, stream, a);
#endif
}
```

```cpp
#include <hip/hip_runtime.h>
#include <cstdio>
#include <cstdint>
#ifndef PROBE_REP_ATTN
#define PROBE_REP_ATTN 1
#define PROBE_REP_SCAN 1
#define PROBE_REP_TOPK 1
#endif
__device__ __forceinline__ int lane_now() { int l; asm volatile("v_mbcnt_lo_u32_b32 %0, -1, 0\n\tv_mbcnt_hi_u32_b32 %0, -1, %0" : "=v"(l)); return l; }
namespace pg8 {
#define PG8_LAS __attribute__((address_space(3)))
typedef unsigned short bf16_t;
typedef short bf16x8 __attribute__((ext_vector_type(8)));
typedef float f32x4 __attribute__((ext_vector_type(4)));
typedef unsigned u32x4 __attribute__((ext_vector_type(4)));
constexpr int BM = 256, BK = 64, HALF = 128, HTB = HALF * BK * 2  , STAGE_BYTES = 8 * HTB, NXCD = 8, WGM = 8;

__host__ __device__ __forceinline__ int lds_byte(int r, int c) { const int st = (r >> 4) * 2 + (c >> 5), rr = r & 15, cc = c & 31, ob = rr * 64 + cc * 2; return st * 1024 + (ob ^ (((ob >> 9) & 1) << 5)); }
__host__ __device__ __forceinline__ void stage_rc(int b, int& R, int& C) { const int st = b / 1024, sb = b % 1024, swz = sb ^ (((sb >> 9) & 1) << 5); R = (st >> 1) * 16 + swz / 64; C = (st & 1) * 32 + (swz % 64) / 2; }
__host__ __device__ __forceinline__ int perm32(int rho) { const int n = rho >> 4, i = rho & 15; return 8 * (i >> 2) + 4 * n + (i & 3); }

struct Unit { int pm, pn; };
struct Gemm { const bf16_t* A; const bf16_t* Bt; int M, N, K; };

struct StaticOrder {
    int nM, nN, nwg, G, c;
    __host__ __device__ void init(int M, int N, int G_, int c_) { nM = M / BM; nN = N / BM; nwg = nM * nN; G = G_; c = c_; }
    __host__ __device__ bool next(int i, Unit& u) const {
        const long L = (long)i * G + c; if (L >= nwg) return false;
        int wgid = (int)L; { const int q = nwg / NXCD, r = nwg % NXCD, xcd = wgid % NXCD, off = wgid / NXCD; wgid = (xcd < r ? xcd * (q + 1) : r * (q + 1) + (xcd - r) * q) + off; }
        const int nig = WGM * nN, gid = wgid / nig, fm = gid * WGM, gsz = (nM - fm) < WGM ? (nM - fm) : WGM;
        u.pm = fm + ((wgid % nig) % gsz); u.pn = (wgid % nig) / gsz; return true;
    }
    __device__ __forceinline__ void a_ready(const Unit&) const {}
    __device__ __forceinline__ void done(const Unit&) const {}
};
__device__ __forceinline__ unsigned cvt_pk_bf16(float lo, float hi) { unsigned r; asm volatile("v_cvt_pk_bf16_f32 %0, %1, %2" : "=v"(r) : "v"(lo), "v"(hi)); return r; }
template <class Epi, class Sched, bool ALIGN_EPI = false, bool SP2 = false>
__device__ __forceinline__ void gemm_phase(PG8_LAS unsigned char* lds, const Gemm g, const Sched& S, const Epi& E, const int wid_in) {
    const int wid = __builtin_amdgcn_readfirstlane(wid_in), lane = lane_now(), tid = wid * 64 + lane, wr = wid >> 2, wc = wid & 3, fr = lane & 15, fq = lane >> 4;
    const int K = g.K, nt = K / BK;
    unsigned voffA[2], voffB[2];
#pragma unroll
    for (int i = 0; i < 2; ++i) { int R, C; stage_rc(tid * 16 + i * 8192, R, C); const int Rb = Epi::PERM ? ((R & ~31) + perm32(R & 31)) : R;
        voffA[i] = (unsigned)(R * K + C) * 2u; voffB[i] = (unsigned)(Rb * K + C) * 2u; }
    const size_t kstep = (size_t)(BK * 2);
    const size_t hstep = (size_t)HALF * K * 2;
    const size_t tstep = 2 * hstep;
    const unsigned ldsw = (unsigned)wid * 1024u;
    const int aoff = lds_byte(wr * 64 + fr, fq * 8), boff = lds_byte(wc * 32 + fr, fq * 8);
#define PG8_SA(b, h) (((b) * 2 + (h)) * HTB)
#define PG8_SB(b, h) ((4 + (b) * 2 + (h)) * HTB)
#define PG8_STAGE(bufoff, gbase, voff) do { _Pragma("unroll") for (int _i = 0; _i < 2; ++_i) \
        __builtin_amdgcn_global_load_lds((const unsigned*)((const char*)(gbase) + (voff)[_i]), (PG8_LAS unsigned*)(lds + (bufoff) + ldsw + _i * 8192), 16, 0, 0); } while (0)
#define PG8_LDA(dst, b, h) do { _Pragma("unroll") for (int m = 0; m < 4; ++m) _Pragma("unroll") for (int k = 0; k < 2; ++k) dst[m][k] = *(const PG8_LAS bf16x8*)(lds + PG8_SA(b, h) + aoff + m * 2048 + k * 1024); } while (0)
#define PG8_LDB(dst, b, h) do { _Pragma("unroll") for (int n = 0; n < 2; ++n) _Pragma("unroll") for (int k = 0; k < 2; ++k) dst[n][k] = *(const PG8_LAS bf16x8*)(lds + PG8_SB(b, h) + boff + n * 2048 + k * 1024); } while (0)
#define PG8_MMA(ai, bj, At, Bt) do { __builtin_amdgcn_s_setprio(1); _Pragma("unroll") for (int m = 0; m < 4; ++m) _Pragma("unroll") for (int n = 0; n < 2; ++n) _Pragma("unroll") for (int k = 0; k < 2; ++k) \
        acc[ai][bj][m][n] = __builtin_amdgcn_mfma_f32_16x16x32_bf16(Bt[n][k], At[m][k], acc[ai][bj][m][n], 0, 0, 0); __builtin_amdgcn_s_setprio(0); } while (0)
#define PG8_WAIT_V(n) asm volatile("s_waitcnt vmcnt(" #n ")" ::: "memory")
#define PG8_WAIT_L(n) asm volatile("s_waitcnt lgkmcnt(" #n ")" ::: "memory")
#define PG8_BAR __builtin_amdgcn_s_barrier()
#define PG8_SCHED __builtin_amdgcn_sched_barrier(0)
    Unit cur, nxt; int ui = 0;
    if (!S.next(0, cur)) return;
    f32x4 acc[2][2][4][2];
#pragma unroll
    for (int a = 0; a < 2; ++a)
#pragma unroll
        for (int b = 0; b < 2; ++b)
#pragma unroll
            for (int m = 0; m < 4; ++m)
#pragma unroll
                for (int n = 0; n < 2; ++n) acc[a][b][m][n] = (f32x4){0.f, 0.f, 0.f, 0.f};
    bf16x8 At[4][2], B0[2][2], B1[2][2];
    const char* cA = (const char*)g.A + (size_t)cur.pm * tstep; const char* cB = (const char*)g.Bt + (size_t)cur.pn * tstep;
    S.a_ready(cur);
    if constexpr (SP2) {
        PG8_STAGE(PG8_SB(0, 0), cB, voffB); PG8_STAGE(PG8_SB(0, 1), cB + hstep, voffB); PG8_STAGE(PG8_SA(0, 0), cA, voffA); PG8_STAGE(PG8_SA(0, 1), cA + hstep, voffA);
        if (wr == 1) PG8_BAR;
        PG8_WAIT_V(2); PG8_BAR;
        PG8_STAGE(PG8_SB(1, 0), cB + kstep, voffB); PG8_STAGE(PG8_SA(1, 0), cA + kstep, voffA); PG8_STAGE(PG8_SB(1, 1), cB + hstep + kstep, voffB);
        PG8_WAIT_V(6); PG8_BAR;
    } else {
        PG8_STAGE(PG8_SB(0, 0), cB, voffB); PG8_STAGE(PG8_SA(0, 0), cA, voffA); PG8_STAGE(PG8_SB(0, 1), cB + hstep, voffB); PG8_STAGE(PG8_SA(0, 1), cA + hstep, voffA);
        if (wr == 1) PG8_BAR;
        PG8_WAIT_V(4); PG8_BAR;
        PG8_STAGE(PG8_SB(1, 0), cB + kstep, voffB); PG8_STAGE(PG8_SA(1, 0), cA + kstep, voffA); PG8_STAGE(PG8_SB(1, 1), cB + hstep + kstep, voffB);
        PG8_WAIT_V(6); PG8_BAR;
    }
    for (;;) {
        const bool has_next = S.next(ui + 1, nxt);
        const char* nA = has_next ? (const char*)g.A + (size_t)nxt.pm * tstep : cA; const char* nB = has_next ? (const char*)g.Bt + (size_t)nxt.pn * tstep : cB;
        for (int t = 0; t < nt; t += 2) {
            const bool last = (t == nt - 2);
            const char* a1 = cA + (size_t)(t + 1) * kstep;
            const char* a2 = last ? nA : cA + (size_t)(t + 2) * kstep; const char* b2 = last ? nB : cB + (size_t)(t + 2) * kstep;
            const char* a3 = a2 + kstep; const char* b3 = b2 + kstep;
            if (last && has_next) S.a_ready(nxt);
            if constexpr (SP2) {
            PG8_LDB(B0, 0, 0); PG8_LDB(B1, 0, 1); PG8_SCHED; PG8_LDA(At, 0, 0); PG8_STAGE(PG8_SA(1, 1), a1 + hstep, voffA);
            PG8_WAIT_V(8); PG8_WAIT_L(0); PG8_BAR; PG8_MMA(0, 0, At, B0); PG8_MMA(0, 1, At, B1); PG8_BAR; PG8_SCHED;
            PG8_LDA(At, 0, 1); PG8_STAGE(PG8_SB(0, 0), b2, voffB); PG8_STAGE(PG8_SB(0, 1), b2 + hstep, voffB); PG8_STAGE(PG8_SA(0, 0), a2, voffA);
            PG8_WAIT_V(8); PG8_WAIT_L(0); PG8_BAR; PG8_MMA(1, 0, At, B0); PG8_MMA(1, 1, At, B1); PG8_BAR; PG8_SCHED;
            PG8_LDB(B0, 1, 0); PG8_LDB(B1, 1, 1); PG8_SCHED; PG8_LDA(At, 1, 0); PG8_STAGE(PG8_SA(0, 1), a2 + hstep, voffA);
            PG8_WAIT_V(8); PG8_WAIT_L(0); PG8_BAR; PG8_MMA(0, 0, At, B0); PG8_MMA(0, 1, At, B1); PG8_BAR; PG8_SCHED;
            PG8_LDA(At, 1, 1); PG8_STAGE(PG8_SB(1, 0), b3, voffB); PG8_STAGE(PG8_SB(1, 1), b3 + hstep, voffB); PG8_STAGE(PG8_SA(1, 0), a3, voffA);
            PG8_WAIT_V(8); PG8_WAIT_L(0); PG8_BAR; PG8_MMA(1, 0, At, B0); PG8_MMA(1, 1, At, B1); PG8_BAR; PG8_SCHED;
            } else {
            PG8_LDB(B0, 0, 0); PG8_SCHED; PG8_LDA(At, 0, 0); PG8_STAGE(PG8_SA(1, 1), a1 + hstep, voffA);
            PG8_WAIT_L(8); PG8_BAR; PG8_WAIT_L(0); PG8_MMA(0, 0, At, B0); PG8_BAR; PG8_SCHED;
            PG8_LDB(B1, 0, 1); PG8_STAGE(PG8_SB(0, 0), b2, voffB);
            PG8_BAR; PG8_WAIT_L(0); PG8_MMA(0, 1, At, B1); PG8_BAR;
            PG8_LDA(At, 0, 1); PG8_STAGE(PG8_SA(0, 0), a2, voffA);
            PG8_BAR; PG8_WAIT_L(0); PG8_MMA(1, 0, At, B0); PG8_BAR; PG8_SCHED;
            PG8_STAGE(PG8_SB(0, 1), b2 + hstep, voffB);
            PG8_WAIT_V(6); PG8_BAR; PG8_MMA(1, 1, At, B1); PG8_BAR;
            PG8_LDB(B0, 1, 0); PG8_SCHED; PG8_LDA(At, 1, 0); PG8_STAGE(PG8_SA(0, 1), a2 + hstep, voffA);
            PG8_WAIT_L(8); PG8_BAR; PG8_WAIT_L(0); PG8_MMA(0, 0, At, B0); PG8_BAR; PG8_SCHED;
            PG8_LDB(B1, 1, 1); PG8_STAGE(PG8_SB(1, 0), b3, voffB);
            PG8_BAR; PG8_WAIT_L(0); PG8_MMA(0, 1, At, B1); PG8_BAR;
            PG8_LDA(At, 1, 1); PG8_STAGE(PG8_SA(1, 0), a3, voffA);
            PG8_BAR; PG8_WAIT_L(0); PG8_MMA(1, 0, At, B0); PG8_BAR; PG8_SCHED;
            PG8_STAGE(PG8_SB(1, 1), b3 + hstep, voffB);
            PG8_WAIT_V(6); PG8_BAR; PG8_MMA(1, 1, At, B1); PG8_BAR;
            }
        }
        if constexpr (ALIGN_EPI) { if (wr == 0) PG8_BAR; }
        if constexpr (!Epi::AFTER_DRAIN) { E(acc, cur, wr, wc, fr, fq); S.done(cur); }
        if (!has_next) break;
#pragma unroll
        for (int a = 0; a < 2; ++a)
#pragma unroll
            for (int b = 0; b < 2; ++b)
#pragma unroll
                for (int m = 0; m < 4; ++m)
#pragma unroll
                    for (int n = 0; n < 2; ++n) acc[a][b][m][n] = (f32x4){0.f, 0.f, 0.f, 0.f};
        cur = nxt; cA = nA; cB = nB; ++ui;
        if constexpr (ALIGN_EPI) { if (wr == 1) PG8_BAR; }
    }
    PG8_WAIT_V(0);
    if constexpr (!ALIGN_EPI) { if (wr == 0) PG8_BAR; }
    PG8_BAR;
    if constexpr (Epi::AFTER_DRAIN) { E.fused(acc, cur, wr, wc, fr, fq, lds, wid, lane); S.done(cur); }
#undef PG8_SA
#undef PG8_SB
#undef PG8_STAGE
#undef PG8_LDA
#undef PG8_LDB
#undef PG8_MMA
#undef PG8_WAIT_V
#undef PG8_WAIT_L
#undef PG8_BAR
#undef PG8_SCHED
}
}

constexpr int NB = 4, SEQ = 8192, DM = 1024, NT = NB * SEQ;
constexpr int EVEN_IN = 2560, ODD_IN = 3088, ODD_IN_PAD = 3328, PQ_N = 2048;
constexpr int NEXP = 16384;
constexpr float EPS = 1e-6f;
constexpr float LOG2E = 1.4426950408889634f;
constexpr float QSCALE_ATT = 0.125f * LOG2E;
constexpr float QSCALE_GLA = 0.08838834764831845f;
constexpr float LAM_INIT0 = 0.2f;
constexpr float U_SCALE = 1024.f, V_SCALE = 128.f;

constexpr size_t MiB = 1u << 20;
constexpr size_t WS_CTL = 0, CTL_ZERO_BYTES = 32 * 1024;
constexpr size_t WS_ROWSQ0 = 27 * MiB, WS_ROWSQ1 = 29 * MiB;
constexpr size_t WS_DEC = 1 * MiB;
constexpr size_t WS_WIN0 = 2 * MiB, WS_WOUT0 = 7 * MiB, WS_WIN1 = 9 * MiB, WS_WOUT1 = 16 * MiB, WS_WQ0 = 18 * MiB, WS_WQ1 = 22 * MiB, WS_SK = 26 * MiB;
constexpr size_t WS_UT = 32 * MiB, WS_VT = 96 * MiB;
constexpr size_t WS_HN = 160 * MiB;
constexpr size_t WS_IDS = 224 * MiB, WS_GATE = 240 * MiB;
constexpr size_t WS_SCR = 256 * MiB;
constexpr size_t WS_XRES = 448 * MiB;
constexpr size_t S0_Q = WS_SCR, S0_K = WS_SCR + 32 * MiB, S0_VT = WS_SCR + 64 * MiB, S0_GLU = WS_SCR + 96 * MiB, S0_CAT = WS_SCR + 128 * MiB;
constexpr size_t SP_PQ = WS_SCR;
constexpr size_t S1_Q = WS_SCR, S1_K = WS_SCR + 32 * MiB, S1_V = WS_SCR + 64 * MiB, S1_G = WS_SCR + 128 * MiB, S1_Z = 27 * MiB;
constexpr size_t WS_LSEG = WS_IDS;
constexpr size_t WS_PSEG = 768 * 1024;
constexpr size_t WS_RSV = 512 * 1024;
constexpr size_t WS_XH8 = 64 * MiB, WS_XL8 = 128 * MiB;
constexpr size_t WS_RS8 = 31 * MiB;
constexpr size_t SP_PART = WS_SCR;
constexpr size_t WS_CH8 = 1 * MiB, WS_CL8 = 5 * MiB;
constexpr size_t WS_END = 512 * MiB;

constexpr int LDS_BYTES = 155648;
constexpr int MISC_OFF = LDS_BYTES - 256;
constexpr int NWAVES = 8, NTHREADS = 512;

#define GAS __attribute__((address_space(1)))
#define LAS __attribute__((address_space(3)))
typedef unsigned short bf16;
typedef unsigned v4u __attribute__((ext_vector_type(4)));
typedef unsigned v2u __attribute__((ext_vector_type(2)));
typedef float f32x4 __attribute__((ext_vector_type(4)));
typedef float f32x16 __attribute__((ext_vector_type(16)));
typedef short bf16x8 __attribute__((ext_vector_type(8)));
typedef short v4s16 __attribute__((ext_vector_type(4)));
typedef int v8i_t __attribute__((ext_vector_type(8)));
typedef float f32x2_t __attribute__((ext_vector_type(2)));
typedef __bf16 bf16x2_t __attribute__((ext_vector_type(2)));
#define LDS_WAIT() asm volatile("s_waitcnt lgkmcnt(0)" ::: "memory")
#define VM_WAIT() asm volatile("s_waitcnt vmcnt(0)" ::: "memory")
__device__ __forceinline__ unsigned pk2(float lo, float hi) { f32x2_t v = {lo, hi}; bf16x2_t b = __builtin_convertvector(v, bf16x2_t); return __builtin_bit_cast(unsigned, b); }
__device__ __forceinline__ float bf_lo(unsigned w) { return __builtin_bit_cast(float, w << 16); }
__device__ __forceinline__ float bf_hi(unsigned w) { return __builtin_bit_cast(float, w & 0xffff0000u); }
__device__ __forceinline__ float bf2f(bf16 v) { return __builtin_bit_cast(float, (unsigned)v << 16); }
__device__ __forceinline__ bf16 f2bf(float f) { return (bf16)(pk2(f, 0.f) & 0xffffu); }
template <int CTRL, int ROWMASK>
__device__ __forceinline__ float dpp_get(float v) { return __builtin_bit_cast(float, __builtin_amdgcn_update_dpp(0, __builtin_bit_cast(int, v), CTRL, ROWMASK, 0xf, false)); }
__device__ __forceinline__ float row16_sum(float v) {
    v += dpp_get<0xB1, 0xf>(v); v += dpp_get<0x4E, 0xf>(v); v += dpp_get<0x124, 0xf>(v); v += dpp_get<0x128, 0xf>(v); return v;
}
__device__ __forceinline__ float wave_sum(float v) {
    v += dpp_get<0xB1, 0xf>(v);
    v += dpp_get<0x4E, 0xf>(v);
    v += dpp_get<0x124, 0xf>(v);
    v += dpp_get<0x128, 0xf>(v);
    v += dpp_get<0x142, 0xa>(v);
    v += dpp_get<0x143, 0xc>(v);
    return __builtin_bit_cast(float, __builtin_amdgcn_readlane(__builtin_bit_cast(int, v), 63));
}
__device__ __forceinline__ float vmax3(float a, float b, float c) { float r; asm("v_max3_f32 %0, %1, %2, %3" : "=v"(r) : "v"(a), "v"(b), "v"(c)); return r; }
__device__ __forceinline__ float fast_exp2(float x) { return __builtin_amdgcn_exp2f(x); }
__device__ __forceinline__ float fast_rcp(float x) { return __builtin_amdgcn_rcpf(x); }
__device__ __forceinline__ float sigmoidf_(float x) { return fast_rcp(1.f + fast_exp2(-x * LOG2E)); }
__device__ __forceinline__ float siluf_(float x) { return x * sigmoidf_(x); }
#define XB_TMO      128
#define XB_XCNT(j)  (256  + 64 * (j))
#define XB_XSUB(j)  (1280 + 64 * (j))
#define XB_XGEN(j)  (2304 + 64 * (j))
#define XB_TOP      3328
#define XB_TOPGEN   3392
#define XCD_BAR_WORDS 3456
#define XB_SPIN_CAP (1u << 18)

__device__ __forceinline__ unsigned xb_ld(unsigned* p)              { return __hip_atomic_load(p, __ATOMIC_RELAXED, __HIP_MEMORY_SCOPE_AGENT); }
__device__ __forceinline__ unsigned xb_add(unsigned* p, unsigned v) { return __hip_atomic_fetch_add(p, v, __ATOMIC_RELAXED, __HIP_MEMORY_SCOPE_AGENT); }
__device__ __forceinline__ unsigned xb_xcc_id() { return (unsigned)__builtin_amdgcn_s_getreg((3 << 11) | 20) & 0xFu; }
#define XB_SPIN(cond, bar) do { unsigned _sp = 0; while (cond) { __builtin_amdgcn_s_sleep(1); \
    if ((++_sp & 255u) == 0u) { if (xb_ld(&(bar)[XB_TMO])) break; if (_sp > XB_SPIN_CAP) { atomicAdd(&(bar)[XB_TMO], 1u); break; } } } } while (0)

struct XcdBarrier {
    unsigned* bar; unsigned x;
    unsigned w;
    volatile LAS unsigned* st;
};

__device__ __forceinline__ XcdBarrier xcd_barrier_post(unsigned* bar, volatile LAS unsigned* st) {
    XcdBarrier b; b.bar = bar; b.x = xb_xcc_id(); b.st = st; b.w = (unsigned)__builtin_amdgcn_readfirstlane(threadIdx.x >> 6);
    if (threadIdx.x == 0) (void)xb_add(&bar[XB_XCNT(b.x)], 1u);
    return b;
}
__device__ __forceinline__ void xcd_barrier_complete(unsigned* bar, unsigned x, unsigned& nloc, unsigned& nx) {
    const unsigned G = gridDim.x * gridDim.y * gridDim.z;
    unsigned sum, cnt, mine, sp = 0u;
    for (;;) {
        sum = 0u; cnt = 0u; mine = 0u;
#pragma unroll
        for (unsigned j = 0; j < 16; ++j) { const unsigned c = xb_ld(&bar[XB_XCNT(j)]); sum += c; cnt += (c > 0u) ? 1u : 0u; mine = (j == x) ? c : mine; }
        if (sum == G) break;
        __builtin_amdgcn_s_sleep(1);
        if ((++sp & 255u) == 0u) { if (xb_ld(&bar[XB_TMO])) break; if (sp > XB_SPIN_CAP) { atomicAdd(&bar[XB_TMO], 1u); break; } }
    }
    nloc = mine > 0u ? mine : 1u; nx = cnt > 0u ? cnt : 1u;
}

__device__ __forceinline__ void xcd_barrier(const XcdBarrier& b) {
    asm volatile("s_waitcnt vmcnt(0)" ::: "memory");
    __syncthreads();
    if (b.w == 0u && lane_now() == 0) {
        unsigned* bar = b.bar;
        __builtin_amdgcn_s_waitcnt(0);
        unsigned nloc = b.st[0], nx = b.st[1];
        const unsigned old = xb_add(&bar[XB_XSUB(b.x)], 1u);
        const unsigned gen = old / nloc;
        if (old + 1u == (gen + 1u) * nloc) {
            __builtin_amdgcn_fence(__ATOMIC_RELEASE, "agent");
            asm volatile("s_waitcnt vmcnt(0)" ::: "memory");
            const unsigned og = xb_add(&bar[XB_TOP], 1u);
            const unsigned tg = og / nx;
            if (og + 1u == (tg + 1u) * nx) xb_add(&bar[XB_TOPGEN], 1u);
            else XB_SPIN(xb_ld(&bar[XB_TOPGEN]) == tg, bar);
            __builtin_amdgcn_fence(__ATOMIC_ACQUIRE, "agent");
            xb_add(&bar[XB_XGEN(b.x)], 1u);
            asm volatile("s_waitcnt vmcnt(0)" ::: "memory");
        } else {
            XB_SPIN(xb_ld(&bar[XB_XGEN(b.x)]) == gen, bar);
            __builtin_amdgcn_fence(__ATOMIC_ACQUIRE, "agent");
            asm volatile("s_waitcnt vmcnt(0)" ::: "memory");
        }
    }
    __syncthreads();
}

struct Frame {
    LAS unsigned char* lds;
    volatile LAS unsigned* MISC;
    unsigned* ctl;
    int tid, lane, wave;
    int vcu, G;
    int xcc, xrank;
    const float* const __attribute__((address_space(4)))* in;
    float* out;
    unsigned char* ws;
};
enum { I_X = 0, I_RELB, I_LNMIX, I_LNFFN, I_EWIN, I_LQ1, I_LK1, I_LQ2, I_LK2, I_SUBLN, I_CONVW, I_CONVB, I_CLNG, I_CLNB, I_EWOUT, I_OWIN, I_WG2, I_BG2, I_GLAG, I_OWOUT, I_PWQ, I_PSK, I_PU, I_PV, I_LNF };

__device__ __forceinline__ void p0_transpose_item(const float* W, int Nsrc, bf16* WT, int kb, int dstrow0, int srccol0, const float* gain, LAS float* scr, int lane) {
    const int k0 = 64 * kb; const int col = srccol0 + (lane & 31); const bool ok = col < Nsrc; const int colc = ok ? col : 0;
    const float* wp = W + (size_t)(k0 + (lane >> 5)) * Nsrc + colc;
#pragma unroll 8
    for (int i = 0; i < 32; ++i) { const float v = wp[(size_t)(2 * i) * Nsrc]; scr[(2 * i + (lane >> 5)) * 33 + (lane & 31)] = ok ? v : 0.f; }
    LDS_WAIT(); asm volatile("" ::: "memory");
    const int c = lane & 7;
    f32x4 g0 = {1.f, 1.f, 1.f, 1.f}, g1 = {1.f, 1.f, 1.f, 1.f};
    if (gain) { g0 = *(const f32x4*)(gain + k0 + 8 * c); g1 = *(const f32x4*)(gain + k0 + 8 * c + 4); }
#pragma unroll
    for (int j = 0; j < 4; ++j) { const int n = (lane >> 3) + 8 * j; const LAS float* s = scr + (8 * c) * 33 + n;
        v4u o; o.x = pk2(s[0 * 33] * g0.x, s[1 * 33] * g0.y); o.y = pk2(s[2 * 33] * g0.z, s[3 * 33] * g0.w); o.z = pk2(s[4 * 33] * g1.x, s[5 * 33] * g1.y); o.w = pk2(s[6 * 33] * g1.z, s[7 * 33] * g1.w);
        *(v4u*)(WT + (size_t)(dstrow0 + n) * 1024 + k0 + 8 * c) = o; }
    LDS_WAIT(); asm volatile("" ::: "memory");
}
__device__ __forceinline__ int win0_src(int dstrow) { if (dstrow < 1536) return dstrow; const int r = dstrow - 1536, j = r >> 8, half = (r >> 7) & 1, i = r & 127; return 1536 + 512 * half + 128 * j + i; }

__device__ __forceinline__ void rms_row_to_bf16(const float* xrow, const float* g, bf16* orow, int lane) {
    const f32x4* xr = (const f32x4*)xrow + lane; const f32x4* gr = (const f32x4*)g + lane;
    f32x4 v[4]; float s = 0.f;
#pragma unroll
    for (int j = 0; j < 4; ++j) { v[j] = xr[64 * j]; s += (v[j].x * v[j].x + v[j].y * v[j].y) + (v[j].z * v[j].z + v[j].w * v[j].w); }
    const float r = 1.f / sqrtf(wave_sum(s) * (1.f / DM) + EPS);
    v2u* o8 = (v2u*)orow + lane;
#pragma unroll
    for (int j = 0; j < 4; ++j) { const f32x4 gg = gr[64 * j]; v2u w; w.x = pk2(v[j].x * r * gg.x, v[j].y * r * gg.y); w.y = pk2(v[j].z * r * gg.z, v[j].w * r * gg.w); o8[64 * j] = w; }
}
__device__ __forceinline__ void cvt_stream_bf16(const float* src, bf16* dst, size_t n, int gtid, int gthreads) {
    const size_t n8 = n >> 3;
    for (size_t i = gtid; i < n8; i += gthreads) { const f32x4 a = ((const f32x4*)src)[2 * i], b = ((const f32x4*)src)[2 * i + 1];
        v4u o; o.x = pk2(a.x, a.y); o.y = pk2(a.z, a.w); o.z = pk2(b.x, b.y); o.w = pk2(b.z, b.w); ((v4u*)dst)[i] = o; }
}
__device__ __forceinline__ unsigned pk_fp8x4(float a, float b, float c, float d) { int w = __builtin_amdgcn_cvt_pk_fp8_f32(a, b, 0, false); w = __builtin_amdgcn_cvt_pk_fp8_f32(c, d, w, true); return (unsigned)w; }
template <bool GAIN>
__device__ __forceinline__ void cvt_table_item(const float* src, unsigned char* dst, float sc, const float* gain, size_t i, const f32x4 (&in)[4]) {
    f32x4 a = in[0] * sc, b = in[1] * sc, c = in[2] * sc, d = in[3] * sc;
    if (GAIN) { const float* gp = gain + ((i >> 6) >> 14) * DM + (i & 63) * 16; a = a * *(const f32x4*)gp; b = b * *(const f32x4*)(gp + 4); c = c * *(const f32x4*)(gp + 8); d = d * *(const f32x4*)(gp + 12); }
    v4u o; o.x = pk_fp8x4(a.x, a.y, a.z, a.w); o.y = pk_fp8x4(b.x, b.y, b.z, b.w); o.z = pk_fp8x4(c.x, c.y, c.z, c.w); o.w = pk_fp8x4(d.x, d.y, d.z, d.w);
    const size_t row = i >> 6, col16 = i & 63, layer = row >> 14, e = row & (NEXP - 1), sl = col16 >> 3, pc = col16 & 7;
    *(v4u*)(dst + (((layer * 8 + sl) * NEXP + e) * 128 + pc * 16)) = o;
}
template <bool GAIN>
__device__ __forceinline__ void cvt_table_fp8(const float* src, unsigned char* dst, float sc, const float* gain  , int gtid, int gthreads) {
    const size_t n16 = ((size_t)2 * NEXP * DM) >> 4;
    size_t i = gtid;
#pragma unroll 1
    for (; i + 3 * (size_t)gthreads < n16; i += 4 * (size_t)gthreads) {
        f32x4 in[4][4];
#pragma unroll
        for (int u = 0; u < 4; ++u)
#pragma unroll
            for (int q = 0; q < 4; ++q) in[u][q] = ((const f32x4*)src)[4 * (i + (size_t)u * gthreads) + q];
#pragma unroll
        for (int u = 0; u < 4; ++u) cvt_table_item<GAIN>(src, dst, sc, gain, i + (size_t)u * gthreads, in[u]);
    }
#pragma unroll 1
    for (; i < n16; i += gthreads) { f32x4 in[4];
#pragma unroll
        for (int q = 0; q < 4; ++q) in[q] = ((const f32x4*)src)[4 * i + q];
        cvt_table_item<GAIN>(src, dst, sc, gain, i, in); }
}
__device__ __forceinline__ bf16x8 ld8_f32_bf16(const float* p) { const f32x4 a = *(const f32x4*)p, b = *(const f32x4*)(p + 4); v4u o; o.x = pk2(a.x, a.y); o.y = pk2(a.z, a.w); o.z = pk2(b.x, b.y); o.w = pk2(b.z, b.w); return __builtin_bit_cast(bf16x8, o); }
__device__ __forceinline__ void p0_fold_item(Frame& F, int task) {
    const int layer = task >> 10, hp = (task >> 6) & 15, cb = task & 63, fr = F.lane & 15, fq = F.lane >> 4;
    const float* Wq = F.in[I_PWQ] + (size_t)layer * DM * PQ_N + (size_t)(16 * cb + fr) * PQ_N + hp * 128 + 8 * fq;
    const float* sk = F.in[I_PSK] + (size_t)(layer * 16 + hp) * 128 * 128 + (size_t)fr * 128 + 8 * fq;
    bf16* WT = (bf16*)(F.ws + (layer ? WS_WQ1 : WS_WQ0)) + (size_t)(hp * 128 + fr) * DM + 16 * cb + 4 * fq;
    const f32x4 g = *(const f32x4*)(F.in[I_LNFFN] + layer * DM + 16 * cb + 4 * fq);
    bf16x8 af[4];
#pragma unroll
    for (int ks = 0; ks < 4; ++ks) af[ks] = ld8_f32_bf16(Wq + 32 * ks);
#pragma unroll 2
    for (int kt = 0; kt < 8; ++kt) { f32x4 acc = {0.f, 0.f, 0.f, 0.f};
#pragma unroll
        for (int ks = 0; ks < 4; ++ks) acc = __builtin_amdgcn_mfma_f32_16x16x32_bf16(af[ks], ld8_f32_bf16(sk + (size_t)kt * 16 * 128 + 32 * ks), acc, 0, 0, 0);
        v2u o; o.x = pk2(acc[0] * g.x, acc[1] * g.y); o.y = pk2(acc[2] * g.z, acc[3] * g.w);
        *(v2u*)(WT + (size_t)kt * 16 * DM) = o; }
}
__device__ __forceinline__ void p0_prologue(Frame& F) {
    LAS float* scr = (LAS float*)(F.lds + F.wave * 8704);
    const int gw = F.vcu * NWAVES + F.wave, NGW = F.G * NWAVES;
    bf16* WIN0 = (bf16*)(F.ws + WS_WIN0); bf16* WOUT0 = (bf16*)(F.ws + WS_WOUT0); bf16* WIN1 = (bf16*)(F.ws + WS_WIN1); bf16* WOUT1 = (bf16*)(F.ws + WS_WOUT1);
    constexpr int I0 = 16 * (EVEN_IN / 32), I1 = 16 * (DM / 32), I2 = 16 * (ODD_IN_PAD / 32), I3 = I1;
    constexpr int NITEMS = I0 + I1 + I2 + I3;
    for (int it = gw; it < NITEMS; it += NGW) {
        int r = it;
        if (r < I0) { const int nb = r % (EVEN_IN / 32), kb = r / (EVEN_IN / 32); p0_transpose_item(F.in[I_EWIN], EVEN_IN, WIN0, kb, 32 * nb, win0_src(32 * nb), nullptr, scr, F.lane); continue; } r -= I0;
        if (r < I1) { const int nb = r % (DM / 32), kb = r / (DM / 32); p0_transpose_item(F.in[I_EWOUT], DM, WOUT0, kb, 32 * nb, 32 * nb, nullptr, scr, F.lane); continue; } r -= I1;
        if (r < I2) { const int nb = r % (ODD_IN_PAD / 32), kb = r / (ODD_IN_PAD / 32); p0_transpose_item(F.in[I_OWIN], ODD_IN, WIN1, kb, 32 * nb, 32 * nb, F.in[I_LNMIX] + DM, scr, F.lane); continue; } r -= I2;
        { const int nb = r % (DM / 32), kb = r / (DM / 32); p0_transpose_item(F.in[I_OWOUT], DM, WOUT1, kb, 32 * nb, 32 * nb, nullptr, scr, F.lane); }
    }
    for (int it = gw; it < 2 * 16 * 64; it += NGW) p0_fold_item(F, it);
    const int gtid = F.vcu * NTHREADS + F.tid, gthreads = F.G * NTHREADS;
    bf16* HN = (bf16*)(F.ws + WS_HN);
    int m = gw;
    f32x4 g4[4];
#pragma unroll
    for (int j = 0; j < 4; ++j) g4[j] = ((const f32x4*)F.in[I_LNMIX])[F.lane + 64 * j];
#pragma unroll 1
    for (; m + 3 * NGW < NT; m += 4 * NGW) {
        f32x4 v[4][4];
#pragma unroll
        for (int u = 0; u < 4; ++u)
#pragma unroll
            for (int j = 0; j < 4; ++j) v[u][j] = ((const f32x4*)(F.in[I_X] + (size_t)(m + u * NGW) * DM))[F.lane + 64 * j];
#pragma unroll
        for (int u = 0; u < 4; ++u) { float s2 = 0.f;
#pragma unroll
            for (int j = 0; j < 4; ++j) s2 += (v[u][j].x * v[u][j].x + v[u][j].y * v[u][j].y) + (v[u][j].z * v[u][j].z + v[u][j].w * v[u][j].w);
            const float r = 1.f / sqrtf(wave_sum(s2) * (1.f / DM) + EPS);
            v2u* o8 = (v2u*)(HN + (size_t)(m + u * NGW) * DM) + F.lane;
#pragma unroll
            for (int j = 0; j < 4; ++j) { const f32x4 gg = g4[j]; v2u w; w.x = pk2(v[u][j].x * r * gg.x, v[u][j].y * r * gg.y); w.y = pk2(v[u][j].z * r * gg.z, v[u][j].w * r * gg.w); o8[64 * j] = w; } }
    }
    for (; m < NT; m += NGW) rms_row_to_bf16(F.in[I_X] + (size_t)m * DM, F.in[I_LNMIX], HN + (size_t)m * DM, F.lane);
}

__device__ __forceinline__ v4u pack8(const pg8::f32x4 a, const pg8::f32x4 b) { return (v4u){pk2(a[0], a[1]), pk2(a[2], a[3]), pk2(b[0], b[1]), pk2(b[2], b[3])}; }
struct EpiIn0 {
    static constexpr bool PERM = true, AFTER_DRAIN = false;
    bf16* Q; bf16* K; bf16* Vt; bf16* GLU;
    __device__ __forceinline__ void operator()(const pg8::f32x4 (&acc)[2][2][4][2], const pg8::Unit& u, int wr, int wc, int fr, int fq) const {
        const int pn = u.pn;
#pragma unroll
        for (int ai = 0; ai < 2; ++ai)
#pragma unroll
            for (int m = 0; m < 4; ++m) {
                const int row = u.pm * 256 + ai * 128 + wr * 64 + m * 16 + fr; const int b = row >> 13, s = row & 8191;
                if (pn < 4) {
                    bf16* base = (pn < 2) ? Q : K; const float sc = (pn < 2) ? QSCALE_ATT : 1.f;
#pragma unroll
                    for (int bj = 0; bj < 2; ++bj) { const int c = (pn & 1) * 256 + bj * 128 + wc * 32 + 8 * fq; const int h = c >> 7, mp = (c >> 6) & 1, d = c & 63;
                        *(v4u*)(base + ((((size_t)(b * 4 + h) * 2 + mp) * SEQ + s) * 64 + d)) = pack8(acc[ai][bj][m][0] * sc, acc[ai][bj][m][1] * sc); }
                } else if (pn < 6) {
#pragma unroll
                    for (int bj = 0; bj < 2; ++bj) { const int c = (pn - 4) * 256 + bj * 128 + wc * 32 + 8 * fq;
                        *(v4u*)(Vt + (size_t)row * 512 + c) = pack8(acc[ai][bj][m][0], acc[ai][bj][m][1]); }
                } else {
                    const int ch = (pn - 6) * 128 + wc * 32 + 8 * fq; pg8::f32x4 y[2];
#pragma unroll
                    for (int n = 0; n < 2; ++n) { const pg8::f32x4 a = acc[ai][0][m][n], g = acc[ai][1][m][n]; y[n] = (pg8::f32x4){a[0] * sigmoidf_(g[0]), a[1] * sigmoidf_(g[1]), a[2] * sigmoidf_(g[2]), a[3] * sigmoidf_(g[3])}; }
                    *(v4u*)(GLU + (size_t)row * 512 + ch) = pack8(y[0], y[1]);
                }
            }
    }
};
template <bool BASE_F32>
struct EpiRes {
    static constexpr bool PERM = true, AFTER_DRAIN = false;
    const float* basef; const bf16* baseh; bf16* xb; float* rowsq; unsigned char* xh8; unsigned char* xl8;
    __device__ __forceinline__ void ldbase(int q, const pg8::Unit& u, int wr, int wc, int fr, int fq, pg8::f32x4& b0, pg8::f32x4& b1, v4u& bw) const {
        const int ai = q >> 3, m = (q >> 1) & 3, bj = q & 1; const int row = u.pm * 256 + ai * 128 + wr * 64 + m * 16 + fr;
        const size_t off = (size_t)row * DM + u.pn * 256 + bj * 128 + wc * 32 + 8 * fq;
        if (BASE_F32) { b0 = *(const pg8::f32x4*)(basef + off); b1 = *(const pg8::f32x4*)(basef + off + 4); } else bw = *(const v4u*)(baseh + off);
    }
    __device__ __forceinline__ void operator()(const pg8::f32x4 (&acc)[2][2][4][2], const pg8::Unit& u, int wr, int wc, int fr, int fq) const {
        pg8::f32x4 nb0, nb1; v4u nbw; ldbase(0, u, wr, wc, fr, fq, nb0, nb1, nbw);
        float ss = 0.f;
#pragma unroll
        for (int q = 0; q < 16; ++q) {
            const int ai = q >> 3, m = (q >> 1) & 3, bj = q & 1; const int row = u.pm * 256 + ai * 128 + wr * 64 + m * 16 + fr;
            const size_t off = (size_t)row * DM + u.pn * 256 + bj * 128 + wc * 32 + 8 * fq;
            pg8::f32x4 b0, b1;
            if (BASE_F32) { b0 = nb0; b1 = nb1; } else { b0 = (pg8::f32x4){bf_lo(nbw.x), bf_hi(nbw.x), bf_lo(nbw.y), bf_hi(nbw.y)}; b1 = (pg8::f32x4){bf_lo(nbw.z), bf_hi(nbw.z), bf_lo(nbw.w), bf_hi(nbw.w)}; }
            if (q + 1 < 16) ldbase(q + 1, u, wr, wc, fr, fq, nb0, nb1, nbw);
            const pg8::f32x4 o0 = b0 + acc[ai][bj][m][0], o1 = b1 + acc[ai][bj][m][1];
            *(v4u*)(xb + off) = pack8(o0, o1);
            { const pg8::f32x4 p0 = o0 * 16.f, p1 = o1 * 16.f; const unsigned h0 = pk_fp8x4(p0[0], p0[1], p0[2], p0[3]), h1 = pk_fp8x4(p1[0], p1[1], p1[2], p1[3]);
              const f32x2_t a0 = __builtin_amdgcn_cvt_pk_f32_fp8((int)h0, false), a1 = __builtin_amdgcn_cvt_pk_f32_fp8((int)h0, true), a2 = __builtin_amdgcn_cvt_pk_f32_fp8((int)h1, false), a3 = __builtin_amdgcn_cvt_pk_f32_fp8((int)h1, true);
              *(v2u*)(xh8 + off) = (v2u){h0, h1};
              *(v2u*)(xl8 + off) = (v2u){pk_fp8x4(p0[0] - a0.x, p0[1] - a0.y, p0[2] - a1.x, p0[3] - a1.y), pk_fp8x4(p1[0] - a2.x, p1[1] - a2.y, p1[2] - a3.x, p1[3] - a3.y)}; }
            ss += ((o0[0] * o0[0] + o0[1] * o0[1]) + (o0[2] * o0[2] + o0[3] * o0[3])) + ((o1[0] * o1[0] + o1[1] * o1[1]) + (o1[2] * o1[2] + o1[3] * o1[3]));
            if (bj == 1) {
                { const unsigned x = __builtin_bit_cast(unsigned, ss); const auto pr = __builtin_amdgcn_permlane16_swap(x, x, false, false); ss = __builtin_bit_cast(float, pr[0]) + __builtin_bit_cast(float, pr[1]); }
                { const unsigned x = __builtin_bit_cast(unsigned, ss); const auto pr = __builtin_amdgcn_permlane32_swap(x, x, false, false); ss = __builtin_bit_cast(float, pr[0]) + __builtin_bit_cast(float, pr[1]); }
                if (fq == 0) rowsq[(size_t)row * 16 + u.pn * 4 + wc] = ss;
                ss = 0.f; }
        }
    }
};
__device__ __forceinline__ unsigned mono16x2(unsigned w) { return w ^ ((((w >> 15) & 0x00010001u) * 0x7fffu) | 0x80008000u); }
__device__ __forceinline__ v4u mono16x8(v4u w) { return (v4u){mono16x2(w.x), mono16x2(w.y), mono16x2(w.z), mono16x2(w.w)}; }
constexpr int EPI_LRS = pg8::STAGE_BYTES;
struct EpiPq {
    static constexpr bool PERM = true, AFTER_DRAIN = false;
    bf16* PQ; const float* rowsq; float* rsv; LAS float* lrs;
    __device__ __forceinline__ void operator()(const pg8::f32x4 (&acc)[2][2][4][2], const pg8::Unit& u, int wr, int wc, int fr, int fq) const {
        { const int tid = (wr * 4 + wc) * 64 + fq * 16 + fr;
          if (tid < 256) { const int row = u.pm * 256 + tid;
              const f32x4 q0 = *(const f32x4*)(rowsq + (size_t)row * 16), q1 = *(const f32x4*)(rowsq + (size_t)row * 16 + 4), q2 = *(const f32x4*)(rowsq + (size_t)row * 16 + 8), q3 = *(const f32x4*)(rowsq + (size_t)row * 16 + 12);
              const float rs = 1.f / sqrtf(((((q0.x + q0.y) + (q0.z + q0.w)) + ((q1.x + q1.y) + (q1.z + q1.w))) + (((q2.x + q2.y) + (q2.z + q2.w)) + ((q3.x + q3.y) + (q3.z + q3.w)))) * (1.f / DM) + EPS);
              lrs[tid] = rs; if (u.pn == 0) rsv[row] = rs; }
          asm volatile("s_waitcnt lgkmcnt(0)" ::: "memory"); __builtin_amdgcn_s_barrier(); }
#pragma unroll
        for (int ai = 0; ai < 2; ++ai)
#pragma unroll
            for (int m = 0; m < 4; ++m) {
                const int rl = ai * 128 + wr * 64 + m * 16 + fr, row = u.pm * 256 + rl;
                const float rs = lrs[rl];
#pragma unroll
                for (int bj = 0; bj < 2; ++bj) { const size_t off = (size_t)row * PQ_N + u.pn * 256 + bj * 128 + wc * 32 + 8 * fq;
                    *(v4u*)(PQ + off) = mono16x8(pack8(acc[ai][bj][m][0] * rs, acc[ai][bj][m][1] * rs)); }
            }
    }
};
struct EpiIn1 {
    static constexpr bool PERM = true, AFTER_DRAIN = false;
    bf16* Q; bf16* K; bf16* V; bf16* G; const float* rs8; LAS float* lrs;
    __device__ __forceinline__ void operator()(const pg8::f32x4 (&acc)[2][2][4][2], const pg8::Unit& u, int wr, int wc, int fr, int fq) const {
        const int pn = u.pn;
        { const int tid = (wr * 4 + wc) * 64 + fq * 16 + fr;
          if (tid < 256) { const int row = u.pm * 256 + tid;
              const f32x4 q0 = *(const f32x4*)(rs8 + (size_t)row * 8), q1 = *(const f32x4*)(rs8 + (size_t)row * 8 + 4);
              lrs[tid] = 1.f / sqrtf((((q0.x + q0.y) + (q0.z + q0.w)) + ((q1.x + q1.y) + (q1.z + q1.w))) * (1.f / DM) + EPS); }
          asm volatile("s_waitcnt lgkmcnt(0)" ::: "memory"); __builtin_amdgcn_s_barrier(); }
#pragma unroll
        for (int ai = 0; ai < 2; ++ai)
#pragma unroll
            for (int m = 0; m < 4; ++m) {
                const int rl = ai * 128 + wr * 64 + m * 16 + fr, row = u.pm * 256 + rl;
                const float rs = lrs[rl];
#pragma unroll
                for (int bj = 0; bj < 2; ++bj) { const int c = pn * 256 + bj * 128 + wc * 32 + 8 * fq; pg8::f32x4 v0 = acc[ai][bj][m][0] * rs, v1 = acc[ai][bj][m][1] * rs;
                    if (pn < 2) *(v4u*)(Q + (size_t)row * 512 + c) = pack8(v0 * QSCALE_GLA, v1 * QSCALE_GLA);
                    else if (pn < 4) *(v4u*)(K + (size_t)row * 512 + (c - 512)) = pack8(v0, v1);
                    else if (pn < 8) *(v4u*)(V + (size_t)row * 1024 + (c - 1024)) = pack8(v0, v1);
                    else { v0 = (pg8::f32x4){siluf_(v0[0]), siluf_(v0[1]), siluf_(v0[2]), siluf_(v0[3])}; v1 = (pg8::f32x4){siluf_(v1[0]), siluf_(v1[1]), siluf_(v1[2]), siluf_(v1[3])};
                        *(v4u*)(G + (size_t)row * 1024 + (c - 2048)) = pack8(v0, v1); } }
            }
    }
};
__device__ __forceinline__ void z_tail(Frame& F) {
    const int lane = F.lane, fr = lane & 15, fq = lane >> 4;
    const bf16* HN = (const bf16*)(F.ws + WS_HN); const bf16* WZ = (const bf16*)(F.ws + WS_WIN1) + (size_t)3072 * DM; const float* RS8 = (const float*)(F.ws + WS_RS8); float* Z = (float*)(F.ws + S1_Z);
    const int gw = F.vcu * NWAVES + F.wave, NGW = F.G * NWAVES;
    for (int tb = gw; tb < NT / 16; tb += NGW) {
        const int t0 = tb * 16; f32x4 acc = {0.f, 0.f, 0.f, 0.f};
        const bf16* ap = HN + (size_t)(t0 + fr) * DM + 8 * fq; const bf16* bp = WZ + (size_t)fr * DM + 8 * fq;
        f32x4 q0[4], q1[4];
#pragma unroll
        for (int r = 0; r < 4; ++r) { const int t = t0 + 4 * fq + r; q0[r] = *(const f32x4*)(RS8 + (size_t)t * 8); q1[r] = *(const f32x4*)(RS8 + (size_t)t * 8 + 4); }
#pragma unroll 16
        for (int ks = 0; ks < 32; ++ks) acc = __builtin_amdgcn_mfma_f32_16x16x32_bf16(*(const bf16x8*)(ap + 32 * ks), *(const bf16x8*)(bp + 32 * ks), acc, 0, 0, 0);
#pragma unroll
        for (int r = 0; r < 4; ++r) { const int t = t0 + 4 * fq + r;
            const float rs = 1.f / sqrtf((((q0[r].x + q0[r].y) + (q0[r].z + q0[r].w)) + ((q1[r].x + q1[r].y) + (q1[r].z + q1[r].w))) * (1.f / DM) + EPS);
            Z[(size_t)t * 16 + fr] = acc[r] * rs; }
    }
}

namespace att {
constexpr int KSTR = 144, VSTR = 136;
constexpr int OFF_K1 = 0, OFF_K2 = 64 * KSTR, OFF_V = 2 * 64 * KSTR, BUFB = OFF_V + 128 * VSTR;
constexpr int OFF_TB = 2 * BUFB;
constexpr float THR = 8.f;
__device__ __forceinline__ int t5_bucket(int rel) {
    const int n = rel < 0 ? -rel : rel; int v;
    if (n < 8) v = n; else { v = 8 + (31 - __clz(n * n)) - 6; if (v > 15) v = 15; }
    return (rel > 0 ? 16 : 0) + v;
}
constexpr int A2_KBUF = 2 * 64 * 128, A2_VBUF = 64 * 256, A2_OFF_V = 2 * A2_KBUF, A2_OFF_Q = A2_OFF_V + 2 * A2_VBUF, A2_QSTR = 144, A2_OFF_TB = A2_OFF_Q + 2 * 256 * A2_QSTR;
__device__ __forceinline__ void attn_unit(Frame& F, int bh, int qb, float lam) {
    const int wid = F.wave, mp = wid >> 2, wq = wid & 3, h = bh & 3;
    const int q0 = qb * 256, qw = q0 + 64 * wq;
    LAS unsigned char* lds = F.lds;
    const bf16* Qg = (const bf16*)(F.ws + S0_Q); const bf16* Kg = (const bf16*)(F.ws + S0_K); const bf16* Vg = (const bf16*)(F.ws + S0_VT);
    LAS float* tb = (LAS float*)(lds + A2_OFF_TB);
    const float* relb = F.in[I_RELB];
    { int tid = F.tid; asm volatile("" : "+v"(tid));
      for (int i = tid; i < 320; i += NTHREADS) tb[i] = relb[t5_bucket(i - 255) * 4 + h] * LOG2E;
      v4u qv[8];
#pragma unroll
      for (int i = 0; i < 8; ++i) { const int c = tid + 512 * i, m = c >> 11, row = (c >> 3) & 255, ch = c & 7; qv[i] = *(const v4u*)(Qg + (((size_t)(bh * 2 + m) * SEQ) + q0 + row) * 64 + ch * 8); }
#pragma unroll
      for (int i = 0; i < 8; ++i) { const int c = tid + 512 * i, m = c >> 11, row = (c >> 3) & 255, ch = c & 7; *(LAS v4u*)(lds + A2_OFF_Q + (m * 256 + row) * A2_QSTR + ch * 16) = qv[i]; } }
    __builtin_amdgcn_sched_barrier(0);
    int lane = F.lane; asm volatile("" : "+v"(lane));
    const int r32 = lane & 31, hi = lane >> 5;
    const float c15 = relb[15 * 4 + h] * LOG2E;
    const int nt_unit = 4 * qb + 4, nt_wave = 4 * qb + wq + 1;
    const int krow = 8 * wid + (lane >> 3), kc = (lane & 7) ^ ((krow >> 1) & 7);
    const bf16* k1src = Kg + (((size_t)(bh * 2 + 0) * SEQ) + krow) * 64 + kc * 8;
    const bf16* k2src = Kg + (((size_t)(bh * 2 + 1) * SEQ) + krow) * 64 + kc * 8;
    const int vrow = 4 * wid + (lane >> 4), vc = (lane & 15) ^ (4 * (vrow & 3));
    const bf16* vsrc = Vg + ((size_t)(bh >> 2) * SEQ + vrow) * 512 + h * 128 + vc * 8;
#define A2_DMA(t, bf) do { \
        __builtin_amdgcn_global_load_lds((const unsigned*)(k1src + (size_t)(t) * 4096), (LAS unsigned*)(lds + (bf) * A2_KBUF + wid * 1024), 16, 0, 0); \
        __builtin_amdgcn_global_load_lds((const unsigned*)(k2src + (size_t)(t) * 4096), (LAS unsigned*)(lds + (bf) * A2_KBUF + 64 * 128 + wid * 1024), 16, 0, 0); \
        __builtin_amdgcn_global_load_lds((const unsigned*)(vsrc + (size_t)(t) * 64 * 512), (LAS unsigned*)(lds + A2_OFF_V + (bf) * A2_VBUF + wid * 1024), 16, 0, 0); \
        __builtin_amdgcn_global_load_lds((const unsigned*)(vsrc + (size_t)(t) * 64 * 512 + (size_t)32 * 512), (LAS unsigned*)(lds + A2_OFF_V + (bf) * A2_VBUF + 32 * 256 + wid * 1024), 16, 0, 0); } while (0)
    A2_DMA(0, 0);
    asm volatile("s_waitcnt vmcnt(0)" ::: "memory");
    __syncthreads();
    f32x16 o[2][4];
#pragma unroll
    for (int j = 0; j < 2; ++j)
#pragma unroll
        for (int d = 0; d < 4; ++d)
#pragma unroll
            for (int r = 0; r < 16; ++r) o[j][d][r] = 0.f;
    float m_run[2] = {0.f, 0.f}, l_run[2] = {0.f, 0.f};
    const int kf_off = (mp * 64 + r32) * 128, kf_swz = (((r32 >> 1) & 7) * 16) ^ (hi * 16);
    const int qf_off = A2_OFF_Q + (mp * 256 + 64 * wq + r32) * A2_QSTR + hi * 16;
    const int vq = (lane & 15) >> 2, vf_off = (4 * hi + vq) * 256 + (lane & 3) * 8, vf_dh = (lane >> 4) & 1;
#pragma unroll 1
    for (int t = 0; t < nt_unit; ++t) {
        const int buf = t & 1;
        if (t + 1 < nt_unit) A2_DMA(t + 1, buf ^ 1);
        if (t < nt_wave) {
            const LAS unsigned char* kb = lds + buf * A2_KBUF + kf_off;
            const LAS unsigned char* vb = lds + A2_OFF_V + buf * A2_VBUF + vf_off;
#pragma unroll
            for (int hf = 0; hf < 2; ++hf) {
                __builtin_amdgcn_sched_barrier(0);
                bf16x8 ka[4];
#pragma unroll
                for (int s = 0; s < 4; ++s) ka[s] = *(const LAS bf16x8*)(kb + hf * 32 * 128 + (((2 * s) * 16) ^ kf_swz));
                bf16x8 pb[2][2];
#pragma unroll
                for (int j = 0; j < 2; ++j) {
                    __builtin_amdgcn_sched_barrier(0);
                    const int qrow0 = qw + 32 * j;
                    const bool far = (64 * t + 154 <= qrow0);
                    const float init = (far ? c15 : 0.f) - m_run[j];
                    f32x16 p0;
#pragma unroll
                    for (int r = 0; r < 16; ++r) p0[r] = init;
#pragma unroll
                    for (int s = 0; s < 4; ++s) { const bf16x8 qf = *(const LAS bf16x8*)(lds + qf_off + 32 * j * A2_QSTR + s * 32);
                        p0 = __builtin_amdgcn_mfma_f32_32x32x16_bf16(ka[s], qf, p0, 0, 0, 0); }
                    if (!far) {
                        const int base = 64 * t + 32 * hf - (qrow0 + r32) + 255 + 4 * hi;
#pragma unroll
                        for (int r = 0; r < 16; ++r) p0[r] += tb[base + (r & 3) + 8 * (r >> 2)];
                    }
                    float rm;
                    { const float m1 = vmax3(p0[0], p0[1], p0[2]), m2 = vmax3(p0[3], p0[4], p0[5]), m3 = vmax3(p0[6], p0[7], p0[8]), m4 = vmax3(p0[9], p0[10], p0[11]), m5 = vmax3(p0[12], p0[13], p0[14]);
                      rm = vmax3(vmax3(m1, m2, m3), vmax3(m4, m5, p0[15]), m1); }
                    const bool first = (t == 0) && (hf == 0);
                    if (first || __any(rm > THR)) {
                        rm = fmaxf(rm, __shfl_xor(rm, 32));
                        const float dl = first ? rm : fmaxf(rm, 0.f), al = first ? 0.f : fast_exp2(-dl);
#pragma unroll
                        for (int d = 0; d < 4; ++d)
#pragma unroll
                            for (int r = 0; r < 16; ++r) o[j][d][r] *= al;
                        l_run[j] *= al; m_run[j] += dl;
#pragma unroll
                        for (int r = 0; r < 16; ++r) p0[r] -= dl;
                    }
                    float ls = 0.f;
#pragma unroll
                    for (int r = 0; r < 16; ++r) { p0[r] = fast_exp2(p0[r]); ls += p0[r]; }
                    l_run[j] += ls;
                    { v4u w;
                      w.x = pk2(p0[0], p0[1]); w.y = pk2(p0[2], p0[3]); w.z = pk2(p0[4], p0[5]); w.w = pk2(p0[6], p0[7]); pb[j][0] = __builtin_bit_cast(bf16x8, w);
                      w.x = pk2(p0[8], p0[9]); w.y = pk2(p0[10], p0[11]); w.z = pk2(p0[12], p0[13]); w.w = pk2(p0[14], p0[15]); pb[j][1] = __builtin_bit_cast(bf16x8, w); }
                }
                __builtin_amdgcn_sched_barrier(0);
#pragma unroll
                for (int d = 0; d < 4; ++d)
#pragma unroll
                    for (int s = 0; s < 2; ++s) { const int chk = ((4 * d + 2 * vf_dh) ^ (4 * vq)) * 16, ro = (hf * 32 + s * 16) * 256;
                        const v4s16 lo = __builtin_amdgcn_ds_read_tr16_b64_v4i16((LAS v4s16*)(vb + ro + chk)), h8 = __builtin_amdgcn_ds_read_tr16_b64_v4i16((LAS v4s16*)(vb + ro + 8 * 256 + chk));
                        const bf16x8 aw = {lo[0], lo[1], lo[2], lo[3], h8[0], h8[1], h8[2], h8[3]};
                        o[0][d] = __builtin_amdgcn_mfma_f32_32x32x16_bf16(aw, pb[0][s], o[0][d], 0, 0, 0); o[1][d] = __builtin_amdgcn_mfma_f32_32x32x16_bf16(aw, pb[1][s], o[1][d], 0, 0, 0); }
            }
        }
        asm volatile("s_waitcnt vmcnt(0)" ::: "memory");
        __syncthreads();
    }
#undef A2_DMA
    __builtin_amdgcn_sched_barrier(0);
    int lane_e = F.lane; asm volatile("" : "+v"(lane_e));
    const int r32e = lane_e & 31, hie = lane_e >> 5;
    LAS float* X = (LAS float*)lds + (size_t)(wq * 128) * 64 + lane_e;
    float inv[2];
#pragma unroll
    for (int j = 0; j < 2; ++j) { l_run[j] += __shfl_xor(l_run[j], 32); inv[j] = 1.f / l_run[j]; }
    if (mp == 1) {
#pragma unroll
        for (int j = 0; j < 2; ++j)
#pragma unroll
            for (int d = 0; d < 4; ++d)
#pragma unroll
                for (int r = 0; r < 16; ++r) X[(j * 64 + d * 16 + r) * 64] = o[j][d][r] * inv[j];
    }
    __syncthreads();
    if (mp == 0) {
        const float* sg = F.in[I_SUBLN];
#pragma unroll
        for (int j = 0; j < 2; ++j) {
            float ss = 0.f;
#pragma unroll
            for (int d = 0; d < 4; ++d)
#pragma unroll
                for (int r = 0; r < 16; ++r) { const float v = o[j][d][r] * inv[j] - lam * X[(j * 64 + d * 16 + r) * 64]; o[j][d][r] = v; ss += v * v; }
            ss += __shfl_xor(ss, 32);
            const float rn = (1.f - LAM_INIT0) / sqrtf(ss * (1.f / 128.f) + EPS);
            bf16* CAT = (bf16*)(F.ws + S0_CAT) + ((size_t)(bh >> 2) * SEQ + qw + 32 * j + r32e) * DM + h * 128;
#pragma unroll
            for (int d = 0; d < 4; ++d)
#pragma unroll
                for (int rg = 0; rg < 4; ++rg) { const int dd = 32 * d + 8 * rg + 4 * hie; const f32x4 g4 = *(const f32x4*)(sg + dd);
                    v2u w; w.x = pk2(o[j][d][4 * rg] * rn * g4.x, o[j][d][4 * rg + 1] * rn * g4.y); w.y = pk2(o[j][d][4 * rg + 2] * rn * g4.z, o[j][d][4 * rg + 3] * rn * g4.w);
                    *(v2u*)(CAT + dd) = w; }
        }
    }
    __syncthreads();
}
constexpr int CV_OFF_Y = 65536;
__device__ __forceinline__ void conv_fetch(const bf16* GLU, int a, int tid, v4u (&pre)[8]) {
    const int t0 = a * 32, s0 = t0 & (SEQ - 1);
#pragma unroll
    for (int k = 0; k < 8; ++k) { const int ch = tid + 512 * k, row = ch >> 6;
        pre[k] = (v4u){0u, 0u, 0u, 0u};
        if (ch < 62 * 64 && s0 - 30 + row >= 0) pre[k] = *(const v4u*)(GLU + (size_t)(t0 - 30) * 512 + (size_t)ch * 8); }
}
__device__ __forceinline__ void conv_phase(Frame& F) {
    const int c = F.tid;
    const bf16* GLU = (const bf16*)(F.ws + S0_GLU);
    int a = F.vcu;
    if (a >= NT / 32) return;
    v4u pre[8];
    conv_fetch(GLU, a, c, pre);
    const float* cw = F.in[I_CONVW];
    float w[31];
#pragma unroll
    for (int j = 0; j < 31; ++j) w[j] = cw[j * 512 + c];
    const float bias = F.in[I_CONVB][c];
    const float* lg = F.in[I_CLNG]; const float* lb = F.in[I_CLNB];
    const f32x4 g0 = *(const f32x4*)(lg + F.lane * 8), g1 = *(const f32x4*)(lg + F.lane * 8 + 4), b0 = *(const f32x4*)(lb + F.lane * 8), b1 = *(const f32x4*)(lb + F.lane * 8 + 4);
    LAS unsigned char* U = F.lds; LAS float* Y = (LAS float*)(F.lds + CV_OFF_Y);
    bf16* CAT = (bf16*)(F.ws + S0_CAT);
#pragma unroll 1
    for (; a < NT / 32; a += F.G) {
        const int t0 = a * 32;
#pragma unroll
        for (int k = 0; k < 8; ++k) { const int ch = c + 512 * k; if (ch < 62 * 64) *(LAS v4u*)(U + ch * 16) = pre[k]; }
        __syncthreads();
        if (a + F.G < NT / 32) conv_fetch(GLU, a + F.G, c, pre);
        {   float u[62];
#pragma unroll
            for (int i = 0; i < 62; ++i) u[i] = bf2f(*(const LAS unsigned short*)(U + i * 1024 + 2 * c));
#pragma unroll
            for (int tt = 0; tt < 32; ++tt) { float y = bias;
#pragma unroll
                for (int j = 0; j < 31; ++j) y += w[j] * u[tt + j];
                Y[tt * 516 + c] = y; } }
        __syncthreads();
#pragma unroll
        for (int k = 0; k < 4; ++k) { const int tt = 4 * F.wave + k;
            const f32x4 ya = *(const LAS f32x4*)(Y + tt * 516 + F.lane * 8), yb = *(const LAS f32x4*)(Y + tt * 516 + F.lane * 8 + 4);
            const float mean = wave_sum((ya.x + ya.y) + (ya.z + ya.w) + (yb.x + yb.y) + (yb.z + yb.w)) * (1.f / 512.f);
            const f32x4 da = ya - mean, db = yb - mean;
            const float var = wave_sum((da.x * da.x + da.y * da.y) + (da.z * da.z + da.w * da.w) + (db.x * db.x + db.y * db.y) + (db.z * db.z + db.w * db.w)) * (1.f / 512.f);
            const float rs = 1.f / sqrtf(var + EPS);
            const f32x4 y0 = da * rs * g0 + b0, y1 = db * rs * g1 + b1;
            v4u o; o.x = pk2(siluf_(y0.x), siluf_(y0.y)); o.y = pk2(siluf_(y0.z), siluf_(y0.w)); o.z = pk2(siluf_(y1.x), siluf_(y1.y)); o.w = pk2(siluf_(y1.z), siluf_(y1.w));
            *(v4u*)(CAT + (size_t)(t0 + tt) * DM + 512 + F.lane * 8) = o; }
        __syncthreads();
    }
}
__device__ __forceinline__ void p2_attn_conv(Frame& F) {
    float d1, d2;
    { const float* lq1 = F.in[I_LQ1]; const float* lk1 = F.in[I_LK1]; const float* lq2 = F.in[I_LQ2]; const float* lk2 = F.in[I_LK2];
      int ln = F.lane; asm volatile("" : "+v"(ln));
      const float a1 = lq1[ln], b1 = lk1[ln], a2 = lq2[ln], b2 = lk2[ln];
      d1 = wave_sum(a1 * b1); d2 = wave_sum(a2 * b2); }
    const float lam = expf(d1) - expf(d2) + LAM_INIT0;
    for (int a = F.vcu; a < 512; a += F.G) { const int i = a >> 8, v = a & 255, x = v >> 5, j = v & 31; attn_unit(F, 2 * x + (j >> 4), i ? (31 - (j & 15)) : (j & 15), lam); }
    conv_phase(F);
}
}

namespace peer {
constexpr int SSTR = 136;
__device__ __forceinline__ unsigned mono(float f) { const unsigned u = __builtin_bit_cast(unsigned, f); return u ^ ((unsigned)((int)u >> 31) | 0x80000000u); }
__device__ __forceinline__ float unmono(unsigned m) { const unsigned u = (m & 0x80000000u) ? (m ^ 0x80000000u) : ~m; return __builtin_bit_cast(float, u); }
__device__ __forceinline__ float unmono_hi16(unsigned key) { const unsigned u = key & 0xffff0000u; return __builtin_bit_cast(float, (u & 0x80000000u) ? (u ^ 0x80000000u) : (~u & 0xffff0000u)); }
#define CE_DESC(a, b) do { const unsigned _x = (a), _y = (b); (a) = _x > _y ? _x : _y; (b) = _x > _y ? _y : _x; } while (0)
#define CE_ASC(a, b)  do { const unsigned _x = (a), _y = (b); (a) = _x > _y ? _y : _x; (b) = _x > _y ? _x : _y; } while (0)
__device__ __forceinline__ void merge16(unsigned (&k)[16], bool desc) {
#pragma unroll
    for (int stride = 8; stride > 0; stride >>= 1)
#pragma unroll
        for (int i = 0; i < 16; ++i) if ((i & stride) == 0) { if (desc) CE_DESC(k[i], k[i + stride]); else CE_ASC(k[i], k[i + stride]); }
}
__device__ __forceinline__ void sort16(unsigned (&k)[16], bool desc) {
#pragma unroll
    for (int size = 2; size <= 16; size <<= 1)
#pragma unroll
        for (int stride = size >> 1; stride > 0; stride >>= 1)
#pragma unroll
            for (int i = 0; i < 16; ++i) if ((i & stride) == 0) { const bool d = (((i & size) == 0) == desc); if (d) CE_DESC(k[i], k[i + stride]); else CE_ASC(k[i], k[i + stride]); }
}
#define OEM16_DESC(k, b) do { CE_DESC(k[(b)+0],k[(b)+1]); CE_DESC(k[(b)+2],k[(b)+3]); CE_DESC(k[(b)+0],k[(b)+2]); CE_DESC(k[(b)+1],k[(b)+3]); CE_DESC(k[(b)+1],k[(b)+2]); CE_DESC(k[(b)+4],k[(b)+5]); CE_DESC(k[(b)+6],k[(b)+7]); CE_DESC(k[(b)+4],k[(b)+6]); CE_DESC(k[(b)+5],k[(b)+7]); CE_DESC(k[(b)+5],k[(b)+6]); CE_DESC(k[(b)+0],k[(b)+4]); CE_DESC(k[(b)+2],k[(b)+6]); CE_DESC(k[(b)+2],k[(b)+4]); CE_DESC(k[(b)+1],k[(b)+5]); CE_DESC(k[(b)+3],k[(b)+7]); CE_DESC(k[(b)+3],k[(b)+5]); CE_DESC(k[(b)+1],k[(b)+2]); CE_DESC(k[(b)+3],k[(b)+4]); CE_DESC(k[(b)+5],k[(b)+6]); CE_DESC(k[(b)+8],k[(b)+9]); CE_DESC(k[(b)+10],k[(b)+11]); CE_DESC(k[(b)+8],k[(b)+10]); CE_DESC(k[(b)+9],k[(b)+11]); CE_DESC(k[(b)+9],k[(b)+10]); CE_DESC(k[(b)+12],k[(b)+13]); CE_DESC(k[(b)+14],k[(b)+15]); CE_DESC(k[(b)+12],k[(b)+14]); CE_DESC(k[(b)+13],k[(b)+15]); CE_DESC(k[(b)+13],k[(b)+14]); CE_DESC(k[(b)+8],k[(b)+12]); CE_DESC(k[(b)+10],k[(b)+14]); CE_DESC(k[(b)+10],k[(b)+12]); CE_DESC(k[(b)+9],k[(b)+13]); CE_DESC(k[(b)+11],k[(b)+15]); CE_DESC(k[(b)+11],k[(b)+13]); CE_DESC(k[(b)+9],k[(b)+10]); CE_DESC(k[(b)+11],k[(b)+12]); CE_DESC(k[(b)+13],k[(b)+14]); CE_DESC(k[(b)+0],k[(b)+8]); CE_DESC(k[(b)+4],k[(b)+12]); CE_DESC(k[(b)+4],k[(b)+8]); CE_DESC(k[(b)+2],k[(b)+10]); CE_DESC(k[(b)+6],k[(b)+14]); CE_DESC(k[(b)+6],k[(b)+10]); CE_DESC(k[(b)+2],k[(b)+4]); CE_DESC(k[(b)+6],k[(b)+8]); CE_DESC(k[(b)+10],k[(b)+12]); CE_DESC(k[(b)+1],k[(b)+9]); CE_DESC(k[(b)+5],k[(b)+13]); CE_DESC(k[(b)+5],k[(b)+9]); CE_DESC(k[(b)+3],k[(b)+11]); CE_DESC(k[(b)+7],k[(b)+15]); CE_DESC(k[(b)+7],k[(b)+11]); CE_DESC(k[(b)+3],k[(b)+5]); CE_DESC(k[(b)+7],k[(b)+9]); CE_DESC(k[(b)+11],k[(b)+13]); CE_DESC(k[(b)+1],k[(b)+2]); CE_DESC(k[(b)+3],k[(b)+4]); CE_DESC(k[(b)+5],k[(b)+6]); CE_DESC(k[(b)+7],k[(b)+8]); CE_DESC(k[(b)+9],k[(b)+10]); CE_DESC(k[(b)+11],k[(b)+12]); CE_DESC(k[(b)+13],k[(b)+14]); } while (0)
__device__ __forceinline__ void top16_of_64(unsigned (&k)[64], unsigned (&res)[16]) {
    OEM16_DESC(k, 0); OEM16_DESC(k, 16); OEM16_DESC(k, 32); OEM16_DESC(k, 48);
    unsigned t0[16], t1[16];
#pragma unroll
    for (int i = 0; i < 16; ++i) { t0[i] = k[i] > k[31 - i] ? k[i] : k[31 - i]; t1[i] = k[32 + i] > k[63 - i] ? k[32 + i] : k[63 - i]; }
    merge16(t0, true); merge16(t1, false);
#pragma unroll
    for (int i = 0; i < 16; ++i) res[i] = t0[i] > t1[i] ? t0[i] : t1[i];
    merge16(res, true);
}
constexpr size_t TBL_ITEMS = (size_t)NEXP * DM / 16;
struct TblJob { const float* pu; const float* pv; unsigned char* du; unsigned char* dv; const float* gain; int layer; };
__device__ __forceinline__ void tbl_issue(const TblJob& J, size_t k, f32x4 (&in)[4]) {
    const size_t kk = (k < 2 * TBL_ITEMS) ? k : 0;
    const size_t gi = (size_t)J.layer * TBL_ITEMS + (kk & (TBL_ITEMS - 1));
    if (kk >= TBL_ITEMS) {
#pragma unroll
        for (int q = 0; q < 4; ++q) in[q] = ((const f32x4*)J.pv)[4 * gi + q];
    } else {
#pragma unroll
        for (int q = 0; q < 4; ++q) in[q] = ((const f32x4*)J.pu)[4 * gi + q];
    }
    asm volatile("" ::: "memory");
}
__device__ __forceinline__ void tbl_finish(const TblJob& J, size_t k, const f32x4 (&in)[4]) {
    if (k < 2 * TBL_ITEMS) { const size_t gi = (size_t)J.layer * TBL_ITEMS + (k & (TBL_ITEMS - 1));
        if (k >= TBL_ITEMS) cvt_table_item<false>(J.pv, J.dv, V_SCALE, nullptr, gi, in); else cvt_table_item<true>(J.pu, J.du, U_SCALE, J.gain, gi, in); }
}
__device__ __forceinline__ void topk_unit(Frame& F, int tile, int h, int layer, const TblJob& J, size_t k0, size_t kstep) {
    const int tid = F.tid;
    f32x4 tin[4];
    tbl_issue(J, k0, tin);
    const int t0 = tile * 256, row = tid >> 1, kh = tid & 1;
    const v4u* src = (const v4u*)((const bf16*)(F.ws + SP_PQ) + (size_t)(t0 + row) * PQ_N + h * 256 + 64 * kh);
    v4u raw[2][8];
#pragma unroll
    for (int p = 0; p < 2; ++p)
#pragma unroll
        for (int i = 0; i < 8; ++i) raw[p][i] = src[16 * p + i];
    unsigned sel[2][16];
#pragma unroll
    for (int p = 0; p < 2; ++p) {
        unsigned k[64];
#pragma unroll
        for (int i = 0; i < 8; ++i)
#pragma unroll
            for (int e = 0; e < 4; ++e) { const unsigned w = raw[p][i][e];
                k[8 * i + 2 * e] = (w << 16) | (unsigned)(127 - (64 * kh + 8 * i + 2 * e));
                k[8 * i + 2 * e + 1] = (w & 0xffff0000u) | (unsigned)(127 - (64 * kh + 8 * i + 2 * e + 1)); }
        unsigned mine[16];
        top16_of_64(k, mine);
#pragma unroll
        for (int i = 0; i < 16; ++i) { const unsigned other = (unsigned)__builtin_amdgcn_update_dpp(0, (int)mine[15 - i], 0xB1, 0xf, 0xf, false); sel[p][i] = mine[i] > other ? mine[i] : other; }
        merge16(sel[p], true);
        tbl_finish(J, k0 + (size_t)p * kstep, tin); tbl_issue(J, k0 + (size_t)(p + 1) * kstep, tin);
    }
    float v1[16], v2[16]; unsigned ib1[4] = {0u, 0u, 0u, 0u}, ib2[4] = {0u, 0u, 0u, 0u};
#pragma unroll
    for (int i = 0; i < 16; ++i) { v1[i] = unmono_hi16(sel[0][i]); v2[i] = unmono_hi16(sel[1][i]);
        ib1[i >> 2] |= (127u - (sel[0][i] & 127u)) << (8 * (i & 3)); ib2[i >> 2] |= (127u - (sel[1][i] & 127u)) << (8 * (i & 3)); }
#define CKEY(i, j) ((mono(v1[i] + v2[j]) & ~255u) | (unsigned)(255 - ((i) * 16 + (j))))
    unsigned A[16], B[16], C[16], D[16];
#pragma unroll
    for (int j = 0; j < 16; ++j) A[j] = CKEY(0, j);
#pragma unroll
    for (int j = 0; j < 8; ++j) B[j] = CKEY(1, j);
    B[8] = 0u; B[9] = 0u; B[10] = 0u;
#pragma unroll
    for (int j = 0; j < 5; ++j) B[15 - j] = CKEY(2, j);
    C[0] = CKEY(3, 0); C[1] = CKEY(3, 1); C[2] = CKEY(3, 2); C[3] = CKEY(3, 3); C[4] = CKEY(4, 0); C[5] = CKEY(4, 1); C[6] = CKEY(4, 2);
    C[7] = CKEY(5, 0); C[8] = CKEY(5, 1); C[9] = CKEY(6, 0); C[10] = CKEY(6, 1); C[11] = CKEY(7, 0); C[12] = CKEY(7, 1); C[13] = 0u; C[14] = 0u; C[15] = 0u;
#pragma unroll
    for (int i = 0; i < 8; ++i) { D[i] = CKEY(8 + i, 0); D[8 + i] = 0u; }
#undef CKEY
    merge16(B, false);
    sort16(C, false);
    unsigned top[16];
#pragma unroll
    for (int i = 0; i < 16; ++i) { A[i] = A[i] > B[i] ? A[i] : B[i]; D[i] = D[i] > C[i] ? D[i] : C[i]; }
    merge16(A, true); merge16(D, false);
#pragma unroll
    for (int i = 0; i < 16; ++i) top[i] = A[i] > D[i] ? A[i] : D[i];
    merge16(top, true);
    tbl_finish(J, k0 + 2 * kstep, tin); tbl_issue(J, k0 + 3 * kstep, tin);
    const size_t obase = ((size_t)(t0 + row) * 8 + h) * 16;
    LAS unsigned char* slot = F.lds + tid * 32;
    *(LAS v4u*)slot = (v4u){ib1[0], ib1[1], ib1[2], ib1[3]}; *(LAS v4u*)(slot + 16) = (v4u){ib2[0], ib2[1], ib2[2], ib2[3]};
    if (kh == 0) {
        unsigned short* IDS = (unsigned short*)(F.ws + WS_IDS) + obase;
        unsigned pk[8];
#pragma unroll
        for (int q2 = 0; q2 < 8; ++q2) { unsigned ev[2];
#pragma unroll
            for (int e = 0; e < 2; ++e) { const unsigned cid = 255u - (top[2 * q2 + e] & 255u); ev[e] = (unsigned)slot[cid >> 4] * 128u + (unsigned)slot[16 + (cid & 15u)]; }
            pk[q2] = ev[0] | (ev[1] << 16); }
        *(v4u*)IDS = (v4u){pk[0], pk[1], pk[2], pk[3]}; *(v4u*)(IDS + 8) = (v4u){pk[4], pk[5], pk[6], pk[7]};
    } else {
        float* GT = (float*)(F.ws + WS_GATE) + obase;
        float cv[16]; float sum = 0.f;
        const float mx = unmono(top[0] & ~255u);
#pragma unroll
        for (int q = 0; q < 16; ++q) { cv[q] = fast_exp2((unmono(top[q] & ~255u) - mx) * LOG2E); sum += cv[q]; }
        const float inv = 1.f / sum;
#pragma unroll
        for (int q4 = 0; q4 < 4; ++q4) *(f32x4*)(GT + 4 * q4) = (f32x4){cv[4 * q4] * inv, cv[4 * q4 + 1] * inv, cv[4 * q4 + 2] * inv, cv[4 * q4 + 3] * inv};
    }
    tbl_finish(J, k0 + 3 * kstep, tin);
}
__device__ __forceinline__ void topk_phase(Frame& F, int layer) {
    const TblJob J{F.in[I_PU], F.in[I_PV], F.ws + WS_UT, F.ws + WS_VT, F.in[I_LNFFN], layer};
    const size_t gtid = (size_t)F.vcu * NTHREADS + F.tid, gthreads = (size_t)F.G * NTHREADS;
    size_t k = gtid;
#pragma unroll 1
    for (int a = F.vcu; a < (NT / 256) * 8; a += F.G) { topk_unit(F, a >> 3, a & 7, layer, J, k, gthreads); k += 4 * gthreads; }
#pragma unroll 1
    for (; k < 2 * TBL_ITEMS; k += gthreads) { f32x4 tin[4]; tbl_issue(J, k, tin); tbl_finish(J, k, tin); }
}
__device__ __forceinline__ float gelu_tanh(float x) { const float y = 1.5957691216057308f * (x + 0.044715f * x * x * x); return x * fast_rcp(1.f + fast_exp2(-y * LOG2E)); }
constexpr float HN_SCALE = 16.f;
__device__ __forceinline__ void fp8x16_to_f32(const v4u w, float (&o)[16]) {
#pragma unroll
    for (int i = 0; i < 4; ++i) { const f32x2_t a = __builtin_amdgcn_cvt_pk_f32_fp8((int)w[i], false), b = __builtin_amdgcn_cvt_pk_f32_fp8((int)w[i], true); o[4 * i] = a.x; o[4 * i + 1] = a.y; o[4 * i + 2] = b.x; o[4 * i + 3] = b.y; }
}
constexpr int E1_TSTR = 144, E1_TILE = 16 * E1_TSTR, E1_WAVE_LDS = 8 * E1_TILE;
__device__ __forceinline__ void slice_assign(Frame& F, int& j, int& wv, int& nwv) {
    const int per = F.G >> 3; j = F.vcu / per; wv = (F.vcu % per) * NWAVES + F.wave; nwv = per * NWAVES;
    if (F.xrank >= 0) {
        unsigned* bar = F.ctl + 4096; unsigned sum = 0u, mine = 0u; bool all = true;
#pragma unroll
        for (int x = 0; x < 8; ++x) { const unsigned cx = xb_ld(&bar[XB_XCNT(x)]); sum += cx; all = all && (cx > 0u); mine = (x == F.xcc) ? cx : mine; }
        if (all && sum == (unsigned)F.G) { j = F.xcc; wv = F.xrank * NWAVES + F.wave; nwv = (int)mine * NWAVES; }
    }
}
struct E1Small { v2u idw; v4u bq[2]; };
__device__ __forceinline__ void e1_small(E1Small& S, int t, const unsigned short* IDS, const unsigned char* XSEL, int lane) {
    S.idw = *(const v2u*)((const unsigned*)IDS + (size_t)t * 64 + 8 * (lane >> 3) + 2 * (lane & 3));
    S.bq[0] = *(const v4u*)(XSEL + (size_t)t * DM); S.bq[1] = *(const v4u*)(XSEL + (size_t)t * DM + 16);
}
template <int CTRL> __device__ __forceinline__ unsigned dppu(unsigned v) { return (unsigned)__builtin_amdgcn_update_dpp(0, (int)v, CTRL, 0xf, 0xf, false); }
__device__ __forceinline__ void gather16(v4u (&G)[16], v2u idw, const unsigned char* TBu  , unsigned lofs  , int lane) {
    unsigned W[8];
    W[0] = dppu<0x00>(idw.x); W[1] = dppu<0x00>(idw.y); W[2] = dppu<0x55>(idw.x); W[3] = dppu<0x55>(idw.y);
    W[4] = dppu<0xAA>(idw.x); W[5] = dppu<0xAA>(idw.y); W[6] = dppu<0xFF>(idw.x); W[7] = dppu<0xFF>(idw.y);
#pragma unroll
    for (int b = 0; b < 16; ++b) { const unsigned id = (b & 1) ? (W[b >> 1] >> 16) : (W[b >> 1] & 0xffffu);
        G[b] = *(const v4u*)(TBu + (id * 128u + lofs)); }
}
__device__ __forceinline__ long mk64(unsigned lo, unsigned hi) { return (long)(((unsigned long long)hi << 32) | lo); }
__device__ __forceinline__ void e1_process(const v4u (&G)[16], const E1Small& S, float* PARTt, LAS unsigned char* tile, unsigned wofs, unsigned rofs, int fr, int kg) {
#pragma unroll
    for (int gi = 0; gi < 8; ++gi) { LAS unsigned char* tb = tile + gi * E1_TILE; *(LAS v4u*)(tb + wofs) = G[2 * gi]; *(LAS v4u*)(tb + 8 * E1_TSTR + wofs) = G[2 * gi + 1]; }
    f32x4 acc[8];
#pragma unroll
    for (int gi = 0; gi < 8; ++gi) {
        const LAS unsigned char* tb = tile + gi * E1_TILE;
        const v4u a0 = *(const LAS v4u*)(tb + rofs), a1 = *(const LAS v4u*)(tb + rofs + 16);
        const v8i_t av = {(int)a0.x, (int)a0.y, (int)a0.z, (int)a0.w, (int)a1.x, (int)a1.y, (int)a1.z, (int)a1.w};
        const v8i_t bv = {(int)S.bq[0].x, (int)S.bq[0].y, (int)S.bq[0].z, (int)S.bq[0].w, (int)S.bq[1].x, (int)S.bq[1].y, (int)S.bq[1].z, (int)S.bq[1].w};
        acc[gi] = __builtin_amdgcn_mfma_scale_f32_16x16x128_f8f6f4(av, bv, (f32x4){0.f, 0.f, 0.f, 0.f}, 0, 0, 0, 0x7f7f7f7f, 0, 0x7f7f7f7f);
    }
#pragma unroll
    for (int gi = 0; gi < 8; ++gi) { f32x4 o;
#pragma unroll
        for (int r = 0; r < 4; ++r) { const float v = acc[gi][r]; o[r] = v + __builtin_bit_cast(float, __builtin_amdgcn_update_dpp(0, __builtin_bit_cast(int, v), 0x128, 0xf, 0xf, false)); }
        acc[gi] = o; }
    if (fr < 2) {
#pragma unroll
        for (int g2 = 0; g2 < 4; ++g2) { const f32x4 v = fr ? acc[2 * g2 + 1] : acc[2 * g2]; *(f32x4*)(PARTt + 32 * g2 + 16 * fr + 4 * kg) = v; }
    }
}
__device__ __forceinline__ void e1_phase(Frame& F, int layer) {
    const int lane = F.lane, e8 = lane >> 3, c = lane & 7, fr = lane & 15, kg = lane >> 4;
    int j, wv, nwv; slice_assign(F, j, wv, nwv);
    if (j >= 8) return;
    const unsigned char* UT = F.ws + WS_UT + ((size_t)(layer * 8 + j) * NEXP) * 128; const unsigned lofs = 16u * (unsigned)c;
    const unsigned short* IDS = (const unsigned short*)(F.ws + WS_IDS);
    float* PART = (float*)(F.ws + SP_PART) + (size_t)j * NT * 128;
    const float* RSV = (const float*)(F.ws + WS_RSV);
    const unsigned char* XBj = F.ws + (fr < 8 ? WS_XH8 : WS_XL8) + 128 * j + 32 * kg;
    LAS unsigned char* tile = F.lds + F.wave * E1_WAVE_LDS;
    const unsigned wofs = (unsigned)(e8 * E1_TSTR + 16 * c), rofs = (unsigned)(fr * E1_TSTR + 32 * kg);
    if (wv >= NT) return;
    const int last = wv + ((NT - 1 - wv) / nwv) * nwv;
#define CLAMP(tt) ((tt) <= last ? (tt) : last)
    E1Small S0, S1, S2, S3; v4u GA[16], GB[16];
    e1_small(S0, wv, IDS, XBj, lane); e1_small(S1, CLAMP(wv + nwv), IDS, XBj, lane); e1_small(S2, CLAMP(wv + 2 * nwv), IDS, XBj, lane);
    gather16(GA, S0.idw, UT, lofs, lane);
    int t = wv;
#pragma unroll 1
    for (; t + 3 * nwv <= last; t += 4 * nwv) {
        gather16(GB, S1.idw, UT, lofs, lane); e1_small(S3, t + 3 * nwv, IDS, XBj, lane);
        e1_process(GA, S0, PART + (size_t)t * 128, tile, wofs, rofs, fr, kg);
        gather16(GA, S2.idw, UT, lofs, lane); e1_small(S0, CLAMP(t + 4 * nwv), IDS, XBj, lane);
        e1_process(GB, S1, PART + (size_t)(t + nwv) * 128, tile, wofs, rofs, fr, kg);
        gather16(GB, S3.idw, UT, lofs, lane); e1_small(S1, CLAMP(t + 5 * nwv), IDS, XBj, lane);
        e1_process(GA, S2, PART + (size_t)(t + 2 * nwv) * 128, tile, wofs, rofs, fr, kg);
        gather16(GA, S0.idw, UT, lofs, lane); e1_small(S2, CLAMP(t + 6 * nwv), IDS, XBj, lane);
        e1_process(GB, S3, PART + (size_t)(t + 3 * nwv) * 128, tile, wofs, rofs, fr, kg);
    }
    if (t <= last) {
        const bool h1 = t + nwv <= last, h2 = t + 2 * nwv <= last;
        if (h1) gather16(GB, S1.idw, UT, lofs, lane);
        e1_process(GA, S0, PART + (size_t)t * 128, tile, wofs, rofs, fr, kg);
        if (h1) {
            if (h2) gather16(GA, S2.idw, UT, lofs, lane);
            e1_process(GB, S1, PART + (size_t)(t + nwv) * 128, tile, wofs, rofs, fr, kg);
            if (h2) e1_process(GA, S2, PART + (size_t)(t + 2 * nwv) * 128, tile, wofs, rofs, fr, kg);
        }
    }
}
constexpr float CF_SCALE = 32.f;
constexpr int E2_OFF_O = 128 * E1_TSTR, E2_WAVE_LDS = E2_OFF_O + 512;
typedef int v2i_t __attribute__((ext_vector_type(2)));
__device__ __forceinline__ void coef_phase(Frame& F) {
    const int lane = F.lane; const float* GT = (const float*)(F.ws + WS_GATE); const float* PART = (const float*)(F.ws + SP_PART); const float* RSV = (const float*)(F.ws + WS_RSV);
    unsigned char* CH = F.ws + WS_CH8; unsigned char* CL = F.ws + WS_CL8;
    const int gw = F.vcu * NWAVES + F.wave, NGW = F.G * NWAVES;
    const int gs0 = 32 * (lane & 3) + (lane >> 2);
    int t = gw;
#pragma unroll 1
    for (; t + NGW < NT; t += 2 * NGW) {
        f32x2_t p[2][8], g[2]; float rsv[2];
#pragma unroll
        for (int u = 0; u < 2; ++u) { const size_t tt = (size_t)(t + u * NGW);
#pragma unroll
            for (int jj = 0; jj < 8; ++jj) p[u][jj] = *(const f32x2_t*)(PART + ((size_t)jj * NT + tt) * 128 + 2 * lane);
            g[u] = (f32x2_t){GT[tt * 128 + gs0], GT[tt * 128 + gs0 + 16]}; rsv[u] = RSV[tt]; }
#pragma unroll
        for (int u = 0; u < 2; ++u) { const size_t tt = (size_t)(t + u * NGW);
            float dA = 0.f, dB = 0.f;
#pragma unroll
            for (int jj = 0; jj < 8; ++jj) { dA += p[u][jj].x; dB += p[u][jj].y; }
            const float rsx = rsv[u] * (1.f / (U_SCALE * HN_SCALE));
            const float cfA = g[u].x * gelu_tanh(dA * rsx) * CF_SCALE, cfB = g[u].y * gelu_tanh(dB * rsx) * CF_SCALE;
            const unsigned h = pk_fp8x4(cfA, cfB, 0.f, 0.f); const f32x2_t hb = __builtin_amdgcn_cvt_pk_f32_fp8((int)h, false); const unsigned l = pk_fp8x4(cfA - hb.x, cfB - hb.y, 0.f, 0.f);
            *(unsigned short*)(CH + tt * 128 + 2 * lane) = (unsigned short)(h & 0xffffu); *(unsigned short*)(CL + tt * 128 + 2 * lane) = (unsigned short)(l & 0xffffu); }
    }
    for (; t < NT; t += NGW) {
        float dA = 0.f, dB = 0.f;
#pragma unroll
        for (int jj = 0; jj < 8; ++jj) { const f32x2_t v = *(const f32x2_t*)(PART + ((size_t)jj * NT + t) * 128 + 2 * lane); dA += v.x; dB += v.y; }
        const f32x2_t g = (f32x2_t){GT[(size_t)t * 128 + gs0], GT[(size_t)t * 128 + gs0 + 16]}; const float rsx = RSV[t] * (1.f / (U_SCALE * HN_SCALE));
        const float cfA = g.x * gelu_tanh(dA * rsx) * CF_SCALE, cfB = g.y * gelu_tanh(dB * rsx) * CF_SCALE;
        const unsigned h = pk_fp8x4(cfA, cfB, 0.f, 0.f); const f32x2_t hb = __builtin_amdgcn_cvt_pk_f32_fp8((int)h, false); const unsigned l = pk_fp8x4(cfA - hb.x, cfB - hb.y, 0.f, 0.f);
        *(unsigned short*)(CH + (size_t)t * 128 + 2 * lane) = (unsigned short)(h & 0xffffu); *(unsigned short*)(CL + (size_t)t * 128 + 2 * lane) = (unsigned short)(l & 0xffffu);
    }
}
struct E2Small { v2u idw; long a[4]; v2u xr; };
__device__ __forceinline__ void e2_small(E2Small& S, int t, const unsigned short* IDS, const unsigned char* CSEL, const bf16* XRj, int lane) {
    S.idw = *(const v2u*)((const unsigned*)IDS + (size_t)t * 64 + 8 * (lane >> 3) + 2 * (lane & 3));
#pragma unroll
    for (int ks = 0; ks < 4; ++ks) S.a[ks] = *(const long*)(CSEL + (size_t)t * 128 + 32 * ks);
    if (lane < 32) S.xr = *(const v2u*)(XRj + (size_t)t * DM);
}
__device__ __forceinline__ void e2_process(const v4u (&G)[16], const E2Small& S, float* xp  , bf16* bp  , float* rs8p, LAS unsigned char* wl, int lane) {
    const int e8 = lane >> 3, c = lane & 7, fr = lane & 15, kg = lane >> 4;
#pragma unroll
    for (int b = 0; b < 16; ++b) *(LAS v4u*)(wl + (8 * b + e8) * E1_TSTR + 16 * c) = G[b];
    const unsigned trofs = (unsigned)((8 * kg + (fr >> 1)) * E1_TSTR + 8 * (fr & 1));
    f32x4 acc[8];
    const v8i_t av = {(int)(unsigned)S.a[0], (int)((unsigned long)S.a[0] >> 32), (int)(unsigned)S.a[1], (int)((unsigned long)S.a[1] >> 32), (int)(unsigned)S.a[2], (int)((unsigned long)S.a[2] >> 32), (int)(unsigned)S.a[3], (int)((unsigned long)S.a[3] >> 32)};
#pragma unroll
    for (int n = 0; n < 8; ++n) {
        v2i_t b4[4];
#pragma unroll
        for (int ks = 0; ks < 4; ++ks) b4[ks] = __builtin_amdgcn_ds_read_tr8_b64_v2i32((LAS v2i_t*)(wl + trofs + ks * 32 * E1_TSTR + 16 * n));
        const v8i_t bv = {b4[0].x, b4[0].y, b4[1].x, b4[1].y, b4[2].x, b4[2].y, b4[3].x, b4[3].y};
        acc[n] = __builtin_amdgcn_mfma_scale_f32_16x16x128_f8f6f4(av, bv, (f32x4){0.f, 0.f, 0.f, 0.f}, 0, 0, 0, 0x7f7f7f7f, 0, 0x7f7f7f7f); }
    LAS float* ol = (LAS float*)(wl + E2_OFF_O);
    LAS float* ol2 = (LAS float*)wl;
    if ((lane & 16) == 0) { LAS float* p = ((lane < 32) ? ol : ol2) + (lane & 15);
#pragma unroll
        for (int n = 0; n < 8; ++n) p[16 * n] = acc[n][0]; }
    float ss = 0.f;
    if (lane < 32) {
        const f32x4 o = *(const LAS f32x4*)(ol + 4 * lane) + *(const LAS f32x4*)(ol2 + 4 * lane);
        const f32x4 x = (f32x4){bf_lo(S.xr.x), bf_hi(S.xr.x), bf_lo(S.xr.y), bf_hi(S.xr.y)} + o * (1.f / (V_SCALE * CF_SCALE));
        ss = (x.x * x.x + x.y * x.y) + (x.z * x.z + x.w * x.w);
        if (xp) *(f32x4*)xp = x;
        if (bp) *(v2u*)bp = (v2u){pk2(x.x, x.y), pk2(x.z, x.w)};
    }
    ss = wave_sum(ss);
    if (lane == 0) *rs8p = ss;
}
__device__ __forceinline__ void e2_phase(Frame& F, int layer, const bf16* XIN, bf16* XBOUT, float* XFOUT) {
    const int lane = F.lane, e8 = lane >> 3, c = lane & 7, fr = lane & 15, kg = lane >> 4;
    int j, wv, nwv; slice_assign(F, j, wv, nwv);
    if (j >= 8) return;
    const unsigned char* VT = F.ws + WS_VT + ((size_t)(layer * 8 + j) * NEXP) * 128; const unsigned lofs = 16u * (unsigned)c;
    const unsigned short* IDS = (const unsigned short*)(F.ws + WS_IDS);
    const unsigned char* CSEL = F.ws + (fr < 8 ? WS_CH8 : WS_CL8) + 8 * kg;
    const bf16* XRj = XIN + 128 * j + 4 * (lane & 31); float* RS8 = (float*)(F.ws + WS_RS8) + j;
    bf16* XBj = XBOUT ? XBOUT + 128 * j + 4 * (lane & 31) : nullptr; float* XFj = XFOUT ? XFOUT + 128 * j + 4 * (lane & 31) : nullptr;
    LAS unsigned char* wl = F.lds + F.wave * E2_WAVE_LDS;
    if (wv >= NT) return;
    const int last = wv + ((NT - 1 - wv) / nwv) * nwv;
    E2Small SA, SB, SC, SD; v4u GA[16], GB[16];
    e2_small(SA, wv, IDS, CSEL, XRj, lane); e2_small(SB, CLAMP(wv + nwv), IDS, CSEL, XRj, lane); e2_small(SC, CLAMP(wv + 2 * nwv), IDS, CSEL, XRj, lane);
    gather16(GA, SA.idw, VT, lofs, lane);
    int t = wv;
#pragma unroll 1
    for (; t + nwv <= last; t += 2 * nwv) {
        gather16(GB, SB.idw, VT, lofs, lane); e2_small(SD, CLAMP(t + 3 * nwv), IDS, CSEL, XRj, lane);
        e2_process(GA, SA, XFj ? XFj + (size_t)t * DM : nullptr, XBj ? XBj + (size_t)t * DM : nullptr, RS8 + (size_t)t * 8, wl, lane);
        e2_small(SA, CLAMP(t + 4 * nwv), IDS, CSEL, XRj, lane); gather16(GA, SC.idw, VT, lofs, lane);
        e2_process(GB, SB, XFj ? XFj + (size_t)(t + nwv) * DM : nullptr, XBj ? XBj + (size_t)(t + nwv) * DM : nullptr, RS8 + (size_t)(t + nwv) * 8, wl, lane);
        { const E2Small tmp = SA; SA = SC; SB = SD; SC = tmp; }
    }
    if (t <= last) e2_process(GA, SA, XFj ? XFj + (size_t)t * DM : nullptr, XBj ? XBj + (size_t)t * DM : nullptr, RS8 + (size_t)t * 8, wl, lane);
#undef CLAMP
}
__device__ __forceinline__ void final_norm_phase(Frame& F) {
    const int lane = F.lane; float* OUT = F.out; const bf16* X = (const bf16*)(F.ws + WS_HN); const float* RS8 = (const float*)(F.ws + WS_RS8); const float* gf = F.in[I_LNF];
    const int gw = F.vcu * NWAVES + F.wave, NGW = F.G * NWAVES;
    f32x4 g4[4];
#pragma unroll
    for (int q = 0; q < 4; ++q) g4[q] = *(const f32x4*)(gf + 256 * q + 4 * lane);
    int t = gw;
#pragma unroll 1
    for (; t + 3 * NGW < NT; t += 4 * NGW) {
        f32x4 q0[4], q1[4]; v2u w[4][4];
#pragma unroll
        for (int u = 0; u < 4; ++u) { const size_t tt = (size_t)(t + u * NGW); q0[u] = *(const f32x4*)(RS8 + tt * 8); q1[u] = *(const f32x4*)(RS8 + tt * 8 + 4);
#pragma unroll
            for (int q = 0; q < 4; ++q) w[u][q] = *(const v2u*)(X + tt * DM + 256 * q + 4 * lane); }
#pragma unroll
        for (int u = 0; u < 4; ++u) { const size_t tt = (size_t)(t + u * NGW);
            const float rs = 1.f / sqrtf((((q0[u].x + q0[u].y) + (q0[u].z + q0[u].w)) + ((q1[u].x + q1[u].y) + (q1[u].z + q1[u].w))) * (1.f / DM) + EPS);
#pragma unroll
            for (int q = 0; q < 4; ++q) *(f32x4*)(OUT + tt * DM + 256 * q + 4 * lane) = (f32x4){bf_lo(w[u][q].x), bf_hi(w[u][q].x), bf_lo(w[u][q].y), bf_hi(w[u][q].y)} * rs * g4[q]; }
    }
    for (; t < NT; t += NGW) {
        const f32x4 q0 = *(const f32x4*)(RS8 + (size_t)t * 8), q1 = *(const f32x4*)(RS8 + (size_t)t * 8 + 4);
        const float rs = 1.f / sqrtf((((q0.x + q0.y) + (q0.z + q0.w)) + ((q1.x + q1.y) + (q1.z + q1.w))) * (1.f / DM) + EPS);
#pragma unroll
        for (int q = 0; q < 4; ++q) { const v2u w = *(const v2u*)(X + (size_t)t * DM + 256 * q + 4 * lane);
            *(f32x4*)(OUT + (size_t)t * DM + 256 * q + 4 * lane) = (f32x4){bf_lo(w.x), bf_hi(w.x), bf_lo(w.y), bf_hi(w.y)} * rs * g4[q]; }
    }
}
}

namespace gla {
__device__ __forceinline__ void prep_unit(Frame& F, int item) {
    const int tid = F.tid, bh = item >> 7, chunk = item & 127, b = bh >> 2, h = bh & 3;
    const int t0 = b * SEQ + 64 * chunk;
    bf16* KG = (bf16*)(F.ws + S1_K); bf16* VG = (bf16*)(F.ws + S1_V); const float* ZG = (const float*)(F.ws + S1_Z);
    float* DEC = (float*)(F.ws + WS_DEC);
    LAS float* TOT = (LAS float*)F.lds;
    LAS bf16* VL = (LAS bf16*)(F.lds + 4096);
    const int dk = tid & 127, seg = tid >> 7;
    float w2r[16];
#pragma unroll
    for (int j = 0; j < 16; ++j) w2r[j] = F.in[I_WG2][j * 512 + h * 128 + dk];
    const float b2 = F.in[I_BG2][h * 128 + dk];
    float cum[16], kv[16]; float run = 0.f;
#pragma unroll
    for (int j = 0; j < 16; ++j) { const int s = 16 * seg + j; const float* zp = ZG + (size_t)(t0 + s) * 16;
        const f32x4 z0 = *(const f32x4*)zp, z1 = *(const f32x4*)(zp + 4), z2 = *(const f32x4*)(zp + 8), z3 = *(const f32x4*)(zp + 12);
        float xg = b2 + z0.x * w2r[0] + z0.y * w2r[1] + z0.z * w2r[2] + z0.w * w2r[3] + z1.x * w2r[4] + z1.y * w2r[5] + z1.z * w2r[6] + z1.w * w2r[7]
                      + z2.x * w2r[8] + z2.y * w2r[9] + z2.z * w2r[10] + z2.w * w2r[11] + z3.x * w2r[12] + z3.y * w2r[13] + z3.z * w2r[14] + z3.w * w2r[15];
        const float la = (fminf(xg, 0.f) - __builtin_amdgcn_logf(1.f + fast_exp2(-fabsf(xg) * LOG2E)) * 0.6931471805599453f) * (1.f / 16.f);
        run += la; cum[j] = run; kv[j] = bf2f(KG[(size_t)(t0 + s) * 512 + h * 128 + dk]); }
    TOT[seg * 128 + dk] = run;
#pragma unroll
    for (int i = 0; i < 4; ++i) { const int q = tid + 512 * i, s = q >> 5, cc = q & 31; const v4u v = *(const v4u*)(VG + (size_t)(t0 + s) * 1024 + h * 256 + 8 * cc);
        *(LAS v2u*)(VL + s * 264 + 8 * cc) = (v2u){v.x, v.y}; *(LAS v2u*)(VL + s * 264 + 8 * cc + 4) = (v2u){v.z, v.w}; }
    __syncthreads();
    float off = 0.f, total = 0.f;
#pragma unroll
    for (int g = 0; g < 4; ++g) { const float tg = TOT[g * 128 + dk]; total += tg; if (g < seg) off += tg; }
    unsigned pk[8];
#pragma unroll
    for (int j = 0; j < 16; j += 2) pk[j >> 1] = pk2(kv[j] * fast_exp2((total - (off + cum[j])) * LOG2E), kv[j + 1] * fast_exp2((total - (off + cum[j + 1])) * LOG2E));
    bf16* kd = KG + (size_t)(t0 + (dk >> 1)) * 512 + h * 128 + (dk & 1) * 64 + 16 * seg;
    *(v4u*)kd = (v4u){pk[0], pk[1], pk[2], pk[3]}; *(v4u*)(kd + 8) = (v4u){pk[4], pk[5], pk[6], pk[7]};
    if (seg == 0) DEC[(size_t)item * 128 + dk] = fast_exp2(total * LOG2E);
#pragma unroll
    for (int i = 0; i < 4; ++i) { const int o = tid + 512 * i, dv = o >> 3, sb = o & 7; unsigned w[4];
#pragma unroll
        for (int j = 0; j < 4; ++j) w[j] = (unsigned)VL[(8 * sb + 2 * j) * 264 + dv] | ((unsigned)VL[(8 * sb + 2 * j + 1) * 264 + dv] << 16);
        *(v4u*)(VG + (size_t)(t0 + (dv >> 2)) * 1024 + h * 256 + (dv & 3) * 64 + 8 * sb) = (v4u){w[0], w[1], w[2], w[3]}; }
    __syncthreads();
}
__device__ __forceinline__ int crow(int r, int hi) { return (r & 3) + 8 * (r >> 2) + 4 * hi; }
constexpr int NSEG = 16, CPS = 128 / NSEG;
constexpr int SK_KSTR = 144, SK_QSTR = 264;
constexpr int SK_OFF_Q = 128 * SK_KSTR, SK_OFF_D = SK_OFF_Q + 64 * SK_QSTR, SK_BUF = SK_OFF_D + 512;
template <bool READOUT>
__device__ __forceinline__ void scan_task(Frame& F, int bh, int seg, int w) {
    const int tid = F.tid, lane = F.lane, r32 = lane & 31, hi = lane >> 5, b = bh >> 2, h = bh & 3;
    const bf16* QG = (const bf16*)(F.ws + S1_Q); const bf16* KG = (const bf16*)(F.ws + S1_K); const bf16* VG = (const bf16*)(F.ws + S1_V);
    const float* DEC = (const float*)(F.ws + WS_DEC); bf16* OUT = (bf16*)(F.ws + WS_XRES);
    float* LSEG = (float*)(F.ws + WS_LSEG); float* PSEG = (float*)(F.ws + WS_PSEG);
    LAS unsigned char* lds = F.lds;
    f32x16 st[4];
#pragma unroll
    for (int d = 0; d < 4; ++d)
#pragma unroll
        for (int r = 0; r < 16; ++r) st[d][r] = 0.f;
    if (!READOUT && w == 0) {
        float p0 = 1.f, p1 = 1.f;
#pragma unroll
        for (int c = 0; c < CPS; ++c) { const float* dc = DEC + (size_t)(bh * 128 + seg * CPS + c) * 128; p0 *= dc[lane]; p1 *= dc[64 + lane]; }
        PSEG[(size_t)(bh * NSEG + seg) * 128 + lane] = p0; PSEG[(size_t)(bh * NSEG + seg) * 128 + 64 + lane] = p1;
    }
    const unsigned lv = (unsigned)((r32 >> 2) * 1024 + (r32 & 3) * 64 + 8 * hi);
    const unsigned lo = (unsigned)(4 * hi * 1024 + r32);
    const unsigned ld = (unsigned)(4 * hi);
    if (READOUT) {
#pragma unroll 1
        for (int j = 0; j < seg; ++j) {
            const float* pj = PSEG + (size_t)(bh * NSEG + j) * 128; const float* lj = LSEG + ((size_t)((bh * NSEG + j) * 8 + w) * 16) * 256;
#pragma unroll
            for (int db = 0; db < 4; ++db)
#pragma unroll
                for (int rg = 0; rg < 4; ++rg) { const f32x4 p4 = *(const f32x4*)(pj + 32 * db + 8 * rg + ld), l4 = *(const f32x4*)(lj + (size_t)(db * 4 + rg) * 256 + 4 * lane);
                    st[db][4 * rg] = st[db][4 * rg] * p4.x + l4.x; st[db][4 * rg + 1] = st[db][4 * rg + 1] * p4.y + l4.y; st[db][4 * rg + 2] = st[db][4 * rg + 2] * p4.z + l4.z; st[db][4 * rg + 3] = st[db][4 * rg + 3] * p4.w + l4.w; }
        }
    }
    const int srow = tid >> 4, spiece = tid & 15;
    const unsigned kdst = (unsigned)((2 * srow + (spiece >> 3)) * SK_KSTR + (spiece & 7) * 16), qdst = (unsigned)(SK_OFF_Q + srow * SK_QSTR + spiece * 16);
    v4u rk0, rk1, rq0, rq1; f32x4 rd; bf16x8 bu[4];
#define SK_LOAD(ch) do { const int t0_ = b * SEQ + 64 * (ch); const bf16* kp_ = KG + (size_t)(t0_ + srow) * 512 + h * 128 + spiece * 8; rk0 = *(const v4u*)kp_; rk1 = *(const v4u*)(kp_ + (size_t)32 * 512); \
        if (READOUT) { const bf16* qp_ = QG + (size_t)(t0_ + srow) * 512 + h * 128 + spiece * 8; rq0 = *(const v4u*)qp_; rq1 = *(const v4u*)(qp_ + (size_t)32 * 512); } \
        if (tid < 32) rd = *(const f32x4*)(DEC + (size_t)(bh * 128 + (ch)) * 128 + 4 * tid); \
        const bf16* vb_ = VG + (size_t)(t0_ + 8 * w) * 1024 + h * 256; _Pragma("unroll") for (int ks = 0; ks < 4; ++ks) bu[ks] = *(const bf16x8*)(vb_ + 16 * ks + lv); } while (0)
#define SK_STORE(bf) do { LAS unsigned char* bb_ = lds + (bf) * SK_BUF; *(LAS v4u*)(bb_ + kdst) = rk0; *(LAS v4u*)(bb_ + kdst + 64 * SK_KSTR) = rk1; \
        if (READOUT) { *(LAS v2u*)(bb_ + qdst) = (v2u){rq0.x, rq0.y}; *(LAS v2u*)(bb_ + qdst + 8) = (v2u){rq0.z, rq0.w}; *(LAS v2u*)(bb_ + qdst + 32 * SK_QSTR) = (v2u){rq1.x, rq1.y}; *(LAS v2u*)(bb_ + qdst + 32 * SK_QSTR + 8) = (v2u){rq1.z, rq1.w}; } \
        if (tid < 32) *(LAS f32x4*)(bb_ + SK_OFF_D + 16 * tid) = rd; } while (0)
    SK_LOAD(seg * CPS); SK_STORE(0);
    bf16x8 bc[4];
#pragma unroll
    for (int ks = 0; ks < 4; ++ks) bc[ks] = bu[ks];
    __syncthreads();
#pragma unroll 1
    for (int i = 0; i < CPS; ++i) {
        const int chunk = seg * CPS + i, buf = i & 1;
        if (i + 1 < CPS) SK_LOAD(chunk + 1);
        const LAS unsigned char* bb = lds + buf * SK_BUF;
#pragma unroll
        for (int db = 0; db < 4; ++db) {
            bf16x8 au[4];
#pragma unroll
            for (int ks = 0; ks < 4; ++ks) au[ks] = *(const LAS bf16x8*)(bb + (32 * db + r32) * SK_KSTR + 32 * ks + 16 * hi);
#pragma unroll
            for (int rg = 0; rg < 4; ++rg) { const f32x4 d4 = *(const LAS f32x4*)(bb + SK_OFF_D + 4 * (32 * db + 8 * rg + 4 * hi));
                st[db][4 * rg] *= d4.x; st[db][4 * rg + 1] *= d4.y; st[db][4 * rg + 2] *= d4.z; st[db][4 * rg + 3] *= d4.w; }
#pragma unroll
            for (int ks = 0; ks < 4; ++ks) st[db] = __builtin_amdgcn_mfma_f32_32x32x16_bf16(au[ks], bc[ks], st[db], 0, 0, 0);
        }
        if (READOUT) {
            bf16* ob = OUT + (size_t)(b * SEQ + 64 * chunk) * 1024 + h * 256 + 32 * w;
#pragma unroll
            for (int sb = 0; sb < 2; ++sb) {
                f32x16 oa;
#pragma unroll
                for (int r = 0; r < 16; ++r) oa[r] = 0.f;
                const LAS unsigned char* qp = bb + SK_OFF_Q + (32 * sb + r32) * SK_QSTR + 8 * hi;
#pragma unroll
                for (int db = 0; db < 4; ++db)
#pragma unroll
                    for (int hs = 0; hs < 2; ++hs) {
                        const v2u qa = *(const LAS v2u*)(qp + 2 * (32 * db + 16 * hs)), qc = *(const LAS v2u*)(qp + 2 * (32 * db + 16 * hs) + 16);
                        const v4u aw = {qa.x, qa.y, qc.x, qc.y};
                        const v4u bw = {pk2(st[db][8 * hs], st[db][8 * hs + 1]), pk2(st[db][8 * hs + 2], st[db][8 * hs + 3]), pk2(st[db][8 * hs + 4], st[db][8 * hs + 5]), pk2(st[db][8 * hs + 6], st[db][8 * hs + 7])};
                        oa = __builtin_amdgcn_mfma_f32_32x32x16_bf16(__builtin_bit_cast(bf16x8, aw), __builtin_bit_cast(bf16x8, bw), oa, 0, 0, 0);
                    }
#pragma unroll
                for (int r = 0; r < 16; ++r) ob[(size_t)(32 * sb + (r & 3) + 8 * (r >> 2)) * 1024 + lo] = f2bf(oa[r]);
            }
        }
        if (i + 1 < CPS) { SK_STORE(buf ^ 1);
#pragma unroll
            for (int ks = 0; ks < 4; ++ks) bc[ks] = bu[ks]; }
        __syncthreads();
    }
#undef SK_LOAD
#undef SK_STORE
    if (!READOUT) {
        float* lj = LSEG + ((size_t)((bh * NSEG + seg) * 8 + w) * 16) * 256;
#pragma unroll
        for (int db = 0; db < 4; ++db)
#pragma unroll
            for (int rg = 0; rg < 4; ++rg) *(f32x4*)(lj + (size_t)(db * 4 + rg) * 256 + 4 * lane) = (f32x4){st[db][4 * rg], st[db][4 * rg + 1], st[db][4 * rg + 2], st[db][4 * rg + 3]};
    }
}
__device__ __forceinline__ void cu_self_fence(Frame& F) {
    asm volatile("s_waitcnt vmcnt(0)" ::: "memory"); __syncthreads();
    if (F.tid == 0) { __threadfence(); asm volatile("s_waitcnt vmcnt(0)" ::: "memory"); }
    __syncthreads();
}
__device__ __forceinline__ void post_tokens(Frame& F, int bh, int seg);
template <bool READOUT>
__device__ __forceinline__ void scan_phase(Frame& F) {
#pragma unroll 1
    for (int a = F.vcu; a < 16 * NSEG; a += F.G) {
        const int bh = a / NSEG, seg = a % NSEG;
        if (!READOUT) { for (int c = 0; c < CPS; ++c) prep_unit(F, bh * 128 + seg * CPS + c); cu_self_fence(F); }
        scan_task<READOUT>(F, bh, seg, F.wave);
        if (READOUT) { cu_self_fence(F); post_tokens(F, bh, seg); }
    }
}
__device__ __forceinline__ void post_phase(Frame& F) {
    const int lane = F.lane; bf16* OUT = (bf16*)(F.ws + WS_XRES); const bf16* GG = (const bf16*)(F.ws + S1_G);
    const float* gn = F.in[I_GLAG] + (lane & 15) * 16;
    float g[16];
#pragma unroll
    for (int i = 0; i < 16; ++i) g[i] = gn[i];
    const int gw = F.vcu * NWAVES + F.wave, NGW = F.G * NWAVES;
    for (int t = gw; t < NT; t += NGW) {
        const v4u o0 = *(const v4u*)(OUT + (size_t)t * 1024 + 16 * lane), o1 = *(const v4u*)(OUT + (size_t)t * 1024 + 16 * lane + 8);
        const v4u g0 = *(const v4u*)(GG + (size_t)t * 1024 + 16 * lane), g1 = *(const v4u*)(GG + (size_t)t * 1024 + 16 * lane + 8);
        float o[16], sg[16];
        o[0] = bf_lo(o0.x); o[1] = bf_hi(o0.x); o[2] = bf_lo(o0.y); o[3] = bf_hi(o0.y); o[4] = bf_lo(o0.z); o[5] = bf_hi(o0.z); o[6] = bf_lo(o0.w); o[7] = bf_hi(o0.w);
        o[8] = bf_lo(o1.x); o[9] = bf_hi(o1.x); o[10] = bf_lo(o1.y); o[11] = bf_hi(o1.y); o[12] = bf_lo(o1.z); o[13] = bf_hi(o1.z); o[14] = bf_lo(o1.w); o[15] = bf_hi(o1.w);
        sg[0] = bf_lo(g0.x); sg[1] = bf_hi(g0.x); sg[2] = bf_lo(g0.y); sg[3] = bf_hi(g0.y); sg[4] = bf_lo(g0.z); sg[5] = bf_hi(g0.z); sg[6] = bf_lo(g0.w); sg[7] = bf_hi(g0.w);
        sg[8] = bf_lo(g1.x); sg[9] = bf_hi(g1.x); sg[10] = bf_lo(g1.y); sg[11] = bf_hi(g1.y); sg[12] = bf_lo(g1.z); sg[13] = bf_hi(g1.z); sg[14] = bf_lo(g1.w); sg[15] = bf_hi(g1.w);
        float ss = 0.f;
#pragma unroll
        for (int i = 0; i < 16; ++i) ss += o[i] * o[i];
        ss = row16_sum(ss);
        const float rs = 1.f / sqrtf(ss * (1.f / 256.f) + EPS);
        float y[16];
#pragma unroll
        for (int i = 0; i < 16; ++i) y[i] = o[i] * rs * g[i] * sg[i];
        *(v4u*)(OUT + (size_t)t * 1024 + 16 * lane) = (v4u){pk2(y[0], y[1]), pk2(y[2], y[3]), pk2(y[4], y[5]), pk2(y[6], y[7])};
        *(v4u*)(OUT + (size_t)t * 1024 + 16 * lane + 8) = (v4u){pk2(y[8], y[9]), pk2(y[10], y[11]), pk2(y[12], y[13]), pk2(y[14], y[15])};
    }
}
__device__ __forceinline__ void post_tokens(Frame& F, int bh, int seg) {
    const int lane = F.lane, b = bh >> 2, h = bh & 3; bf16* OUT = (bf16*)(F.ws + WS_XRES); const bf16* GG = (const bf16*)(F.ws + S1_G);
    const float* gn = F.in[I_GLAG] + (lane & 15) * 16;
    float g[16];
#pragma unroll
    for (int i = 0; i < 16; ++i) g[i] = gn[i];
    const int tbase = b * SEQ + 64 * CPS * seg;
    const size_t off0 = (size_t)(tbase + F.wave * 4 + (lane >> 4)) * 1024 + h * 256 + 16 * (lane & 15);
#pragma unroll 1
    for (int half = 0; half < (64 * CPS) / 256; ++half) {
        v4u O0[8], O1[8], G0[8], G1[8];
#pragma unroll
        for (int u = 0; u < 8; ++u) { const size_t off = off0 + (size_t)(half * 8 + u) * 32 * 1024;
            O0[u] = *(const v4u*)(OUT + off); O1[u] = *(const v4u*)(OUT + off + 8); G0[u] = *(const v4u*)(GG + off); G1[u] = *(const v4u*)(GG + off + 8); }
#pragma unroll
        for (int u = 0; u < 8; ++u) { const size_t off = off0 + (size_t)(half * 8 + u) * 32 * 1024;
            const v4u o0 = O0[u], o1 = O1[u], g0 = G0[u], g1 = G1[u];
            float o[16], sg[16];
            o[0] = bf_lo(o0.x); o[1] = bf_hi(o0.x); o[2] = bf_lo(o0.y); o[3] = bf_hi(o0.y); o[4] = bf_lo(o0.z); o[5] = bf_hi(o0.z); o[6] = bf_lo(o0.w); o[7] = bf_hi(o0.w);
            o[8] = bf_lo(o1.x); o[9] = bf_hi(o1.x); o[10] = bf_lo(o1.y); o[11] = bf_hi(o1.y); o[12] = bf_lo(o1.z); o[13] = bf_hi(o1.z); o[14] = bf_lo(o1.w); o[15] = bf_hi(o1.w);
            sg[0] = bf_lo(g0.x); sg[1] = bf_hi(g0.x); sg[2] = bf_lo(g0.y); sg[3] = bf_hi(g0.y); sg[4] = bf_lo(g0.z); sg[5] = bf_hi(g0.z); sg[6] = bf_lo(g0.w); sg[7] = bf_hi(g0.w);
            sg[8] = bf_lo(g1.x); sg[9] = bf_hi(g1.x); sg[10] = bf_lo(g1.y); sg[11] = bf_hi(g1.y); sg[12] = bf_lo(g1.z); sg[13] = bf_hi(g1.z); sg[14] = bf_lo(g1.w); sg[15] = bf_hi(g1.w);
            float ss = 0.f;
#pragma unroll
            for (int i = 0; i < 16; ++i) ss += o[i] * o[i];
            ss = row16_sum(ss);
            const float rs = 1.f / sqrtf(ss * (1.f / 256.f) + EPS);
            float y[16];
#pragma unroll
            for (int i = 0; i < 16; ++i) y[i] = o[i] * rs * g[i] * sg[i];
            *(v4u*)(OUT + off) = (v4u){pk2(y[0], y[1]), pk2(y[2], y[3]), pk2(y[4], y[5]), pk2(y[6], y[7])};
            *(v4u*)(OUT + off + 8) = (v4u){pk2(y[8], y[9]), pk2(y[10], y[11]), pk2(y[12], y[13]), pk2(y[14], y[15])}; }
    }
}
}

constexpr int CW_BAR = 4096;
constexpr int N_PHASES = 19;
struct Args { const float* in[25]; float* out; unsigned char* ws; int ph_lo, ph_hi; };
__global__ void __launch_bounds__(NTHREADS, 2) fwd_kernel(Args args) {
    extern __shared__ __attribute__((aligned(16))) unsigned char lds_raw[];
    Frame F;
    F.lds = (LAS unsigned char*)lds_raw;
    F.MISC = (volatile LAS unsigned*)(F.lds + MISC_OFF);
    F.tid = threadIdx.x; F.lane = F.tid & 63; F.wave = __builtin_amdgcn_readfirstlane(F.tid >> 6);
    F.G = gridDim.x; { const int bx = blockIdx.x; F.vcu = (F.G % 8 == 0) ? (bx % 8) * (F.G / 8) + bx / 8 : bx; }
    F.in = (const float* const __attribute__((address_space(4)))*)__builtin_amdgcn_kernarg_segment_ptr();
    F.out = args.out; F.ws = args.ws; F.ctl = (unsigned*)(args.ws + WS_CTL);
    if (F.tid < 64) ((LAS unsigned*)(F.lds + MISC_OFF))[F.tid] = 0u;
    __syncthreads();
    const int lo = args.ph_lo, hi = args.ph_hi;
    const bool multi = (hi - lo) > 1;
    XcdBarrier bar; bar.bar = F.ctl + CW_BAR; bar.x = 0; bar.st = nullptr; bar.w = (unsigned)F.wave;
    F.xcc = (int)xb_xcc_id(); F.xrank = -1;
    if (multi) {
        bar.x = (unsigned)F.xcc; bar.st = F.MISC + 8;
        if (F.tid == 0) F.MISC[10] = xb_add(&bar.bar[XB_XCNT(bar.x)], 1u);
        if (F.tid == 0) { unsigned nloc, nx; xcd_barrier_complete(bar.bar, bar.x, nloc, nx); bar.st[0] = nloc; bar.st[1] = nx; }
        __syncthreads();
        F.xrank = (int)F.MISC[10];
    }
#ifndef PH_MASK
#define PH_MASK 0x7ffff
#endif
#define IN(k) ((((PH_MASK) >> (k)) & 1) && lo <= (k) && (k) < hi)
#ifndef DIAG_A
#define DIAG_A -1
#define DIAG_B -1
#endif
#define STAMP(k) do { if (DIAG_A >= 0 && blockIdx.x == 0 && F.tid == 0) F.MISC[16 + (k)] = (unsigned)__builtin_amdgcn_s_memrealtime(); } while (0)
#define SEAM(k) do { if (IN((k) + 1)) xcd_barrier(bar); STAMP((k) + 1); } while (0)
#define REFRESH() do { F.lane = lane_now(); F.tid = F.wave * 64 + F.lane; } while (0)
    bf16* HN = (bf16*)(F.ws + WS_HN);
    STAMP(0);
    if (IN(0)) { REFRESH(); p0_prologue(F); SEAM(0); }
    if (IN(1)) { REFRESH(); pg8::Gemm g{HN, (const bf16*)(F.ws + WS_WIN0), NT, EVEN_IN, DM}; pg8::StaticOrder S; S.init(NT, EVEN_IN, F.G, (int)blockIdx.x);
        EpiIn0 E{(bf16*)(F.ws + S0_Q), (bf16*)(F.ws + S0_K), (bf16*)(F.ws + S0_VT), (bf16*)(F.ws + S0_GLU)};
        pg8::gemm_phase<EpiIn0, pg8::StaticOrder, true, true>(F.lds, g, S, E, F.wave); SEAM(1); }
    if (IN(2)) { REFRESH(); att::p2_attn_conv(F); SEAM(2); }
    if (IN(3)) { REFRESH(); pg8::Gemm g{(const bf16*)(F.ws + S0_CAT), (const bf16*)(F.ws + WS_WOUT0), NT, DM, DM}; pg8::StaticOrder S; S.init(NT, DM, F.G, (int)blockIdx.x);
        EpiRes<true> E{F.in[I_X], nullptr, HN, (float*)(F.ws + WS_ROWSQ0), F.ws + WS_XH8, F.ws + WS_XL8};
        pg8::gemm_phase<EpiRes<true>, pg8::StaticOrder, true, true>(F.lds, g, S, E, F.wave); SEAM(3); }
    if (IN(4)) { REFRESH(); pg8::Gemm g{HN, (const bf16*)(F.ws + WS_WQ0), NT, PQ_N, DM}; pg8::StaticOrder S; S.init(NT, PQ_N, F.G, (int)blockIdx.x);
        EpiPq E{(bf16*)(F.ws + SP_PQ), (const float*)(F.ws + WS_ROWSQ0), (float*)(F.ws + WS_RSV), (LAS float*)(F.lds + EPI_LRS)};
        pg8::gemm_phase<EpiPq, pg8::StaticOrder, true, true>(F.lds, g, S, E, F.wave); SEAM(4); }
    if (IN(5)) { REFRESH(); for (int rep = 0; rep < PROBE_REP_TOPK; ++rep) peer::topk_phase(F, 0); SEAM(5); }
    if (IN(6)) { REFRESH(); peer::e1_phase(F, 0); SEAM(6); }
    if (IN(7)) { REFRESH(); peer::coef_phase(F); SEAM(7); }
    if (IN(8)) { REFRESH(); peer::e2_phase(F, 0, HN, HN, nullptr); SEAM(8); }
    if (IN(9)) { REFRESH(); pg8::Gemm g{HN, (const bf16*)(F.ws + WS_WIN1), NT, 3072, DM}; pg8::StaticOrder S; S.init(NT, 3072, F.G, (int)blockIdx.x);
        EpiIn1 E{(bf16*)(F.ws + S1_Q), (bf16*)(F.ws + S1_K), (bf16*)(F.ws + S1_V), (bf16*)(F.ws + S1_G), (const float*)(F.ws + WS_RS8), (LAS float*)(F.lds + EPI_LRS)};
        pg8::gemm_phase<EpiIn1, pg8::StaticOrder, true, true>(F.lds, g, S, E, F.wave); z_tail(F); SEAM(9); }
    if (IN(10)) { REFRESH(); for (int rep = 0; rep < PROBE_REP_SCAN; ++rep) gla::scan_phase<false>(F); SEAM(10); }
    if (IN(11)) { REFRESH(); for (int rep = 0; rep < PROBE_REP_SCAN; ++rep) gla::scan_phase<true>(F); SEAM(11); }
    if (IN(12)) { REFRESH(); pg8::Gemm g{(const bf16*)(F.ws + WS_XRES), (const bf16*)(F.ws + WS_WOUT1), NT, DM, DM}; pg8::StaticOrder S; S.init(NT, DM, F.G, (int)blockIdx.x);
        EpiRes<false> E{nullptr, HN, (bf16*)(F.ws + S1_G), (float*)(F.ws + WS_ROWSQ1), F.ws + WS_XH8, F.ws + WS_XL8};
        pg8::gemm_phase<EpiRes<false>, pg8::StaticOrder, true, true>(F.lds, g, S, E, F.wave); SEAM(12); }
    if (IN(13)) { REFRESH(); pg8::Gemm g{(const bf16*)(F.ws + S1_G), (const bf16*)(F.ws + WS_WQ1), NT, PQ_N, DM}; pg8::StaticOrder S; S.init(NT, PQ_N, F.G, (int)blockIdx.x);
        EpiPq E{(bf16*)(F.ws + SP_PQ), (const float*)(F.ws + WS_ROWSQ1), (float*)(F.ws + WS_RSV), (LAS float*)(F.lds + EPI_LRS)};
        pg8::gemm_phase<EpiPq, pg8::StaticOrder, true, true>(F.lds, g, S, E, F.wave); SEAM(13); }
    if (IN(14)) { REFRESH(); peer::topk_phase(F, 1); SEAM(14); }
    if (IN(15)) { REFRESH(); peer::e1_phase(F, 1); SEAM(15); }
    if (IN(16)) { REFRESH(); peer::coef_phase(F); SEAM(16); }
    if (IN(17)) { REFRESH(); peer::e2_phase(F, 1, (const bf16*)(F.ws + S1_G), HN, nullptr); SEAM(17); }
    if (IN(18)) { REFRESH(); peer::final_norm_phase(F); }
    if (DIAG_A >= 0 && blockIdx.x == 0) {
        __syncthreads(); STAMP(19);
        if (F.tid == 0) { const int a = DIAG_A, b = DIAG_B;
            const float da = (a >= 19 ? (float)(F.MISC[16 + 19] - F.MISC[16]) : (float)(F.MISC[16 + a + 1] - F.MISC[16 + a])) * 0.01f;
            const float db = (float)(F.MISC[16 + b + 1] - F.MISC[16 + b]) * 0.01f * 0.125f;
            F.out[0] = da; for (int i = 0; i < 1024; ++i) F.out[1024 + i] = db; }
    }
#undef IN
#undef SEAM
}

#ifndef N_LAUNCH_SPLIT
#define N_LAUNCH_SPLIT 0
#endif
extern "C" void kernel_launch(void* const* d_in, const int* in_sizes, int n_in, void* d_out, int out_size, void* d_ws, size_t ws_size, hipStream_t stream) {
    static int grid = 0;
    if (grid == 0) {
        if (n_in != 25 || out_size != NT * DM || ws_size < WS_END) { fprintf(stderr, "kernel_launch: unexpected shapes (n_in %d out %d ws %zu)\n", n_in, out_size, ws_size); grid = -1; return; }
        int dev = 0, cus = 0;
        if (hipGetDevice(&dev) != hipSuccess || hipDeviceGetAttribute(&cus, hipDeviceAttributeMultiprocessorCount, dev) != hipSuccess) { grid = -1; return; }
        if (hipFuncSetAttribute((const void*)fwd_kernel, hipFuncAttributeMaxDynamicSharedMemorySize, LDS_BYTES) != hipSuccess) { fprintf(stderr, "kernel_launch: hipFuncSetAttribute failed\n"); grid = -1; return; }
        int per_cu = 0;
        if (hipOccupancyMaxActiveBlocksPerMultiprocessor(&per_cu, (const void*)fwd_kernel, NTHREADS, LDS_BYTES) != hipSuccess || per_cu < 1) fprintf(stderr, "kernel_launch: occupancy query says %d\n", per_cu);
        (void)hipGetLastError();
        grid = cus;
    }
    if (grid < 0) return;
    (void)hipMemsetAsync((char*)d_ws + WS_CTL, 0, CTL_ZERO_BYTES, stream);
    Args a{};
    for (int i = 0; i < 25; ++i) a.in[i] = (const float*)d_in[i];
    a.out = (float*)d_out; a.ws = (unsigned char*)d_ws;
#if N_LAUNCH_SPLIT
    for (int p = 0; p < N_PHASES; ++p) { a.ph_lo = p; a.ph_hi = p + 1; hipLaunchKernelGGL(fwd_kernel, dim3(grid), dim3(NTHREADS), LDS_BYTES, stream, a); }
#else
    a.ph_lo = 0; a.ph_hi = N_PHASES; hipLaunchKernelGGL(fwd_kernel, dim3(grid), dim3(NTHREADS), LDS_BYTES, stream, a);
#endif
}
```

```cpp
#include <hip/hip_runtime.h>
#include <cstdio>
#include <cstdint>
#ifndef PROBE_REP_ATTN
#define PROBE_REP_ATTN 1
#define PROBE_REP_SCAN 1
#define PROBE_REP_TOPK 1
#endif
__device__ __forceinline__ int lane_now() { int l; asm volatile("v_mbcnt_lo_u32_b32 %0, -1, 0\n\tv_mbcnt_hi_u32_b32 %0, -1, %0" : "=v"(l)); return l; }
namespace pg8 {
#define PG8_LAS __attribute__((address_space(3)))
typedef unsigned short bf16_t;
typedef short bf16x8 __attribute__((ext_vector_type(8)));
typedef float f32x4 __attribute__((ext_vector_type(4)));
typedef unsigned u32x4 __attribute__((ext_vector_type(4)));
constexpr int BM = 256, BK = 64, HALF = 128, HTB = HALF * BK * 2  , STAGE_BYTES = 8 * HTB, NXCD = 8, WGM = 8;

__host__ __device__ __forceinline__ int lds_byte(int r, int c) { const int st = (r >> 4) * 2 + (c >> 5), rr = r & 15, cc = c & 31, ob = rr * 64 + cc * 2; return st * 1024 + (ob ^ (((ob >> 9) & 1) << 5)); }
__host__ __device__ __forceinline__ void stage_rc(int b, int& R, int& C) { const int st = b / 1024, sb = b % 1024, swz = sb ^ (((sb >> 9) & 1) << 5); R = (st >> 1) * 16 + swz / 64; C = (st & 1) * 32 + (swz % 64) / 2; }
__host__ __device__ __forceinline__ int perm32(int rho) { const int n = rho >> 4, i = rho & 15; return 8 * (i >> 2) + 4 * n + (i & 3); }

struct Unit { int pm, pn; };
struct Gemm { const bf16_t* A; const bf16_t* Bt; int M, N, K; };

struct StaticOrder {
    int nM, nN, nwg, G, c;
    __host__ __device__ void init(int M, int N, int G_, int c_) { nM = M / BM; nN = N / BM; nwg = nM * nN; G = G_; c = c_; }
    __host__ __device__ bool next(int i, Unit& u) const {
        const long L = (long)i * G + c; if (L >= nwg) return false;
        int wgid = (int)L; { const int q = nwg / NXCD, r = nwg % NXCD, xcd = wgid % NXCD, off = wgid / NXCD; wgid = (xcd < r ? xcd * (q + 1) : r * (q + 1) + (xcd - r) * q) + off; }
        const int nig = WGM * nN, gid = wgid / nig, fm = gid * WGM, gsz = (nM - fm) < WGM ? (nM - fm) : WGM;
        u.pm = fm + ((wgid % nig) % gsz); u.pn = (wgid % nig) / gsz; return true;
    }
    __device__ __forceinline__ void a_ready(const Unit&) const {}
    __device__ __forceinline__ void done(const Unit&) const {}
};
__device__ __forceinline__ unsigned cvt_pk_bf16(float lo, float hi) { unsigned r; asm volatile("v_cvt_pk_bf16_f32 %0, %1, %2" : "=v"(r) : "v"(lo), "v"(hi)); return r; }
template <class Epi, class Sched, bool ALIGN_EPI = false, bool SP2 = false>
__device__ __forceinline__ void gemm_phase(PG8_LAS unsigned char* lds, const Gemm g, const Sched& S, const Epi& E, const int wid_in) {
    const int wid = __builtin_amdgcn_readfirstlane(wid_in), lane = lane_now(), tid = wid * 64 + lane, wr = wid >> 2, wc = wid & 3, fr = lane & 15, fq = lane >> 4;
    const int K = g.K, nt = K / BK;
    unsigned voffA[2], voffB[2];
#pragma unroll
    for (int i = 0; i < 2; ++i) { int R, C; stage_rc(tid * 16 + i * 8192, R, C); const int Rb = Epi::PERM ? ((R & ~31) + perm32(R & 31)) : R;
        voffA[i] = (unsigned)(R * K + C) * 2u; voffB[i] = (unsigned)(Rb * K + C) * 2u; }
    const size_t kstep = (size_t)(BK * 2);
    const size_t hstep = (size_t)HALF * K * 2;
    const size_t tstep = 2 * hstep;
    const unsigned ldsw = (unsigned)wid * 1024u;
    const int aoff = lds_byte(wr * 64 + fr, fq * 8), boff = lds_byte(wc * 32 + fr, fq * 8);
#define PG8_SA(b, h) (((b) * 2 + (h)) * HTB)
#define PG8_SB(b, h) ((4 + (b) * 2 + (h)) * HTB)
#define PG8_STAGE(bufoff, gbase, voff) do { _Pragma("unroll") for (int _i = 0; _i < 2; ++_i) \
        __builtin_amdgcn_global_load_lds((const unsigned*)((const char*)(gbase) + (voff)[_i]), (PG8_LAS unsigned*)(lds + (bufoff) + ldsw + _i * 8192), 16, 0, 0); } while (0)
#define PG8_LDA(dst, b, h) do { _Pragma("unroll") for (int m = 0; m < 4; ++m) _Pragma("unroll") for (int k = 0; k < 2; ++k) dst[m][k] = *(const PG8_LAS bf16x8*)(lds + PG8_SA(b, h) + aoff + m * 2048 + k * 1024); } while (0)
#define PG8_LDB(dst, b, h) do { _Pragma("unroll") for (int n = 0; n < 2; ++n) _Pragma("unroll") for (int k = 0; k < 2; ++k) dst[n][k] = *(const PG8_LAS bf16x8*)(lds + PG8_SB(b, h) + boff + n * 2048 + k * 1024); } while (0)
#define PG8_MMA(ai, bj, At, Bt) do { __builtin_amdgcn_s_setprio(1); _Pragma("unroll") for (int m = 0; m < 4; ++m) _Pragma("unroll") for (int n = 0; n < 2; ++n) _Pragma("unroll") for (int k = 0; k < 2; ++k) \
        acc[ai][bj][m][n] = __builtin_amdgcn_mfma_f32_16x16x32_bf16(Bt[n][k], At[m][k], acc[ai][bj][m][n], 0, 0, 0); __builtin_amdgcn_s_setprio(0); } while (0)
#define PG8_WAIT_V(n) asm volatile("s_waitcnt vmcnt(" #n ")" ::: "memory")
#define PG8_WAIT_L(n) asm volatile("s_waitcnt lgkmcnt(" #n ")" ::: "memory")
#define PG8_BAR __builtin_amdgcn_s_barrier()
#define PG8_SCHED __builtin_amdgcn_sched_barrier(0)
    Unit cur, nxt; int ui = 0;
    if (!S.next(0, cur)) return;
    f32x4 acc[2][2][4][2];
#pragma unroll
    for (int a = 0; a < 2; ++a)
#pragma unroll
        for (int b = 0; b < 2; ++b)
#pragma unroll
            for (int m = 0; m < 4; ++m)
#pragma unroll
                for (int n = 0; n < 2; ++n) acc[a][b][m][n] = (f32x4){0.f, 0.f, 0.f, 0.f};
    bf16x8 At[4][2], B0[2][2], B1[2][2];
    const char* cA = (const char*)g.A + (size_t)cur.pm * tstep; const char* cB = (const char*)g.Bt + (size_t)cur.pn * tstep;
    S.a_ready(cur);
    if constexpr (SP2) {
        PG8_STAGE(PG8_SB(0, 0), cB, voffB); PG8_STAGE(PG8_SB(0, 1), cB + hstep, voffB); PG8_STAGE(PG8_SA(0, 0), cA, voffA); PG8_STAGE(PG8_SA(0, 1), cA + hstep, voffA);
        if (wr == 1) PG8_BAR;
        PG8_WAIT_V(2); PG8_BAR;
        PG8_STAGE(PG8_SB(1, 0), cB + kstep, voffB); PG8_STAGE(PG8_SA(1, 0), cA + kstep, voffA); PG8_STAGE(PG8_SB(1, 1), cB + hstep + kstep, voffB);
        PG8_WAIT_V(6); PG8_BAR;
    } else {
        PG8_STAGE(PG8_SB(0, 0), cB, voffB); PG8_STAGE(PG8_SA(0, 0), cA, voffA); PG8_STAGE(PG8_SB(0, 1), cB + hstep, voffB); PG8_STAGE(PG8_SA(0, 1), cA + hstep, voffA);
        if (wr == 1) PG8_BAR;
        PG8_WAIT_V(4); PG8_BAR;
        PG8_STAGE(PG8_SB(1, 0), cB + kstep, voffB); PG8_STAGE(PG8_SA(1, 0), cA + kstep, voffA); PG8_STAGE(PG8_SB(1, 1), cB + hstep + kstep, voffB);
        PG8_WAIT_V(6); PG8_BAR;
    }
    for (;;) {
        const bool has_next = S.next(ui + 1, nxt);
        const char* nA = has_next ? (const char*)g.A + (size_t)nxt.pm * tstep : cA; const char* nB = has_next ? (const char*)g.Bt + (size_t)nxt.pn * tstep : cB;
        for (int t = 0; t < nt; t += 2) {
            const bool last = (t == nt - 2);
            const char* a1 = cA + (size_t)(t + 1) * kstep;
            const char* a2 = last ? nA : cA + (size_t)(t + 2) * kstep; const char* b2 = last ? nB : cB + (size_t)(t + 2) * kstep;
            const char* a3 = a2 + kstep; const char* b3 = b2 + kstep;
            if (last && has_next) S.a_ready(nxt);
            if constexpr (SP2) {
            PG8_LDB(B0, 0, 0); PG8_LDB(B1, 0, 1); PG8_SCHED; PG8_LDA(At, 0, 0); PG8_STAGE(PG8_SA(1, 1), a1 + hstep, voffA);
            PG8_WAIT_V(8); PG8_WAIT_L(0); PG8_BAR; PG8_MMA(0, 0, At, B0); PG8_MMA(0, 1, At, B1); PG8_BAR; PG8_SCHED;
            PG8_LDA(At, 0, 1); PG8_STAGE(PG8_SB(0, 0), b2, voffB); PG8_STAGE(PG8_SB(0, 1), b2 + hstep, voffB); PG8_STAGE(PG8_SA(0, 0), a2, voffA);
            PG8_WAIT_V(8); PG8_WAIT_L(0); PG8_BAR; PG8_MMA(1, 0, At, B0); PG8_MMA(1, 1, At, B1); PG8_BAR; PG8_SCHED;
            PG8_LDB(B0, 1, 0); PG8_LDB(B1, 1, 1); PG8_SCHED; PG8_LDA(At, 1, 0); PG8_STAGE(PG8_SA(0, 1), a2 + hstep, voffA);
            PG8_WAIT_V(8); PG8_WAIT_L(0); PG8_BAR; PG8_MMA(0, 0, At, B0); PG8_MMA(0, 1, At, B1); PG8_BAR; PG8_SCHED;
            PG8_LDA(At, 1, 1); PG8_STAGE(PG8_SB(1, 0), b3, voffB); PG8_STAGE(PG8_SB(1, 1), b3 + hstep, voffB); PG8_STAGE(PG8_SA(1, 0), a3, voffA);
            PG8_WAIT_V(8); PG8_WAIT_L(0); PG8_BAR; PG8_MMA(1, 0, At, B0); PG8_MMA(1, 1, At, B1); PG8_BAR; PG8_SCHED;
            } else {
            PG8_LDB(B0, 0, 0); PG8_SCHED; PG8_LDA(At, 0, 0); PG8_STAGE(PG8_SA(1, 1), a1 + hstep, voffA);
            PG8_WAIT_L(8); PG8_BAR; PG8_WAIT_L(0); PG8_MMA(0, 0, At, B0); PG8_BAR; PG8_SCHED;
            PG8_LDB(B1, 0, 1); PG8_STAGE(PG8_SB(0, 0), b2, voffB);
            PG8_BAR; PG8_WAIT_L(0); PG8_MMA(0, 1, At, B1); PG8_BAR;
            PG8_LDA(At, 0, 1); PG8_STAGE(PG8_SA(0, 0), a2, voffA);
            PG8_BAR; PG8_WAIT_L(0); PG8_MMA(1, 0, At, B0); PG8_BAR; PG8_SCHED;
            PG8_STAGE(PG8_SB(0, 1), b2 + hstep, voffB);
            PG8_WAIT_V(6); PG8_BAR; PG8_MMA(1, 1, At, B1); PG8_BAR;
            PG8_LDB(B0, 1, 0); PG8_SCHED; PG8_LDA(At, 1, 0); PG8_STAGE(PG8_SA(0, 1), a2 + hstep, voffA);
            PG8_WAIT_L(8); PG8_BAR; PG8_WAIT_L(0); PG8_MMA(0, 0, At, B0); PG8_BAR; PG8_SCHED;
            PG8_LDB(B1, 1, 1); PG8_STAGE(PG8_SB(1, 0), b3, voffB);
            PG8_BAR; PG8_WAIT_L(0); PG8_MMA(0, 1, At, B1); PG8_BAR;
            PG8_LDA(At, 1, 1); PG8_STAGE(PG8_SA(1, 0), a3, voffA);
            PG8_BAR; PG8_WAIT_L(0); PG8_MMA(1, 0, At, B0); PG8_BAR; PG8_SCHED;
            PG8_STAGE(PG8_SB(1, 1), b3 + hstep, voffB);
            PG8_WAIT_V(6); PG8_BAR; PG8_MMA(1, 1, At, B1); PG8_BAR;
            }
        }
        if constexpr (ALIGN_EPI) { if (wr == 0) PG8_BAR; }
        if constexpr (!Epi::AFTER_DRAIN) { E(acc, cur, wr, wc, fr, fq); S.done(cur); }
        if (!has_next) break;
#pragma unroll
        for (int a = 0; a < 2; ++a)
#pragma unroll
            for (int b = 0; b < 2; ++b)
#pragma unroll
                for (int m = 0; m < 4; ++m)
#pragma unroll
                    for (int n = 0; n < 2; ++n) acc[a][b][m][n] = (f32x4){0.f, 0.f, 0.f, 0.f};
        cur = nxt; cA = nA; cB = nB; ++ui;
        if constexpr (ALIGN_EPI) { if (wr == 1) PG8_BAR; }
    }
    PG8_WAIT_V(0);
    if constexpr (!ALIGN_EPI) { if (wr == 0) PG8_BAR; }
    PG8_BAR;
    if constexpr (Epi::AFTER_DRAIN) { E.fused(acc, cur, wr, wc, fr, fq, lds, wid, lane); S.done(cur); }
#undef PG8_SA
#undef PG8_SB
#undef PG8_STAGE
#undef PG8_LDA
#undef PG8_LDB
#undef PG8_MMA
#undef PG8_WAIT_V
#undef PG8_WAIT_L
#undef PG8_BAR
#undef PG8_SCHED
}
}

constexpr int NB = 4, SEQ = 8192, DM = 1024, NT = NB * SEQ;
constexpr int EVEN_IN = 2560, ODD_IN = 3088, ODD_IN_PAD = 3328, PQ_N = 2048;
constexpr int NEXP = 16384;
constexpr float EPS = 1e-6f;
constexpr float LOG2E = 1.4426950408889634f;
constexpr float QSCALE_ATT = 0.125f * LOG2E;
constexpr float QSCALE_GLA = 0.08838834764831845f;
constexpr float LAM_INIT0 = 0.2f;
constexpr float U_SCALE = 1024.f, V_SCALE = 128.f;

constexpr size_t MiB = 1u << 20;
constexpr size_t WS_CTL = 0, CTL_ZERO_BYTES = 32 * 1024;
constexpr size_t WS_ROWSQ0 = 27 * MiB, WS_ROWSQ1 = 29 * MiB;
constexpr size_t WS_DEC = 1 * MiB;
constexpr size_t WS_WIN0 = 2 * MiB, WS_WOUT0 = 7 * MiB, WS_WIN1 = 9 * MiB, WS_WOUT1 = 16 * MiB, WS_WQ0 = 18 * MiB, WS_WQ1 = 22 * MiB, WS_SK = 26 * MiB;
constexpr size_t WS_UT = 32 * MiB, WS_VT = 96 * MiB;
constexpr size_t WS_HN = 160 * MiB;
constexpr size_t WS_IDS = 224 * MiB, WS_GATE = 240 * MiB;
constexpr size_t WS_SCR = 256 * MiB;
constexpr size_t WS_XRES = 448 * MiB;
constexpr size_t S0_Q = WS_SCR, S0_K = WS_SCR + 32 * MiB, S0_VT = WS_SCR + 64 * MiB, S0_GLU = WS_SCR + 96 * MiB, S0_CAT = WS_SCR + 128 * MiB;
constexpr size_t SP_PQ = WS_SCR;
constexpr size_t S1_Q = WS_SCR, S1_K = WS_SCR + 32 * MiB, S1_V = WS_SCR + 64 * MiB, S1_G = WS_SCR + 128 * MiB, S1_Z = 27 * MiB;
constexpr size_t WS_LSEG = WS_IDS;
constexpr size_t WS_PSEG = 768 * 1024;
constexpr size_t WS_RSV = 512 * 1024;
constexpr size_t WS_XH8 = 64 * MiB, WS_XL8 = 128 * MiB;
constexpr size_t WS_RS8 = 31 * MiB;
constexpr size_t SP_PART = WS_SCR;
constexpr size_t WS_CH8 = 1 * MiB, WS_CL8 = 5 * MiB;
constexpr size_t WS_END = 512 * MiB;

constexpr int LDS_BYTES = 155648;
constexpr int MISC_OFF = LDS_BYTES - 256;
constexpr int NWAVES = 8, NTHREADS = 512;

#define GAS __attribute__((address_space(1)))
#define LAS __attribute__((address_space(3)))
typedef unsigned short bf16;
typedef unsigned v4u __attribute__((ext_vector_type(4)));
typedef unsigned v2u __attribute__((ext_vector_type(2)));
typedef float f32x4 __attribute__((ext_vector_type(4)));
typedef float f32x16 __attribute__((ext_vector_type(16)));
typedef short bf16x8 __attribute__((ext_vector_type(8)));
typedef short v4s16 __attribute__((ext_vector_type(4)));
typedef int v8i_t __attribute__((ext_vector_type(8)));
typedef float f32x2_t __attribute__((ext_vector_type(2)));
typedef __bf16 bf16x2_t __attribute__((ext_vector_type(2)));
#define LDS_WAIT() asm volatile("s_waitcnt lgkmcnt(0)" ::: "memory")
#define VM_WAIT() asm volatile("s_waitcnt vmcnt(0)" ::: "memory")
__device__ __forceinline__ unsigned pk2(float lo, float hi) { f32x2_t v = {lo, hi}; bf16x2_t b = __builtin_convertvector(v, bf16x2_t); return __builtin_bit_cast(unsigned, b); }
__device__ __forceinline__ float bf_lo(unsigned w) { return __builtin_bit_cast(float, w << 16); }
__device__ __forceinline__ float bf_hi(unsigned w) { return __builtin_bit_cast(float, w & 0xffff0000u); }
__device__ __forceinline__ float bf2f(bf16 v) { return __builtin_bit_cast(float, (unsigned)v << 16); }
__device__ __forceinline__ bf16 f2bf(float f) { return (bf16)(pk2(f, 0.f) & 0xffffu); }
template <int CTRL, int ROWMASK>
__device__ __forceinline__ float dpp_get(float v) { return __builtin_bit_cast(float, __builtin_amdgcn_update_dpp(0, __builtin_bit_cast(int, v), CTRL, ROWMASK, 0xf, false)); }
__device__ __forceinline__ float row16_sum(float v) {
    v += dpp_get<0xB1, 0xf>(v); v += dpp_get<0x4E, 0xf>(v); v += dpp_get<0x124, 0xf>(v); v += dpp_get<0x128, 0xf>(v); return v;
}
__device__ __forceinline__ float wave_sum(float v) {
    v += dpp_get<0xB1, 0xf>(v);
    v += dpp_get<0x4E, 0xf>(v);
    v += dpp_get<0x124, 0xf>(v);
    v += dpp_get<0x128, 0xf>(v);
    v += dpp_get<0x142, 0xa>(v);
    v += dpp_get<0x143, 0xc>(v);
    return __builtin_bit_cast(float, __builtin_amdgcn_readlane(__builtin_bit_cast(int, v), 63));
}
__device__ __forceinline__ float vmax3(float a, float b, float c) { float r; asm("v_max3_f32 %0, %1, %2, %3" : "=v"(r) : "v"(a), "v"(b), "v"(c)); return r; }
__device__ __forceinline__ float fast_exp2(float x) { return __builtin_amdgcn_exp2f(x); }
__device__ __forceinline__ float fast_rcp(float x) { return __builtin_amdgcn_rcpf(x); }
__device__ __forceinline__ float sigmoidf_(float x) { return fast_rcp(1.f + fast_exp2(-x * LOG2E)); }
__device__ __forceinline__ float siluf_(float x) { return x * sigmoidf_(x); }
#define XB_TMO      128
#define XB_XCNT(j)  (256  + 64 * (j))
#define XB_XSUB(j)  (1280 + 64 * (j))
#define XB_XGEN(j)  (2304 + 64 * (j))
#define XB_TOP      3328
#define XB_TOPGEN   3392
#define XCD_BAR_WORDS 3456
#define XB_SPIN_CAP (1u << 18)

__device__ __forceinline__ unsigned xb_ld(unsigned* p)              { return __hip_atomic_load(p, __ATOMIC_RELAXED, __HIP_MEMORY_SCOPE_AGENT); }
__device__ __forceinline__ unsigned xb_add(unsigned* p, unsigned v) { return __hip_atomic_fetch_add(p, v, __ATOMIC_RELAXED, __HIP_MEMORY_SCOPE_AGENT); }
__device__ __forceinline__ unsigned xb_xcc_id() { return (unsigned)__builtin_amdgcn_s_getreg((3 << 11) | 20) & 0xFu; }
#define XB_SPIN(cond, bar) do { unsigned _sp = 0; while (cond) { __builtin_amdgcn_s_sleep(1); \
    if ((++_sp & 255u) == 0u) { if (xb_ld(&(bar)[XB_TMO])) break; if (_sp > XB_SPIN_CAP) { atomicAdd(&(bar)[XB_TMO], 1u); break; } } } } while (0)

struct XcdBarrier {
    unsigned* bar; unsigned x;
    unsigned w;
    volatile LAS unsigned* st;
};

__device__ __forceinline__ XcdBarrier xcd_barrier_post(unsigned* bar, volatile LAS unsigned* st) {
    XcdBarrier b; b.bar = bar; b.x = xb_xcc_id(); b.st = st; b.w = (unsigned)__builtin_amdgcn_readfirstlane(threadIdx.x >> 6);
    if (threadIdx.x == 0) (void)xb_add(&bar[XB_XCNT(b.x)], 1u);
    return b;
}
__device__ __forceinline__ void xcd_barrier_complete(unsigned* bar, unsigned x, unsigned& nloc, unsigned& nx) {
    const unsigned G = gridDim.x * gridDim.y * gridDim.z;
    unsigned sum, cnt, mine, sp = 0u;
    for (;;) {
        sum = 0u; cnt = 0u; mine = 0u;
#pragma unroll
        for (unsigned j = 0; j < 16; ++j) { const unsigned c = xb_ld(&bar[XB_XCNT(j)]); sum += c; cnt += (c > 0u) ? 1u : 0u; mine = (j == x) ? c : mine; }
        if (sum == G) break;
        __builtin_amdgcn_s_sleep(1);
        if ((++sp & 255u) == 0u) { if (xb_ld(&bar[XB_TMO])) break; if (sp > XB_SPIN_CAP) { atomicAdd(&bar[XB_TMO], 1u); break; } }
    }
    nloc = mine > 0u ? mine : 1u; nx = cnt > 0u ? cnt : 1u;
}

__device__ __forceinline__ void xcd_barrier(const XcdBarrier& b) {
    asm volatile("s_waitcnt vmcnt(0)" ::: "memory");
    __syncthreads();
    if (b.w == 0u && lane_now() == 0) {
        unsigned* bar = b.bar;
        __builtin_amdgcn_s_waitcnt(0);
        unsigned nloc = b.st[0], nx = b.st[1];
        const unsigned old = xb_add(&bar[XB_XSUB(b.x)], 1u);
        const unsigned gen = old / nloc;
        if (old + 1u == (gen + 1u) * nloc) {
            __builtin_amdgcn_fence(__ATOMIC_RELEASE, "agent");
            asm volatile("s_waitcnt vmcnt(0)" ::: "memory");
            const unsigned og = xb_add(&bar[XB_TOP], 1u);
            const unsigned tg = og / nx;
            if (og + 1u == (tg + 1u) * nx) xb_add(&bar[XB_TOPGEN], 1u);
            else XB_SPIN(xb_ld(&bar[XB_TOPGEN]) == tg, bar);
            __builtin_amdgcn_fence(__ATOMIC_ACQUIRE, "agent");
            xb_add(&bar[XB_XGEN(b.x)], 1u);
            asm volatile("s_waitcnt vmcnt(0)" ::: "memory");
        } else {
            XB_SPIN(xb_ld(&bar[XB_XGEN(b.x)]) == gen, bar);
            __builtin_amdgcn_fence(__ATOMIC_ACQUIRE, "agent");
            asm volatile("s_waitcnt vmcnt(0)" ::: "memory");
        }
    }
    __syncthreads();
}

struct Frame {
    LAS unsigned char* lds;
    volatile LAS unsigned* MISC;
    unsigned* ctl;
    int tid, lane, wave;
    int vcu, G;
    int xcc, xrank;
    const float* const __attribute__((address_space(4)))* in;
    float* out;
    unsigned char* ws;
};
enum { I_X = 0, I_RELB, I_LNMIX, I_LNFFN, I_EWIN, I_LQ1, I_LK1, I_LQ2, I_LK2, I_SUBLN, I_CONVW, I_CONVB, I_CLNG, I_CLNB, I_EWOUT, I_OWIN, I_WG2, I_BG2, I_GLAG, I_OWOUT, I_PWQ, I_PSK, I_PU, I_PV, I_LNF };

__device__ __forceinline__ void p0_transpose_item(const float* W, int Nsrc, bf16* WT, int kb, int dstrow0, int srccol0, const float* gain, LAS float* scr, int lane) {
    const int k0 = 64 * kb; const int col = srccol0 + (lane & 31); const bool ok = col < Nsrc; const int colc = ok ? col : 0;
    const float* wp = W + (size_t)(k0 + (lane >> 5)) * Nsrc + colc;
#pragma unroll 8
    for (int i = 0; i < 32; ++i) { const float v = wp[(size_t)(2 * i) * Nsrc]; scr[(2 * i + (lane >> 5)) * 33 + (lane & 31)] = ok ? v : 0.f; }
    LDS_WAIT(); asm volatile("" ::: "memory");
    const int c = lane & 7;
    f32x4 g0 = {1.f, 1.f, 1.f, 1.f}, g1 = {1.f, 1.f, 1.f, 1.f};
    if (gain) { g0 = *(const f32x4*)(gain + k0 + 8 * c); g1 = *(const f32x4*)(gain + k0 + 8 * c + 4); }
#pragma unroll
    for (int j = 0; j < 4; ++j) { const int n = (lane >> 3) + 8 * j; const LAS float* s = scr + (8 * c) * 33 + n;
        v4u o; o.x = pk2(s[0 * 33] * g0.x, s[1 * 33] * g0.y); o.y = pk2(s[2 * 33] * g0.z, s[3 * 33] * g0.w); o.z = pk2(s[4 * 33] * g1.x, s[5 * 33] * g1.y); o.w = pk2(s[6 * 33] * g1.z, s[7 * 33] * g1.w);
        *(v4u*)(WT + (size_t)(dstrow0 + n) * 1024 + k0 + 8 * c) = o; }
    LDS_WAIT(); asm volatile("" ::: "memory");
}
__device__ __forceinline__ int win0_src(int dstrow) { if (dstrow < 1536) return dstrow; const int r = dstrow - 1536, j = r >> 8, half = (r >> 7) & 1, i = r & 127; return 1536 + 512 * half + 128 * j + i; }

__device__ __forceinline__ void rms_row_to_bf16(const float* xrow, const float* g, bf16* orow, int lane) {
    const f32x4* xr = (const f32x4*)xrow + lane; const f32x4* gr = (const f32x4*)g + lane;
    f32x4 v[4]; float s = 0.f;
#pragma unroll
    for (int j = 0; j < 4; ++j) { v[j] = xr[64 * j]; s += (v[j].x * v[j].x + v[j].y * v[j].y) + (v[j].z * v[j].z + v[j].w * v[j].w); }
    const float r = 1.f / sqrtf(wave_sum(s) * (1.f / DM) + EPS);
    v2u* o8 = (v2u*)orow + lane;
#pragma unroll
    for (int j = 0; j < 4; ++j) { const f32x4 gg = gr[64 * j]; v2u w; w.x = pk2(v[j].x * r * gg.x, v[j].y * r * gg.y); w.y = pk2(v[j].z * r * gg.z, v[j].w * r * gg.w); o8[64 * j] = w; }
}
__device__ __forceinline__ void cvt_stream_bf16(const float* src, bf16* dst, size_t n, int gtid, int gthreads) {
    const size_t n8 = n >> 3;
    for (size_t i = gtid; i < n8; i += gthreads) { const f32x4 a = ((const f32x4*)src)[2 * i], b = ((const f32x4*)src)[2 * i + 1];
        v4u o; o.x = pk2(a.x, a.y); o.y = pk2(a.z, a.w); o.z = pk2(b.x, b.y); o.w = pk2(b.z, b.w); ((v4u*)dst)[i] = o; }
}
__device__ __forceinline__ unsigned pk_fp8x4(float a, float b, float c, float d) { int w = __builtin_amdgcn_cvt_pk_fp8_f32(a, b, 0, false); w = __builtin_amdgcn_cvt_pk_fp8_f32(c, d, w, true); return (unsigned)w; }
template <bool GAIN>
__device__ __forceinline__ void cvt_table_item(const float* src, unsigned char* dst, float sc, const float* gain, size_t i, const f32x4 (&in)[4]) {
    f32x4 a = in[0] * sc, b = in[1] * sc, c = in[2] * sc, d = in[3] * sc;
    if (GAIN) { const float* gp = gain + ((i >> 6) >> 14) * DM + (i & 63) * 16; a = a * *(const f32x4*)gp; b = b * *(const f32x4*)(gp + 4); c = c * *(const f32x4*)(gp + 8); d = d * *(const f32x4*)(gp + 12); }
    v4u o; o.x = pk_fp8x4(a.x, a.y, a.z, a.w); o.y = pk_fp8x4(b.x, b.y, b.z, b.w); o.z = pk_fp8x4(c.x, c.y, c.z, c.w); o.w = pk_fp8x4(d.x, d.y, d.z, d.w);
    const size_t row = i >> 6, col16 = i & 63, layer = row >> 14, e = row & (NEXP - 1), sl = col16 >> 3, pc = col16 & 7;
    *(v4u*)(dst + (((layer * 8 + sl) * NEXP + e) * 128 + pc * 16)) = o;
}
template <bool GAIN>
__device__ __forceinline__ void cvt_table_fp8(const float* src, unsigned char* dst, float sc, const float* gain  , int gtid, int gthreads) {
    const size_t n16 = ((size_t)2 * NEXP * DM) >> 4;
    size_t i = gtid;
#pragma unroll 1
    for (; i + 3 * (size_t)gthreads < n16; i += 4 * (size_t)gthreads) {
        f32x4 in[4][4];
#pragma unroll
        for (int u = 0; u < 4; ++u)
#pragma unroll
            for (int q = 0; q < 4; ++q) in[u][q] = ((const f32x4*)src)[4 * (i + (size_t)u * gthreads) + q];
#pragma unroll
        for (int u = 0; u < 4; ++u) cvt_table_item<GAIN>(src, dst, sc, gain, i + (size_t)u * gthreads, in[u]);
    }
#pragma unroll 1
    for (; i < n16; i += gthreads) { f32x4 in[4];
#pragma unroll
        for (int q = 0; q < 4; ++q) in[q] = ((const f32x4*)src)[4 * i + q];
        cvt_table_item<GAIN>(src, dst, sc, gain, i, in); }
}
__device__ __forceinline__ bf16x8 ld8_f32_bf16(const float* p) { const f32x4 a = *(const f32x4*)p, b = *(const f32x4*)(p + 4); v4u o; o.x = pk2(a.x, a.y); o.y = pk2(a.z, a.w); o.z = pk2(b.x, b.y); o.w = pk2(b.z, b.w); return __builtin_bit_cast(bf16x8, o); }
__device__ __forceinline__ void p0_fold_item(Frame& F, int task) {
    const int layer = task >> 10, hp = (task >> 6) & 15, cb = task & 63, fr = F.lane & 15, fq = F.lane >> 4;
    const float* Wq = F.in[I_PWQ] + (size_t)layer * DM * PQ_N + (size_t)(16 * cb + fr) * PQ_N + hp * 128 + 8 * fq;
    const float* sk = F.in[I_PSK] + (size_t)(layer * 16 + hp) * 128 * 128 + (size_t)fr * 128 + 8 * fq;
    bf16* WT = (bf16*)(F.ws + (layer ? WS_WQ1 : WS_WQ0)) + (size_t)(hp * 128 + fr) * DM + 16 * cb + 4 * fq;
    const f32x4 g = *(const f32x4*)(F.in[I_LNFFN] + layer * DM + 16 * cb + 4 * fq);
    bf16x8 af[4];
#pragma unroll
    for (int ks = 0; ks < 4; ++ks) af[ks] = ld8_f32_bf16(Wq + 32 * ks);
#pragma unroll 2
    for (int kt = 0; kt < 8; ++kt) { f32x4 acc = {0.f, 0.f, 0.f, 0.f};
#pragma unroll
        for (int ks = 0; ks < 4; ++ks) acc = __builtin_amdgcn_mfma_f32_16x16x32_bf16(af[ks], ld8_f32_bf16(sk + (size_t)kt * 16 * 128 + 32 * ks), acc, 0, 0, 0);
        v2u o; o.x = pk2(acc[0] * g.x, acc[1] * g.y); o.y = pk2(acc[2] * g.z, acc[3] * g.w);
        *(v2u*)(WT + (size_t)kt * 16 * DM) = o; }
}
__device__ __forceinline__ void p0_prologue(Frame& F) {
    LAS float* scr = (LAS float*)(F.lds + F.wave * 8704);
    const int gw = F.vcu * NWAVES + F.wave, NGW = F.G * NWAVES;
    bf16* WIN0 = (bf16*)(F.ws + WS_WIN0); bf16* WOUT0 = (bf16*)(F.ws + WS_WOUT0); bf16* WIN1 = (bf16*)(F.ws + WS_WIN1); bf16* WOUT1 = (bf16*)(F.ws + WS_WOUT1);
    constexpr int I0 = 16 * (EVEN_IN / 32), I1 = 16 * (DM / 32), I2 = 16 * (ODD_IN_PAD / 32), I3 = I1;
    constexpr int NITEMS = I0 + I1 + I2 + I3;
    for (int it = gw; it < NITEMS; it += NGW) {
        int r = it;
        if (r < I0) { const int nb = r % (EVEN_IN / 32), kb = r / (EVEN_IN / 32); p0_transpose_item(F.in[I_EWIN], EVEN_IN, WIN0, kb, 32 * nb, win0_src(32 * nb), nullptr, scr, F.lane); continue; } r -= I0;
        if (r < I1) { const int nb = r % (DM / 32), kb = r / (DM / 32); p0_transpose_item(F.in[I_EWOUT], DM, WOUT0, kb, 32 * nb, 32 * nb, nullptr, scr, F.lane); continue; } r -= I1;
        if (r < I2) { const int nb = r % (ODD_IN_PAD / 32), kb = r / (ODD_IN_PAD / 32); p0_transpose_item(F.in[I_OWIN], ODD_IN, WIN1, kb, 32 * nb, 32 * nb, F.in[I_LNMIX] + DM, scr, F.lane); continue; } r -= I2;
        { const int nb = r % (DM / 32), kb = r / (DM / 32); p0_transpose_item(F.in[I_OWOUT], DM, WOUT1, kb, 32 * nb, 32 * nb, nullptr, scr, F.lane); }
    }
    for (int it = gw; it < 2 * 16 * 64; it += NGW) p0_fold_item(F, it);
    const int gtid = F.vcu * NTHREADS + F.tid, gthreads = F.G * NTHREADS;
    bf16* HN = (bf16*)(F.ws + WS_HN);
    int m = gw;
    f32x4 g4[4];
#pragma unroll
    for (int j = 0; j < 4; ++j) g4[j] = ((const f32x4*)F.in[I_LNMIX])[F.lane + 64 * j];
#pragma unroll 1
    for (; m + 3 * NGW < NT; m += 4 * NGW) {
        f32x4 v[4][4];
#pragma unroll
        for (int u = 0; u < 4; ++u)
#pragma unroll
            for (int j = 0; j < 4; ++j) v[u][j] = ((const f32x4*)(F.in[I_X] + (size_t)(m + u * NGW) * DM))[F.lane + 64 * j];
#pragma unroll
        for (int u = 0; u < 4; ++u) { float s2 = 0.f;
#pragma unroll
            for (int j = 0; j < 4; ++j) s2 += (v[u][j].x * v[u][j].x + v[u][j].y * v[u][j].y) + (v[u][j].z * v[u][j].z + v[u][j].w * v[u][j].w);
            const float r = 1.f / sqrtf(wave_sum(s2) * (1.f / DM) + EPS);
            v2u* o8 = (v2u*)(HN + (size_t)(m + u * NGW) * DM) + F.lane;
#pragma unroll
            for (int j = 0; j < 4; ++j) { const f32x4 gg = g4[j]; v2u w; w.x = pk2(v[u][j].x * r * gg.x, v[u][j].y * r * gg.y); w.y = pk2(v[u][j].z * r * gg.z, v[u][j].w * r * gg.w); o8[64 * j] = w; } }
    }
    for (; m < NT; m += NGW) rms_row_to_bf16(F.in[I_X] + (size_t)m * DM, F.in[I_LNMIX], HN + (size_t)m * DM, F.lane);
}

__device__ __forceinline__ v4u pack8(const pg8::f32x4 a, const pg8::f32x4 b) { return (v4u){pk2(a[0], a[1]), pk2(a[2], a[3]), pk2(b[0], b[1]), pk2(b[2], b[3])}; }
struct EpiIn0 {
    static constexpr bool PERM = true, AFTER_DRAIN = false;
    bf16* Q; bf16* K; bf16* Vt; bf16* GLU;
    __device__ __forceinline__ void operator()(const pg8::f32x4 (&acc)[2][2][4][2], const pg8::Unit& u, int wr, int wc, int fr, int fq) const {
        const int pn = u.pn;
#pragma unroll
        for (int ai = 0; ai < 2; ++ai)
#pragma unroll
            for (int m = 0; m < 4; ++m) {
                const int row = u.pm * 256 + ai * 128 + wr * 64 + m * 16 + fr; const int b = row >> 13, s = row & 8191;
                if (pn < 4) {
                    bf16* base = (pn < 2) ? Q : K; const float sc = (pn < 2) ? QSCALE_ATT : 1.f;
#pragma unroll
                    for (int bj = 0; bj < 2; ++bj) { const int c = (pn & 1) * 256 + bj * 128 + wc * 32 + 8 * fq; const int h = c >> 7, mp = (c >> 6) & 1, d = c & 63;
                        *(v4u*)(base + ((((size_t)(b * 4 + h) * 2 + mp) * SEQ + s) * 64 + d)) = pack8(acc[ai][bj][m][0] * sc, acc[ai][bj][m][1] * sc); }
                } else if (pn < 6) {
#pragma unroll
                    for (int bj = 0; bj < 2; ++bj) { const int c = (pn - 4) * 256 + bj * 128 + wc * 32 + 8 * fq;
                        *(v4u*)(Vt + (size_t)row * 512 + c) = pack8(acc[ai][bj][m][0], acc[ai][bj][m][1]); }
                } else {
                    const int ch = (pn - 6) * 128 + wc * 32 + 8 * fq; pg8::f32x4 y[2];
#pragma unroll
                    for (int n = 0; n < 2; ++n) { const pg8::f32x4 a = acc[ai][0][m][n], g = acc[ai][1][m][n]; y[n] = (pg8::f32x4){a[0] * sigmoidf_(g[0]), a[1] * sigmoidf_(g[1]), a[2] * sigmoidf_(g[2]), a[3] * sigmoidf_(g[3])}; }
                    *(v4u*)(GLU + (size_t)row * 512 + ch) = pack8(y[0], y[1]);
                }
            }
    }
};
template <bool BASE_F32>
struct EpiRes {
    static constexpr bool PERM = true, AFTER_DRAIN = false;
    const float* basef; const bf16* baseh; bf16* xb; float* rowsq; unsigned char* xh8; unsigned char* xl8;
    __device__ __forceinline__ void ldbase(int q, const pg8::Unit& u, int wr, int wc, int fr, int fq, pg8::f32x4& b0, pg8::f32x4& b1, v4u& bw) const {
        const int ai = q >> 3, m = (q >> 1) & 3, bj = q & 1; const int row = u.pm * 256 + ai * 128 + wr * 64 + m * 16 + fr;
        const size_t off = (size_t)row * DM + u.pn * 256 + bj * 128 + wc * 32 + 8 * fq;
        if (BASE_F32) { b0 = *(const pg8::f32x4*)(basef + off); b1 = *(const pg8::f32x4*)(basef + off + 4); } else bw = *(const v4u*)(baseh + off);
    }
    __device__ __forceinline__ void operator()(const pg8::f32x4 (&acc)[2][2][4][2], const pg8::Unit& u, int wr, int wc, int fr, int fq) const {
        pg8::f32x4 nb0, nb1; v4u nbw; ldbase(0, u, wr, wc, fr, fq, nb0, nb1, nbw);
        float ss = 0.f;
#pragma unroll
        for (int q = 0; q < 16; ++q) {
            const int ai = q >> 3, m = (q >> 1) & 3, bj = q & 1; const int row = u.pm * 256 + ai * 128 + wr * 64 + m * 16 + fr;
            const size_t off = (size_t)row * DM + u.pn * 256 + bj * 128 + wc * 32 + 8 * fq;
            pg8::f32x4 b0, b1;
            if (BASE_F32) { b0 = nb0; b1 = nb1; } else { b0 = (pg8::f32x4){bf_lo(nbw.x), bf_hi(nbw.x), bf_lo(nbw.y), bf_hi(nbw.y)}; b1 = (pg8::f32x4){bf_lo(nbw.z), bf_hi(nbw.z), bf_lo(nbw.w), bf_hi(nbw.w)}; }
            if (q + 1 < 16) ldbase(q + 1, u, wr, wc, fr, fq, nb0, nb1, nbw);
            const pg8::f32x4 o0 = b0 + acc[ai][bj][m][0], o1 = b1 + acc[ai][bj][m][1];
            *(v4u*)(xb + off) = pack8(o0, o1);
            { const pg8::f32x4 p0 = o0 * 16.f, p1 = o1 * 16.f; const unsigned h0 = pk_fp8x4(p0[0], p0[1], p0[2], p0[3]), h1 = pk_fp8x4(p1[0], p1[1], p1[2], p1[3]);
              const f32x2_t a0 = __builtin_amdgcn_cvt_pk_f32_fp8((int)h0, false), a1 = __builtin_amdgcn_cvt_pk_f32_fp8((int)h0, true), a2 = __builtin_amdgcn_cvt_pk_f32_fp8((int)h1, false), a3 = __builtin_amdgcn_cvt_pk_f32_fp8((int)h1, true);
              *(v2u*)(xh8 + off) = (v2u){h0, h1};
              *(v2u*)(xl8 + off) = (v2u){pk_fp8x4(p0[0] - a0.x, p0[1] - a0.y, p0[2] - a1.x, p0[3] - a1.y), pk_fp8x4(p1[0] - a2.x, p1[1] - a2.y, p1[2] - a3.x, p1[3] - a3.y)}; }
            ss += ((o0[0] * o0[0] + o0[1] * o0[1]) + (o0[2] * o0[2] + o0[3] * o0[3])) + ((o1[0] * o1[0] + o1[1] * o1[1]) + (o1[2] * o1[2] + o1[3] * o1[3]));
            if (bj == 1) {
                { const unsigned x = __builtin_bit_cast(unsigned, ss); const auto pr = __builtin_amdgcn_permlane16_swap(x, x, false, false); ss = __builtin_bit_cast(float, pr[0]) + __builtin_bit_cast(float, pr[1]); }
                { const unsigned x = __builtin_bit_cast(unsigned, ss); const auto pr = __builtin_amdgcn_permlane32_swap(x, x, false, false); ss = __builtin_bit_cast(float, pr[0]) + __builtin_bit_cast(float, pr[1]); }
                if (fq == 0) rowsq[(size_t)row * 16 + u.pn * 4 + wc] = ss;
                ss = 0.f; }
        }
    }
};
__device__ __forceinline__ unsigned mono16x2(unsigned w) { return w ^ ((((w >> 15) & 0x00010001u) * 0x7fffu) | 0x80008000u); }
__device__ __forceinline__ v4u mono16x8(v4u w) { return (v4u){mono16x2(w.x), mono16x2(w.y), mono16x2(w.z), mono16x2(w.w)}; }
constexpr int EPI_LRS = pg8::STAGE_BYTES;
struct EpiPq {
    static constexpr bool PERM = true, AFTER_DRAIN = false;
    bf16* PQ; const float* rowsq; float* rsv; LAS float* lrs;
    __device__ __forceinline__ void operator()(const pg8::f32x4 (&acc)[2][2][4][2], const pg8::Unit& u, int wr, int wc, int fr, int fq) const {
        { const int tid = (wr * 4 + wc) * 64 + fq * 16 + fr;
          if (tid < 256) { const int row = u.pm * 256 + tid;
              const f32x4 q0 = *(const f32x4*)(rowsq + (size_t)row * 16), q1 = *(const f32x4*)(rowsq + (size_t)row * 16 + 4), q2 = *(const f32x4*)(rowsq + (size_t)row * 16 + 8), q3 = *(const f32x4*)(rowsq + (size_t)row * 16 + 12);
              const float rs = 1.f / sqrtf(((((q0.x + q0.y) + (q0.z + q0.w)) + ((q1.x + q1.y) + (q1.z + q1.w))) + (((q2.x + q2.y) + (q2.z + q2.w)) + ((q3.x + q3.y) + (q3.z + q3.w)))) * (1.f / DM) + EPS);
              lrs[tid] = rs; if (u.pn == 0) rsv[row] = rs; }
          asm volatile("s_waitcnt lgkmcnt(0)" ::: "memory"); __builtin_amdgcn_s_barrier(); }
#pragma unroll
        for (int ai = 0; ai < 2; ++ai)
#pragma unroll
            for (int m = 0; m < 4; ++m) {
                const int rl = ai * 128 + wr * 64 + m * 16 + fr, row = u.pm * 256 + rl;
                const float rs = lrs[rl];
#pragma unroll
                for (int bj = 0; bj < 2; ++bj) { const size_t off = (size_t)row * PQ_N + u.pn * 256 + bj * 128 + wc * 32 + 8 * fq;
                    *(v4u*)(PQ + off) = mono16x8(pack8(acc[ai][bj][m][0] * rs, acc[ai][bj][m][1] * rs)); }
            }
    }
};
struct EpiIn1 {
    static constexpr bool PERM = true, AFTER_DRAIN = false;
    bf16* Q; bf16* K; bf16* V; bf16* G; const float* rs8; LAS float* lrs;
    __device__ __forceinline__ void operator()(const pg8::f32x4 (&acc)[2][2][4][2], const pg8::Unit& u, int wr, int wc, int fr, int fq) const {
        const int pn = u.pn;
        { const int tid = (wr * 4 + wc) * 64 + fq * 16 + fr;
          if (tid < 256) { const int row = u.pm * 256 + tid;
              const f32x4 q0 = *(const f32x4*)(rs8 + (size_t)row * 8), q1 = *(const f32x4*)(rs8 + (size_t)row * 8 + 4);
              lrs[tid] = 1.f / sqrtf((((q0.x + q0.y) + (q0.z + q0.w)) + ((q1.x + q1.y) + (q1.z + q1.w))) * (1.f / DM) + EPS); }
          asm volatile("s_waitcnt lgkmcnt(0)" ::: "memory"); __builtin_amdgcn_s_barrier(); }
#pragma unroll
        for (int ai = 0; ai < 2; ++ai)
#pragma unroll
            for (int m = 0; m < 4; ++m) {
                const int rl = ai * 128 + wr * 64 + m * 16 + fr, row = u.pm * 256 + rl;
                const float rs = lrs[rl];
#pragma unroll
                for (int bj = 0; bj < 2; ++bj) { const int c = pn * 256 + bj * 128 + wc * 32 + 8 * fq; pg8::f32x4 v0 = acc[ai][bj][m][0] * rs, v1 = acc[ai][bj][m][1] * rs;
                    if (pn < 2) *(v4u*)(Q + (size_t)row * 512 + c) = pack8(v0 * QSCALE_GLA, v1 * QSCALE_GLA);
                    else if (pn < 4) *(v4u*)(K + (size_t)row * 512 + (c - 512)) = pack8(v0, v1);
                    else if (pn < 8) *(v4u*)(V + (size_t)row * 1024 + (c - 1024)) = pack8(v0, v1);
                    else { v0 = (pg8::f32x4){siluf_(v0[0]), siluf_(v0[1]), siluf_(v0[2]), siluf_(v0[3])}; v1 = (pg8::f32x4){siluf_(v1[0]), siluf_(v1[1]), siluf_(v1[2]), siluf_(v1[3])};
                        *(v4u*)(G + (size_t)row * 1024 + (c - 2048)) = pack8(v0, v1); } }
            }
    }
};
__device__ __forceinline__ void z_tail(Frame& F) {
    const int lane = F.lane, fr = lane & 15, fq = lane >> 4;
    const bf16* HN = (const bf16*)(F.ws + WS_HN); const bf16* WZ = (const bf16*)(F.ws + WS_WIN1) + (size_t)3072 * DM; const float* RS8 = (const float*)(F.ws + WS_RS8); float* Z = (float*)(F.ws + S1_Z);
    const int gw = F.vcu * NWAVES + F.wave, NGW = F.G * NWAVES;
    for (int tb = gw; tb < NT / 16; tb += NGW) {
        const int t0 = tb * 16; f32x4 acc = {0.f, 0.f, 0.f, 0.f};
        const bf16* ap = HN + (size_t)(t0 + fr) * DM + 8 * fq; const bf16* bp = WZ + (size_t)fr * DM + 8 * fq;
        f32x4 q0[4], q1[4];
#pragma unroll
        for (int r = 0; r < 4; ++r) { const int t = t0 + 4 * fq + r; q0[r] = *(const f32x4*)(RS8 + (size_t)t * 8); q1[r] = *(const f32x4*)(RS8 + (size_t)t * 8 + 4); }
#pragma unroll 16
        for (int ks = 0; ks < 32; ++ks) acc = __builtin_amdgcn_mfma_f32_16x16x32_bf16(*(const bf16x8*)(ap + 32 * ks), *(const bf16x8*)(bp + 32 * ks), acc, 0, 0, 0);
#pragma unroll
        for (int r = 0; r < 4; ++r) { const int t = t0 + 4 * fq + r;
            const float rs = 1.f / sqrtf((((q0[r].x + q0[r].y) + (q0[r].z + q0[r].w)) + ((q1[r].x + q1[r].y) + (q1[r].z + q1[r].w))) * (1.f / DM) + EPS);
            Z[(size_t)t * 16 + fr] = acc[r] * rs; }
    }
}

namespace att {
constexpr int KSTR = 144, VSTR = 136;
constexpr int OFF_K1 = 0, OFF_K2 = 64 * KSTR, OFF_V = 2 * 64 * KSTR, BUFB = OFF_V + 128 * VSTR;
constexpr int OFF_TB = 2 * BUFB;
constexpr float THR = 8.f;
__device__ __forceinline__ int t5_bucket(int rel) {
    const int n = rel < 0 ? -rel : rel; int v;
    if (n < 8) v = n; else { v = 8 + (31 - __clz(n * n)) - 6; if (v > 15) v = 15; }
    return (rel > 0 ? 16 : 0) + v;
}
constexpr int A2_KBUF = 2 * 64 * 128, A2_VBUF = 64 * 256, A2_OFF_V = 2 * A2_KBUF, A2_OFF_Q = A2_OFF_V + 2 * A2_VBUF, A2_QSTR = 144, A2_OFF_TB = A2_OFF_Q + 2 * 256 * A2_QSTR;
__device__ __forceinline__ void attn_unit(Frame& F, int bh, int qb, float lam) {
    const int wid = F.wave, mp = wid >> 2, wq = wid & 3, h = bh & 3;
    const int q0 = qb * 256, qw = q0 + 64 * wq;
    LAS unsigned char* lds = F.lds;
    const bf16* Qg = (const bf16*)(F.ws + S0_Q); const bf16* Kg = (const bf16*)(F.ws + S0_K); const bf16* Vg = (const bf16*)(F.ws + S0_VT);
    LAS float* tb = (LAS float*)(lds + A2_OFF_TB);
    const float* relb = F.in[I_RELB];
    { int tid = F.tid; asm volatile("" : "+v"(tid));
      for (int i = tid; i < 320; i += NTHREADS) tb[i] = relb[t5_bucket(i - 255) * 4 + h] * LOG2E;
      v4u qv[8];
#pragma unroll
      for (int i = 0; i < 8; ++i) { const int c = tid + 512 * i, m = c >> 11, row = (c >> 3) & 255, ch = c & 7; qv[i] = *(const v4u*)(Qg + (((size_t)(bh * 2 + m) * SEQ) + q0 + row) * 64 + ch * 8); }
#pragma unroll
      for (int i = 0; i < 8; ++i) { const int c = tid + 512 * i, m = c >> 11, row = (c >> 3) & 255, ch = c & 7; *(LAS v4u*)(lds + A2_OFF_Q + (m * 256 + row) * A2_QSTR + ch * 16) = qv[i]; } }
    __builtin_amdgcn_sched_barrier(0);
    int lane = F.lane; asm volatile("" : "+v"(lane));
    const int r32 = lane & 31, hi = lane >> 5;
    const float c15 = relb[15 * 4 + h] * LOG2E;
    const int nt_unit = 4 * qb + 4, nt_wave = 4 * qb + wq + 1;
    const int krow = 8 * wid + (lane >> 3), kc = (lane & 7) ^ ((krow >> 1) & 7);
    const bf16* k1src = Kg + (((size_t)(bh * 2 + 0) * SEQ) + krow) * 64 + kc * 8;
    const bf16* k2src = Kg + (((size_t)(bh * 2 + 1) * SEQ) + krow) * 64 + kc * 8;
    const int vrow = 4 * wid + (lane >> 4), vc = (lane & 15) ^ (4 * (vrow & 3));
    const bf16* vsrc = Vg + ((size_t)(bh >> 2) * SEQ + vrow) * 512 + h * 128 + vc * 8;
#define A2_DMA(t, bf) do { \
        __builtin_amdgcn_global_load_lds((const unsigned*)(k1src + (size_t)(t) * 4096), (LAS unsigned*)(lds + (bf) * A2_KBUF + wid * 1024), 16, 0, 0); \
        __builtin_amdgcn_global_load_lds((const unsigned*)(k2src + (size_t)(t) * 4096), (LAS unsigned*)(lds + (bf) * A2_KBUF + 64 * 128 + wid * 1024), 16, 0, 0); \
        __builtin_amdgcn_global_load_lds((const unsigned*)(vsrc + (size_t)(t) * 64 * 512), (LAS unsigned*)(lds + A2_OFF_V + (bf) * A2_VBUF + wid * 1024), 16, 0, 0); \
        __builtin_amdgcn_global_load_lds((const unsigned*)(vsrc + (size_t)(t) * 64 * 512 + (size_t)32 * 512), (LAS unsigned*)(lds + A2_OFF_V + (bf) * A2_VBUF + 32 * 256 + wid * 1024), 16, 0, 0); } while (0)
    A2_DMA(0, 0);
    asm volatile("s_waitcnt vmcnt(0)" ::: "memory");
    __syncthreads();
    f32x16 o[2][4];
#pragma unroll
    for (int j = 0; j < 2; ++j)
#pragma unroll
        for (int d = 0; d < 4; ++d)
#pragma unroll
            for (int r = 0; r < 16; ++r) o[j][d][r] = 0.f;
    float m_run[2] = {0.f, 0.f}, l_run[2] = {0.f, 0.f};
    const int kf_off = (mp * 64 + r32) * 128, kf_swz = (((r32 >> 1) & 7) * 16) ^ (hi * 16);
    const int qf_off = A2_OFF_Q + (mp * 256 + 64 * wq + r32) * A2_QSTR + hi * 16;
    const int vq = (lane & 15) >> 2, vf_off = (4 * hi + vq) * 256 + (lane & 3) * 8, vf_dh = (lane >> 4) & 1;
#pragma unroll 1
    for (int t = 0; t < nt_unit; ++t) {
        const int buf = t & 1;
        if (t + 1 < nt_unit) A2_DMA(t + 1, buf ^ 1);
        if (t < nt_wave) {
            const LAS unsigned char* kb = lds + buf * A2_KBUF + kf_off;
            const LAS unsigned char* vb = lds + A2_OFF_V + buf * A2_VBUF + vf_off;
#pragma unroll
            for (int hf = 0; hf < 2; ++hf) {
                __builtin_amdgcn_sched_barrier(0);
                bf16x8 ka[4];
#pragma unroll
                for (int s = 0; s < 4; ++s) ka[s] = *(const LAS bf16x8*)(kb + hf * 32 * 128 + (((2 * s) * 16) ^ kf_swz));
                bf16x8 pb[2][2];
#pragma unroll
                for (int j = 0; j < 2; ++j) {
                    __builtin_amdgcn_sched_barrier(0);
                    const int qrow0 = qw + 32 * j;
                    const bool far = (64 * t + 154 <= qrow0);
                    const float init = (far ? c15 : 0.f) - m_run[j];
                    f32x16 p0;
#pragma unroll
                    for (int r = 0; r < 16; ++r) p0[r] = init;
#pragma unroll
                    for (int s = 0; s < 4; ++s) { const bf16x8 qf = *(const LAS bf16x8*)(lds + qf_off + 32 * j * A2_QSTR + s * 32);
                        p0 = __builtin_amdgcn_mfma_f32_32x32x16_bf16(ka[s], qf, p0, 0, 0, 0); }
                    if (!far) {
                        const int base = 64 * t + 32 * hf - (qrow0 + r32) + 255 + 4 * hi;
#pragma unroll
                        for (int r = 0; r < 16; ++r) p0[r] += tb[base + (r & 3) + 8 * (r >> 2)];
                    }
                    float rm;
                    { const float m1 = vmax3(p0[0], p0[1], p0[2]), m2 = vmax3(p0[3], p0[4], p0[5]), m3 = vmax3(p0[6], p0[7], p0[8]), m4 = vmax3(p0[9], p0[10], p0[11]), m5 = vmax3(p0[12], p0[13], p0[14]);
                      rm = vmax3(vmax3(m1, m2, m3), vmax3(m4, m5, p0[15]), m1); }
                    const bool first = (t == 0) && (hf == 0);
                    if (first || __any(rm > THR)) {
                        rm = fmaxf(rm, __shfl_xor(rm, 32));
                        const float dl = first ? rm : fmaxf(rm, 0.f), al = first ? 0.f : fast_exp2(-dl);
#pragma unroll
                        for (int d = 0; d < 4; ++d)
#pragma unroll
                            for (int r = 0; r < 16; ++r) o[j][d][r] *= al;
                        l_run[j] *= al; m_run[j] += dl;
#pragma unroll
                        for (int r = 0; r < 16; ++r) p0[r] -= dl;
                    }
                    float ls = 0.f;
#pragma unroll
                    for (int r = 0; r < 16; ++r) { p0[r] = fast_exp2(p0[r]); ls += p0[r]; }
                    l_run[j] += ls;
                    { v4u w;
                      w.x = pk2(p0[0], p0[1]); w.y = pk2(p0[2], p0[3]); w.z = pk2(p0[4], p0[5]); w.w = pk2(p0[6], p0[7]); pb[j][0] = __builtin_bit_cast(bf16x8, w);
                      w.x = pk2(p0[8], p0[9]); w.y = pk2(p0[10], p0[11]); w.z = pk2(p0[12], p0[13]); w.w = pk2(p0[14], p0[15]); pb[j][1] = __builtin_bit_cast(bf16x8, w); }
                }
                __builtin_amdgcn_sched_barrier(0);
#pragma unroll
                for (int d = 0; d < 4; ++d)
#pragma unroll
                    for (int s = 0; s < 2; ++s) { const int chk = ((4 * d + 2 * vf_dh) ^ (4 * vq)) * 16, ro = (hf * 32 + s * 16) * 256;
                        const v4s16 lo = __builtin_amdgcn_ds_read_tr16_b64_v4i16((LAS v4s16*)(vb + ro + chk)), h8 = __builtin_amdgcn_ds_read_tr16_b64_v4i16((LAS v4s16*)(vb + ro + 8 * 256 + chk));
                        const bf16x8 aw = {lo[0], lo[1], lo[2], lo[3], h8[0], h8[1], h8[2], h8[3]};
                        o[0][d] = __builtin_amdgcn_mfma_f32_32x32x16_bf16(aw, pb[0][s], o[0][d], 0, 0, 0); o[1][d] = __builtin_amdgcn_mfma_f32_32x32x16_bf16(aw, pb[1][s], o[1][d], 0, 0, 0); }
            }
        }
        asm volatile("s_waitcnt vmcnt(0)" ::: "memory");
        __syncthreads();
    }
#undef A2_DMA
    __builtin_amdgcn_sched_barrier(0);
    int lane_e = F.lane; asm volatile("" : "+v"(lane_e));
    const int r32e = lane_e & 31, hie = lane_e >> 5;
    LAS float* X = (LAS float*)lds + (size_t)(wq * 128) * 64 + lane_e;
    float inv[2];
#pragma unroll
    for (int j = 0; j < 2; ++j) { l_run[j] += __shfl_xor(l_run[j], 32); inv[j] = 1.f / l_run[j]; }
    if (mp == 1) {
#pragma unroll
        for (int j = 0; j < 2; ++j)
#pragma unroll
            for (int d = 0; d < 4; ++d)
#pragma unroll
                for (int r = 0; r < 16; ++r) X[(j * 64 + d * 16 + r) * 64] = o[j][d][r] * inv[j];
    }
    __syncthreads();
    if (mp == 0) {
        const float* sg = F.in[I_SUBLN];
#pragma unroll
        for (int j = 0; j < 2; ++j) {
            float ss = 0.f;
#pragma unroll
            for (int d = 0; d < 4; ++d)
#pragma unroll
                for (int r = 0; r < 16; ++r) { const float v = o[j][d][r] * inv[j] - lam * X[(j * 64 + d * 16 + r) * 64]; o[j][d][r] = v; ss += v * v; }
            ss += __shfl_xor(ss, 32);
            const float rn = (1.f - LAM_INIT0) / sqrtf(ss * (1.f / 128.f) + EPS);
            bf16* CAT = (bf16*)(F.ws + S0_CAT) + ((size_t)(bh >> 2) * SEQ + qw + 32 * j + r32e) * DM + h * 128;
#pragma unroll
            for (int d = 0; d < 4; ++d)
#pragma unroll
                for (int rg = 0; rg < 4; ++rg) { const int dd = 32 * d + 8 * rg + 4 * hie; const f32x4 g4 = *(const f32x4*)(sg + dd);
                    v2u w; w.x = pk2(o[j][d][4 * rg] * rn * g4.x, o[j][d][4 * rg + 1] * rn * g4.y); w.y = pk2(o[j][d][4 * rg + 2] * rn * g4.z, o[j][d][4 * rg + 3] * rn * g4.w);
                    *(v2u*)(CAT + dd) = w; }
        }
    }
    __syncthreads();
}
constexpr int CV_OFF_Y = 65536;
__device__ __forceinline__ void conv_fetch(const bf16* GLU, int a, int tid, v4u (&pre)[8]) {
    const int t0 = a * 32, s0 = t0 & (SEQ - 1);
#pragma unroll
    for (int k = 0; k < 8; ++k) { const int ch = tid + 512 * k, row = ch >> 6;
        pre[k] = (v4u){0u, 0u, 0u, 0u};
        if (ch < 62 * 64 && s0 - 30 + row >= 0) pre[k] = *(const v4u*)(GLU + (size_t)(t0 - 30) * 512 + (size_t)ch * 8); }
}
__device__ __forceinline__ void conv_phase(Frame& F) {
    const int c = F.tid;
    const bf16* GLU = (const bf16*)(F.ws + S0_GLU);
    int a = F.vcu;
    if (a >= NT / 32) return;
    v4u pre[8];
    conv_fetch(GLU, a, c, pre);
    const float* cw = F.in[I_CONVW];
    float w[31];
#pragma unroll
    for (int j = 0; j < 31; ++j) w[j] = cw[j * 512 + c];
    const float bias = F.in[I_CONVB][c];
    const float* lg = F.in[I_CLNG]; const float* lb = F.in[I_CLNB];
    const f32x4 g0 = *(const f32x4*)(lg + F.lane * 8), g1 = *(const f32x4*)(lg + F.lane * 8 + 4), b0 = *(const f32x4*)(lb + F.lane * 8), b1 = *(const f32x4*)(lb + F.lane * 8 + 4);
    LAS unsigned char* U = F.lds; LAS float* Y = (LAS float*)(F.lds + CV_OFF_Y);
    bf16* CAT = (bf16*)(F.ws + S0_CAT);
#pragma unroll 1
    for (; a < NT / 32; a += F.G) {
        const int t0 = a * 32;
#pragma unroll
        for (int k = 0; k < 8; ++k) { const int ch = c + 512 * k; if (ch < 62 * 64) *(LAS v4u*)(U + ch * 16) = pre[k]; }
        __syncthreads();
        if (a + F.G < NT / 32) conv_fetch(GLU, a + F.G, c, pre);
        {   float u[62];
#pragma unroll
            for (int i = 0; i < 62; ++i) u[i] = bf2f(*(const LAS unsigned short*)(U + i * 1024 + 2 * c));
#pragma unroll
            for (int tt = 0; tt < 32; ++tt) { float y = bias;
#pragma unroll
                for (int j = 0; j < 31; ++j) y += w[j] * u[tt + j];
                Y[tt * 516 + c] = y; } }
        __syncthreads();
#pragma unroll
        for (int k = 0; k < 4; ++k) { const int tt = 4 * F.wave + k;
            const f32x4 ya = *(const LAS f32x4*)(Y + tt * 516 + F.lane * 8), yb = *(const LAS f32x4*)(Y + tt * 516 + F.lane * 8 + 4);
            const float mean = wave_sum((ya.x + ya.y) + (ya.z + ya.w) + (yb.x + yb.y) + (yb.z + yb.w)) * (1.f / 512.f);
            const f32x4 da = ya - mean, db = yb - mean;
            const float var = wave_sum((da.x * da.x + da.y * da.y) + (da.z * da.z + da.w * da.w) + (db.x * db.x + db.y * db.y) + (db.z * db.z + db.w * db.w)) * (1.f / 512.f);
            const float rs = 1.f / sqrtf(var + EPS);
            const f32x4 y0 = da * rs * g0 + b0, y1 = db * rs * g1 + b1;
            v4u o; o.x = pk2(siluf_(y0.x), siluf_(y0.y)); o.y = pk2(siluf_(y0.z), siluf_(y0.w)); o.z = pk2(siluf_(y1.x), siluf_(y1.y)); o.w = pk2(siluf_(y1.z), siluf_(y1.w));
            *(v4u*)(CAT + (size_t)(t0 + tt) * DM + 512 + F.lane * 8) = o; }
        __syncthreads();
    }
}
__device__ __forceinline__ void p2_attn_conv(Frame& F) {
    float d1 = 0.f, d2 = 0.f;
    { const float* lq1 = F.in[I_LQ1]; const float* lk1 = F.in[I_LK1]; const float* lq2 = F.in[I_LQ2]; const float* lk2 = F.in[I_LK2];
#pragma unroll 8
      for (int i = 0; i < 64; ++i) { d1 += lq1[i] * lk1[i]; d2 += lq2[i] * lk2[i]; } }
    const float lam = expf(d1) - expf(d2) + LAM_INIT0;
    for (int a = F.vcu; a < 512; a += F.G) { const int i = a >> 8, v = a & 255, x = v >> 5, j = v & 31; attn_unit(F, 2 * x + (j >> 4), i ? (31 - (j & 15)) : (j & 15), lam); }
    conv_phase(F);
}
}

namespace peer {
constexpr int SSTR = 136;
__device__ __forceinline__ unsigned mono(float f) { const unsigned u = __builtin_bit_cast(unsigned, f); return u ^ ((unsigned)((int)u >> 31) | 0x80000000u); }
__device__ __forceinline__ float unmono(unsigned m) { const unsigned u = (m & 0x80000000u) ? (m ^ 0x80000000u) : ~m; return __builtin_bit_cast(float, u); }
__device__ __forceinline__ float unmono_hi16(unsigned key) { const unsigned u = key & 0xffff0000u; return __builtin_bit_cast(float, (u & 0x80000000u) ? (u ^ 0x80000000u) : (~u & 0xffff0000u)); }
#define CE_DESC(a, b) do { const unsigned _x = (a), _y = (b); (a) = _x > _y ? _x : _y; (b) = _x > _y ? _y : _x; } while (0)
#define CE_ASC(a, b)  do { const unsigned _x = (a), _y = (b); (a) = _x > _y ? _y : _x; (b) = _x > _y ? _x : _y; } while (0)
__device__ __forceinline__ void merge16(unsigned (&k)[16], bool desc) {
#pragma unroll
    for (int stride = 8; stride > 0; stride >>= 1)
#pragma unroll
        for (int i = 0; i < 16; ++i) if ((i & stride) == 0) { if (desc) CE_DESC(k[i], k[i + stride]); else CE_ASC(k[i], k[i + stride]); }
}
__device__ __forceinline__ void sort16(unsigned (&k)[16], bool desc) {
#pragma unroll
    for (int size = 2; size <= 16; size <<= 1)
#pragma unroll
        for (int stride = size >> 1; stride > 0; stride >>= 1)
#pragma unroll
            for (int i = 0; i < 16; ++i) if ((i & stride) == 0) { const bool d = (((i & size) == 0) == desc); if (d) CE_DESC(k[i], k[i + stride]); else CE_ASC(k[i], k[i + stride]); }
}
#define OEM16_DESC(k, b) do { CE_DESC(k[(b)+0],k[(b)+1]); CE_DESC(k[(b)+2],k[(b)+3]); CE_DESC(k[(b)+0],k[(b)+2]); CE_DESC(k[(b)+1],k[(b)+3]); CE_DESC(k[(b)+1],k[(b)+2]); CE_DESC(k[(b)+4],k[(b)+5]); CE_DESC(k[(b)+6],k[(b)+7]); CE_DESC(k[(b)+4],k[(b)+6]); CE_DESC(k[(b)+5],k[(b)+7]); CE_DESC(k[(b)+5],k[(b)+6]); CE_DESC(k[(b)+0],k[(b)+4]); CE_DESC(k[(b)+2],k[(b)+6]); CE_DESC(k[(b)+2],k[(b)+4]); CE_DESC(k[(b)+1],k[(b)+5]); CE_DESC(k[(b)+3],k[(b)+7]); CE_DESC(k[(b)+3],k[(b)+5]); CE_DESC(k[(b)+1],k[(b)+2]); CE_DESC(k[(b)+3],k[(b)+4]); CE_DESC(k[(b)+5],k[(b)+6]); CE_DESC(k[(b)+8],k[(b)+9]); CE_DESC(k[(b)+10],k[(b)+11]); CE_DESC(k[(b)+8],k[(b)+10]); CE_DESC(k[(b)+9],k[(b)+11]); CE_DESC(k[(b)+9],k[(b)+10]); CE_DESC(k[(b)+12],k[(b)+13]); CE_DESC(k[(b)+14],k[(b)+15]); CE_DESC(k[(b)+12],k[(b)+14]); CE_DESC(k[(b)+13],k[(b)+15]); CE_DESC(k[(b)+13],k[(b)+14]); CE_DESC(k[(b)+8],k[(b)+12]); CE_DESC(k[(b)+10],k[(b)+14]); CE_DESC(k[(b)+10],k[(b)+12]); CE_DESC(k[(b)+9],k[(b)+13]); CE_DESC(k[(b)+11],k[(b)+15]); CE_DESC(k[(b)+11],k[(b)+13]); CE_DESC(k[(b)+9],k[(b)+10]); CE_DESC(k[(b)+11],k[(b)+12]); CE_DESC(k[(b)+13],k[(b)+14]); CE_DESC(k[(b)+0],k[(b)+8]); CE_DESC(k[(b)+4],k[(b)+12]); CE_DESC(k[(b)+4],k[(b)+8]); CE_DESC(k[(b)+2],k[(b)+10]); CE_DESC(k[(b)+6],k[(b)+14]); CE_DESC(k[(b)+6],k[(b)+10]); CE_DESC(k[(b)+2],k[(b)+4]); CE_DESC(k[(b)+6],k[(b)+8]); CE_DESC(k[(b)+10],k[(b)+12]); CE_DESC(k[(b)+1],k[(b)+9]); CE_DESC(k[(b)+5],k[(b)+13]); CE_DESC(k[(b)+5],k[(b)+9]); CE_DESC(k[(b)+3],k[(b)+11]); CE_DESC(k[(b)+7],k[(b)+15]); CE_DESC(k[(b)+7],k[(b)+11]); CE_DESC(k[(b)+3],k[(b)+5]); CE_DESC(k[(b)+7],k[(b)+9]); CE_DESC(k[(b)+11],k[(b)+13]); CE_DESC(k[(b)+1],k[(b)+2]); CE_DESC(k[(b)+3],k[(b)+4]); CE_DESC(k[(b)+5],k[(b)+6]); CE_DESC(k[(b)+7],k[(b)+8]); CE_DESC(k[(b)+9],k[(b)+10]); CE_DESC(k[(b)+11],k[(b)+12]); CE_DESC(k[(b)+13],k[(b)+14]); } while (0)
__device__ __forceinline__ void top16_of_64(unsigned (&k)[64], unsigned (&res)[16]) {
    OEM16_DESC(k, 0); OEM16_DESC(k, 16); OEM16_DESC(k, 32); OEM16_DESC(k, 48);
    unsigned t0[16], t1[16];
#pragma unroll
    for (int i = 0; i < 16; ++i) { t0[i] = k[i] > k[31 - i] ? k[i] : k[31 - i]; t1[i] = k[32 + i] > k[63 - i] ? k[32 + i] : k[63 - i]; }
    merge16(t0, true); merge16(t1, false);
#pragma unroll
    for (int i = 0; i < 16; ++i) res[i] = t0[i] > t1[i] ? t0[i] : t1[i];
    merge16(res, true);
}
constexpr size_t TBL_ITEMS = (size_t)NEXP * DM / 16;
struct TblJob { const float* pu; const float* pv; unsigned char* du; unsigned char* dv; const float* gain; int layer; };
__device__ __forceinline__ void tbl_issue(const TblJob& J, size_t k, f32x4 (&in)[4]) {
    const size_t kk = (k < 2 * TBL_ITEMS) ? k : 0;
    const size_t gi = (size_t)J.layer * TBL_ITEMS + (kk & (TBL_ITEMS - 1));
    if (kk >= TBL_ITEMS) {
#pragma unroll
        for (int q = 0; q < 4; ++q) in[q] = ((const f32x4*)J.pv)[4 * gi + q];
    } else {
#pragma unroll
        for (int q = 0; q < 4; ++q) in[q] = ((const f32x4*)J.pu)[4 * gi + q];
    }
    asm volatile("" ::: "memory");
}
__device__ __forceinline__ void tbl_finish(const TblJob& J, size_t k, const f32x4 (&in)[4]) {
    if (k < 2 * TBL_ITEMS) { const size_t gi = (size_t)J.layer * TBL_ITEMS + (k & (TBL_ITEMS - 1));
        if (k >= TBL_ITEMS) cvt_table_item<false>(J.pv, J.dv, V_SCALE, nullptr, gi, in); else cvt_table_item<true>(J.pu, J.du, U_SCALE, J.gain, gi, in); }
}
__device__ __forceinline__ void topk_unit(Frame& F, int tile, int h, int layer, const TblJob& J, size_t k0, size_t kstep) {
    const int tid = F.tid;
    f32x4 tin[4];
    tbl_issue(J, k0, tin);
    const int t0 = tile * 256, row = tid >> 1, kh = tid & 1;
    const v4u* src = (const v4u*)((const bf16*)(F.ws + SP_PQ) + (size_t)(t0 + row) * PQ_N + h * 256 + 64 * kh);
    v4u raw[2][8];
#pragma unroll
    for (int p = 0; p < 2; ++p)
#pragma unroll
        for (int i = 0; i < 8; ++i) raw[p][i] = src[16 * p + i];
    unsigned sel[2][16];
#pragma unroll
    for (int p = 0; p < 2; ++p) {
        unsigned k[64];
#pragma unroll
        for (int i = 0; i < 8; ++i)
#pragma unroll
            for (int e = 0; e < 4; ++e) { const unsigned w = raw[p][i][e];
                k[8 * i + 2 * e] = (w << 16) | (unsigned)(127 - (64 * kh + 8 * i + 2 * e));
                k[8 * i + 2 * e + 1] = (w & 0xffff0000u) | (unsigned)(127 - (64 * kh + 8 * i + 2 * e + 1)); }
        unsigned mine[16];
        top16_of_64(k, mine);
#pragma unroll
        for (int i = 0; i < 16; ++i) { const unsigned other = (unsigned)__builtin_amdgcn_update_dpp(0, (int)mine[15 - i], 0xB1, 0xf, 0xf, false); sel[p][i] = mine[i] > other ? mine[i] : other; }
        merge16(sel[p], true);
        tbl_finish(J, k0 + (size_t)p * kstep, tin); tbl_issue(J, k0 + (size_t)(p + 1) * kstep, tin);
    }
    float v1[16], v2[16]; unsigned ib1[4] = {0u, 0u, 0u, 0u}, ib2[4] = {0u, 0u, 0u, 0u};
#pragma unroll
    for (int i = 0; i < 16; ++i) { v1[i] = unmono_hi16(sel[0][i]); v2[i] = unmono_hi16(sel[1][i]);
        ib1[i >> 2] |= (127u - (sel[0][i] & 127u)) << (8 * (i & 3)); ib2[i >> 2] |= (127u - (sel[1][i] & 127u)) << (8 * (i & 3)); }
#define CKEY(i, j) ((mono(v1[i] + v2[j]) & ~255u) | (unsigned)(255 - ((i) * 16 + (j))))
    unsigned A[16], B[16], C[16], D[16];
#pragma unroll
    for (int j = 0; j < 16; ++j) A[j] = CKEY(0, j);
#pragma unroll
    for (int j = 0; j < 8; ++j) B[j] = CKEY(1, j);
    B[8] = 0u; B[9] = 0u; B[10] = 0u;
#pragma unroll
    for (int j = 0; j < 5; ++j) B[15 - j] = CKEY(2, j);
    C[0] = CKEY(3, 0); C[1] = CKEY(3, 1); C[2] = CKEY(3, 2); C[3] = CKEY(3, 3); C[4] = CKEY(4, 0); C[5] = CKEY(4, 1); C[6] = CKEY(4, 2);
    C[7] = CKEY(5, 0); C[8] = CKEY(5, 1); C[9] = CKEY(6, 0); C[10] = CKEY(6, 1); C[11] = CKEY(7, 0); C[12] = CKEY(7, 1); C[13] = 0u; C[14] = 0u; C[15] = 0u;
#pragma unroll
    for (int i = 0; i < 8; ++i) { D[i] = CKEY(8 + i, 0); D[8 + i] = 0u; }
#undef CKEY
    merge16(B, false);
    sort16(C, false);
    unsigned top[16];
#pragma unroll
    for (int i = 0; i < 16; ++i) { A[i] = A[i] > B[i] ? A[i] : B[i]; D[i] = D[i] > C[i] ? D[i] : C[i]; }
    merge16(A, true); merge16(D, false);
#pragma unroll
    for (int i = 0; i < 16; ++i) top[i] = A[i] > D[i] ? A[i] : D[i];
    merge16(top, true);
    tbl_finish(J, k0 + 2 * kstep, tin); tbl_issue(J, k0 + 3 * kstep, tin);
    const size_t obase = ((size_t)(t0 + row) * 8 + h) * 16;
    LAS unsigned char* slot = F.lds + tid * 32;
    *(LAS v4u*)slot = (v4u){ib1[0], ib1[1], ib1[2], ib1[3]}; *(LAS v4u*)(slot + 16) = (v4u){ib2[0], ib2[1], ib2[2], ib2[3]};
    if (kh == 0) {
        unsigned short* IDS = (unsigned short*)(F.ws + WS_IDS) + obase;
        unsigned pk[8];
#pragma unroll
        for (int q2 = 0; q2 < 8; ++q2) { unsigned ev[2];
#pragma unroll
            for (int e = 0; e < 2; ++e) { const unsigned cid = 255u - (top[2 * q2 + e] & 255u); ev[e] = (unsigned)slot[cid >> 4] * 128u + (unsigned)slot[16 + (cid & 15u)]; }
            pk[q2] = ev[0] | (ev[1] << 16); }
        *(v4u*)IDS = (v4u){pk[0], pk[1], pk[2], pk[3]}; *(v4u*)(IDS + 8) = (v4u){pk[4], pk[5], pk[6], pk[7]};
    } else {
        float* GT = (float*)(F.ws + WS_GATE) + obase;
        float cv[16]; float sum = 0.f;
        const float mx = unmono(top[0] & ~255u);
#pragma unroll
        for (int q = 0; q < 16; ++q) { cv[q] = fast_exp2((unmono(top[q] & ~255u) - mx) * LOG2E); sum += cv[q]; }
        const float inv = 1.f / sum;
#pragma unroll
        for (int q4 = 0; q4 < 4; ++q4) *(f32x4*)(GT + 4 * q4) = (f32x4){cv[4 * q4] * inv, cv[4 * q4 + 1] * inv, cv[4 * q4 + 2] * inv, cv[4 * q4 + 3] * inv};
    }
    tbl_finish(J, k0 + 3 * kstep, tin);
}
__device__ __forceinline__ void topk_phase(Frame& F, int layer) {
    const TblJob J{F.in[I_PU], F.in[I_PV], F.ws + WS_UT, F.ws + WS_VT, F.in[I_LNFFN], layer};
    const size_t gtid = (size_t)F.vcu * NTHREADS + F.tid, gthreads = (size_t)F.G * NTHREADS;
    size_t k = gtid;
#pragma unroll 1
    for (int a = F.vcu; a < (NT / 256) * 8; a += F.G) { topk_unit(F, a >> 3, a & 7, layer, J, k, gthreads); k += 4 * gthreads; }
#pragma unroll 1
    for (; k < 2 * TBL_ITEMS; k += gthreads) { f32x4 tin[4]; tbl_issue(J, k, tin); tbl_finish(J, k, tin); }
}
__device__ __forceinline__ float gelu_tanh(float x) { const float y = 1.5957691216057308f * (x + 0.044715f * x * x * x); return x * fast_rcp(1.f + fast_exp2(-y * LOG2E)); }
constexpr float HN_SCALE = 16.f;
__device__ __forceinline__ void fp8x16_to_f32(const v4u w, float (&o)[16]) {
#pragma unroll
    for (int i = 0; i < 4; ++i) { const f32x2_t a = __builtin_amdgcn_cvt_pk_f32_fp8((int)w[i], false), b = __builtin_amdgcn_cvt_pk_f32_fp8((int)w[i], true); o[4 * i] = a.x; o[4 * i + 1] = a.y; o[4 * i + 2] = b.x; o[4 * i + 3] = b.y; }
}
constexpr int E1_TSTR = 144, E1_TILE = 16 * E1_TSTR, E1_WAVE_LDS = 8 * E1_TILE;
__device__ __forceinline__ void slice_assign(Frame& F, int& j, int& wv, int& nwv) {
    const int per = F.G >> 3; j = F.vcu / per; wv = (F.vcu % per) * NWAVES + F.wave; nwv = per * NWAVES;
    if (F.xrank >= 0) {
        unsigned* bar = F.ctl + 4096; unsigned sum = 0u, mine = 0u; bool all = true;
#pragma unroll
        for (int x = 0; x < 8; ++x) { const unsigned cx = xb_ld(&bar[XB_XCNT(x)]); sum += cx; all = all && (cx > 0u); mine = (x == F.xcc) ? cx : mine; }
        if (all && sum == (unsigned)F.G) { j = F.xcc; wv = F.xrank * NWAVES + F.wave; nwv = (int)mine * NWAVES; }
    }
}
struct E1Small { v2u idw; v4u bq[2]; };
__device__ __forceinline__ void e1_small(E1Small& S, int t, const unsigned short* IDS, const unsigned char* XSEL, int lane) {
    S.idw = *(const v2u*)((const unsigned*)IDS + (size_t)t * 64 + 8 * (lane >> 3) + 2 * (lane & 3));
    S.bq[0] = *(const v4u*)(XSEL + (size_t)t * DM); S.bq[1] = *(const v4u*)(XSEL + (size_t)t * DM + 16);
}
template <int CTRL> __device__ __forceinline__ unsigned dppu(unsigned v) { return (unsigned)__builtin_amdgcn_update_dpp(0, (int)v, CTRL, 0xf, 0xf, false); }
__device__ __forceinline__ void gather16(v4u (&G)[16], v2u idw, const unsigned char* TBu  , unsigned lofs  , int lane) {
    unsigned W[8];
    W[0] = dppu<0x00>(idw.x); W[1] = dppu<0x00>(idw.y); W[2] = dppu<0x55>(idw.x); W[3] = dppu<0x55>(idw.y);
    W[4] = dppu<0xAA>(idw.x); W[5] = dppu<0xAA>(idw.y); W[6] = dppu<0xFF>(idw.x); W[7] = dppu<0xFF>(idw.y);
#pragma unroll
    for (int b = 0; b < 16; ++b) { const unsigned id = (b & 1) ? (W[b >> 1] >> 16) : (W[b >> 1] & 0xffffu);
        G[b] = *(const v4u*)(TBu + (id * 128u + lofs)); }
}
__device__ __forceinline__ long mk64(unsigned lo, unsigned hi) { return (long)(((unsigned long long)hi << 32) | lo); }
__device__ __forceinline__ void e1_process(const v4u (&G)[16], const E1Small& S, float* PARTt, LAS unsigned char* tile, unsigned wofs, unsigned rofs, int fr, int kg) {
#pragma unroll
    for (int gi = 0; gi < 8; ++gi) { LAS unsigned char* tb = tile + gi * E1_TILE; *(LAS v4u*)(tb + wofs) = G[2 * gi]; *(LAS v4u*)(tb + 8 * E1_TSTR + wofs) = G[2 * gi + 1]; }
    f32x4 acc[8];
#pragma unroll
    for (int gi = 0; gi < 8; ++gi) {
        const LAS unsigned char* tb = tile + gi * E1_TILE;
        const v4u a0 = *(const LAS v4u*)(tb + rofs), a1 = *(const LAS v4u*)(tb + rofs + 16);
        const v8i_t av = {(int)a0.x, (int)a0.y, (int)a0.z, (int)a0.w, (int)a1.x, (int)a1.y, (int)a1.z, (int)a1.w};
        const v8i_t bv = {(int)S.bq[0].x, (int)S.bq[0].y, (int)S.bq[0].z, (int)S.bq[0].w, (int)S.bq[1].x, (int)S.bq[1].y, (int)S.bq[1].z, (int)S.bq[1].w};
        acc[gi] = __builtin_amdgcn_mfma_scale_f32_16x16x128_f8f6f4(av, bv, (f32x4){0.f, 0.f, 0.f, 0.f}, 0, 0, 0, 0x7f7f7f7f, 0, 0x7f7f7f7f);
    }
#pragma unroll
    for (int gi = 0; gi < 8; ++gi) { f32x4 o;
#pragma unroll
        for (int r = 0; r < 4; ++r) { const float v = acc[gi][r]; o[r] = v + __builtin_bit_cast(float, __builtin_amdgcn_update_dpp(0, __builtin_bit_cast(int, v), 0x128, 0xf, 0xf, false)); }
        acc[gi] = o; }
    if (fr < 2) {
#pragma unroll
        for (int g2 = 0; g2 < 4; ++g2) { const f32x4 v = fr ? acc[2 * g2 + 1] : acc[2 * g2]; *(f32x4*)(PARTt + 32 * g2 + 16 * fr + 4 * kg) = v; }
    }
}
__device__ __forceinline__ void e1_phase(Frame& F, int layer) {
    const int lane = F.lane, e8 = lane >> 3, c = lane & 7, fr = lane & 15, kg = lane >> 4;
    int j, wv, nwv; slice_assign(F, j, wv, nwv);
    if (j >= 8) return;
    const unsigned char* UT = F.ws + WS_UT + ((size_t)(layer * 8 + j) * NEXP) * 128; const unsigned lofs = 16u * (unsigned)c;
    const unsigned short* IDS = (const unsigned short*)(F.ws + WS_IDS);
    float* PART = (float*)(F.ws + SP_PART) + (size_t)j * NT * 128;
    const float* RSV = (const float*)(F.ws + WS_RSV);
    const unsigned char* XBj = F.ws + (fr < 8 ? WS_XH8 : WS_XL8) + 128 * j + 32 * kg;
    LAS unsigned char* tile = F.lds + F.wave * E1_WAVE_LDS;
    const unsigned wofs = (unsigned)(e8 * E1_TSTR + 16 * c), rofs = (unsigned)(fr * E1_TSTR + 32 * kg);
    if (wv >= NT) return;
    const int last = wv + ((NT - 1 - wv) / nwv) * nwv;
#define CLAMP(tt) ((tt) <= last ? (tt) : last)
    E1Small S0, S1, S2, S3; v4u GA[16], GB[16];
    e1_small(S0, wv, IDS, XBj, lane); e1_small(S1, CLAMP(wv + nwv), IDS, XBj, lane); e1_small(S2, CLAMP(wv + 2 * nwv), IDS, XBj, lane);
    gather16(GA, S0.idw, UT, lofs, lane);
    int t = wv;
#pragma unroll 1
    for (; t + 3 * nwv <= last; t += 4 * nwv) {
        gather16(GB, S1.idw, UT, lofs, lane); e1_small(S3, t + 3 * nwv, IDS, XBj, lane);
        e1_process(GA, S0, PART + (size_t)t * 128, tile, wofs, rofs, fr, kg);
        gather16(GA, S2.idw, UT, lofs, lane); e1_small(S0, CLAMP(t + 4 * nwv), IDS, XBj, lane);
        e1_process(GB, S1, PART + (size_t)(t + nwv) * 128, tile, wofs, rofs, fr, kg);
        gather16(GB, S3.idw, UT, lofs, lane); e1_small(S1, CLAMP(t + 5 * nwv), IDS, XBj, lane);
        e1_process(GA, S2, PART + (size_t)(t + 2 * nwv) * 128, tile, wofs, rofs, fr, kg);
        gather16(GA, S0.idw, UT, lofs, lane); e1_small(S2, CLAMP(t + 6 * nwv), IDS, XBj, lane);
        e1_process(GB, S3, PART + (size_t)(t + 3 * nwv) * 128, tile, wofs, rofs, fr, kg);
    }
    if (t <= last) {
        const bool h1 = t + nwv <= last, h2 = t + 2 * nwv <= last;
        if (h1) gather16(GB, S1.idw, UT, lofs, lane);
        e1_process(GA, S0, PART + (size_t)t * 128, tile, wofs, rofs, fr, kg);
        if (h1) {
            if (h2) gather16(GA, S2.idw, UT, lofs, lane);
            e1_process(GB, S1, PART + (size_t)(t + nwv) * 128, tile, wofs, rofs, fr, kg);
            if (h2) e1_process(GA, S2, PART + (size_t)(t + 2 * nwv) * 128, tile, wofs, rofs, fr, kg);
        }
    }
}
constexpr float CF_SCALE = 32.f;
constexpr int E2_OFF_O = 128 * E1_TSTR, E2_WAVE_LDS = E2_OFF_O + 512;
typedef int v2i_t __attribute__((ext_vector_type(2)));
__device__ __forceinline__ void coef_phase(Frame& F) {
    const int lane = F.lane; const float* GT = (const float*)(F.ws + WS_GATE); const float* PART = (const float*)(F.ws + SP_PART); const float* RSV = (const float*)(F.ws + WS_RSV);
    unsigned char* CH = F.ws + WS_CH8; unsigned char* CL = F.ws + WS_CL8;
    const int gw = F.vcu * NWAVES + F.wave, NGW = F.G * NWAVES;
    const int gs0 = 32 * (lane & 3) + (lane >> 2);
    int t = gw;
#pragma unroll 1
    for (; t + NGW < NT; t += 2 * NGW) {
        f32x2_t p[2][8], g[2]; float rsv[2];
#pragma unroll
        for (int u = 0; u < 2; ++u) { const size_t tt = (size_t)(t + u * NGW);
#pragma unroll
            for (int jj = 0; jj < 8; ++jj) p[u][jj] = *(const f32x2_t*)(PART + ((size_t)jj * NT + tt) * 128 + 2 * lane);
            g[u] = (f32x2_t){GT[tt * 128 + gs0], GT[tt * 128 + gs0 + 16]}; rsv[u] = RSV[tt]; }
#pragma unroll
        for (int u = 0; u < 2; ++u) { const size_t tt = (size_t)(t + u * NGW);
            float dA = 0.f, dB = 0.f;
#pragma unroll
            for (int jj = 0; jj < 8; ++jj) { dA += p[u][jj].x; dB += p[u][jj].y; }
            const float rsx = rsv[u] * (1.f / (U_SCALE * HN_SCALE));
            const float cfA = g[u].x * gelu_tanh(dA * rsx) * CF_SCALE, cfB = g[u].y * gelu_tanh(dB * rsx) * CF_SCALE;
            const unsigned h = pk_fp8x4(cfA, cfB, 0.f, 0.f); const f32x2_t hb = __builtin_amdgcn_cvt_pk_f32_fp8((int)h, false); const unsigned l = pk_fp8x4(cfA - hb.x, cfB - hb.y, 0.f, 0.f);
            *(unsigned short*)(CH + tt * 128 + 2 * lane) = (unsigned short)(h & 0xffffu); *(unsigned short*)(CL + tt * 128 + 2 * lane) = (unsigned short)(l & 0xffffu); }
    }
    for (; t < NT; t += NGW) {
        float dA = 0.f, dB = 0.f;
#pragma unroll
        for (int jj = 0; jj < 8; ++jj) { const f32x2_t v = *(const f32x2_t*)(PART + ((size_t)jj * NT + t) * 128 + 2 * lane); dA += v.x; dB += v.y; }
        const f32x2_t g = (f32x2_t){GT[(size_t)t * 128 + gs0], GT[(size_t)t * 128 + gs0 + 16]}; const float rsx = RSV[t] * (1.f / (U_SCALE * HN_SCALE));
        const float cfA = g.x * gelu_tanh(dA * rsx) * CF_SCALE, cfB = g.y * gelu_tanh(dB * rsx) * CF_SCALE;
        const unsigned h = pk_fp8x4(cfA, cfB, 0.f, 0.f); const f32x2_t hb = __builtin_amdgcn_cvt_pk_f32_fp8((int)h, false); const unsigned l = pk_fp8x4(cfA - hb.x, cfB - hb.y, 0.f, 0.f);
        *(unsigned short*)(CH + (size_t)t * 128 + 2 * lane) = (unsigned short)(h & 0xffffu); *(unsigned short*)(CL + (size_t)t * 128 + 2 * lane) = (unsigned short)(l & 0xffffu);
    }
}
struct E2Small { v2u idw; long a[4]; v2u xr; };
__device__ __forceinline__ void e2_small(E2Small& S, int t, const unsigned short* IDS, const unsigned char* CSEL, const bf16* XRj, int lane) {
    S.idw = *(const v2u*)((const unsigned*)IDS + (size_t)t * 64 + 8 * (lane >> 3) + 2 * (lane & 3));
#pragma unroll
    for (int ks = 0; ks < 4; ++ks) S.a[ks] = *(const long*)(CSEL + (size_t)t * 128 + 32 * ks);
    if (lane < 32) S.xr = *(const v2u*)(XRj + (size_t)t * DM);
}
__device__ __forceinline__ void e2_process(const v4u (&G)[16], const E2Small& S, float* xp  , bf16* bp  , float* rs8p, LAS unsigned char* wl, int lane) {
    const int e8 = lane >> 3, c = lane & 7, fr = lane & 15, kg = lane >> 4;
#pragma unroll
    for (int b = 0; b < 16; ++b) *(LAS v4u*)(wl + (8 * b + e8) * E1_TSTR + 16 * c) = G[b];
    const unsigned trofs = (unsigned)((8 * kg + (fr >> 1)) * E1_TSTR + 8 * (fr & 1));
    f32x4 acc[8];
    const v8i_t av = {(int)(unsigned)S.a[0], (int)((unsigned long)S.a[0] >> 32), (int)(unsigned)S.a[1], (int)((unsigned long)S.a[1] >> 32), (int)(unsigned)S.a[2], (int)((unsigned long)S.a[2] >> 32), (int)(unsigned)S.a[3], (int)((unsigned long)S.a[3] >> 32)};
#pragma unroll
    for (int n = 0; n < 8; ++n) {
        v2i_t b4[4];
#pragma unroll
        for (int ks = 0; ks < 4; ++ks) b4[ks] = __builtin_amdgcn_ds_read_tr8_b64_v2i32((LAS v2i_t*)(wl + trofs + ks * 32 * E1_TSTR + 16 * n));
        const v8i_t bv = {b4[0].x, b4[0].y, b4[1].x, b4[1].y, b4[2].x, b4[2].y, b4[3].x, b4[3].y};
        acc[n] = __builtin_amdgcn_mfma_scale_f32_16x16x128_f8f6f4(av, bv, (f32x4){0.f, 0.f, 0.f, 0.f}, 0, 0, 0, 0x7f7f7f7f, 0, 0x7f7f7f7f); }
    LAS float* ol = (LAS float*)(wl + E2_OFF_O);
    LAS float* ol2 = (LAS float*)wl;
    if ((lane & 16) == 0) { LAS float* p = ((lane < 32) ? ol : ol2) + (lane & 15);
#pragma unroll
        for (int n = 0; n < 8; ++n) p[16 * n] = acc[n][0]; }
    float ss = 0.f;
    if (lane < 32) {
        const f32x4 o = *(const LAS f32x4*)(ol + 4 * lane) + *(const LAS f32x4*)(ol2 + 4 * lane);
        const f32x4 x = (f32x4){bf_lo(S.xr.x), bf_hi(S.xr.x), bf_lo(S.xr.y), bf_hi(S.xr.y)} + o * (1.f / (V_SCALE * CF_SCALE));
        ss = (x.x * x.x + x.y * x.y) + (x.z * x.z + x.w * x.w);
        if (xp) *(f32x4*)xp = x;
        if (bp) *(v2u*)bp = (v2u){pk2(x.x, x.y), pk2(x.z, x.w)};
    }
    ss = wave_sum(ss);
    if (lane == 0) *rs8p = ss;
}
__device__ __forceinline__ void e2_phase(Frame& F, int layer, const bf16* XIN, bf16* XBOUT, float* XFOUT) {
    const int lane = F.lane, e8 = lane >> 3, c = lane & 7, fr = lane & 15, kg = lane >> 4;
    int j, wv, nwv; slice_assign(F, j, wv, nwv);
    if (j >= 8) return;
    const unsigned char* VT = F.ws + WS_VT + ((size_t)(layer * 8 + j) * NEXP) * 128; const unsigned lofs = 16u * (unsigned)c;
    const unsigned short* IDS = (const unsigned short*)(F.ws + WS_IDS);
    const unsigned char* CSEL = F.ws + (fr < 8 ? WS_CH8 : WS_CL8) + 8 * kg;
    const bf16* XRj = XIN + 128 * j + 4 * (lane & 31); float* RS8 = (float*)(F.ws + WS_RS8) + j;
    bf16* XBj = XBOUT ? XBOUT + 128 * j + 4 * (lane & 31) : nullptr; float* XFj = XFOUT ? XFOUT + 128 * j + 4 * (lane & 31) : nullptr;
    LAS unsigned char* wl = F.lds + F.wave * E2_WAVE_LDS;
    if (wv >= NT) return;
    const int last = wv + ((NT - 1 - wv) / nwv) * nwv;
    E2Small SA, SB, SC, SD; v4u GA[16], GB[16];
    e2_small(SA, wv, IDS, CSEL, XRj, lane); e2_small(SB, CLAMP(wv + nwv), IDS, CSEL, XRj, lane); e2_small(SC, CLAMP(wv + 2 * nwv), IDS, CSEL, XRj, lane);
    gather16(GA, SA.idw, VT, lofs, lane);
    int t = wv;
#pragma unroll 1
    for (; t + nwv <= last; t += 2 * nwv) {
        gather16(GB, SB.idw, VT, lofs, lane); e2_small(SD, CLAMP(t + 3 * nwv), IDS, CSEL, XRj, lane);
        e2_process(GA, SA, XFj ? XFj + (size_t)t * DM : nullptr, XBj ? XBj + (size_t)t * DM : nullptr, RS8 + (size_t)t * 8, wl, lane);
        e2_small(SA, CLAMP(t + 4 * nwv), IDS, CSEL, XRj, lane); gather16(GA, SC.idw, VT, lofs, lane);
        e2_process(GB, SB, XFj ? XFj + (size_t)(t + nwv) * DM : nullptr, XBj ? XBj + (size_t)(t + nwv) * DM : nullptr, RS8 + (size_t)(t + nwv) * 8, wl, lane);
        { const E2Small tmp = SA; SA = SC; SB = SD; SC = tmp; }
    }
    if (t <= last) e2_process(GA, SA, XFj ? XFj + (size_t)t * DM : nullptr, XBj ? XBj + (size_t)t * DM : nullptr, RS8 + (size_t)t * 8, wl, lane);
#undef CLAMP
}
__device__ __forceinline__ void final_norm_phase(Frame& F) {
    const int lane = F.lane; float* OUT = F.out; const bf16* X = (const bf16*)(F.ws + WS_HN); const float* RS8 = (const float*)(F.ws + WS_RS8); const float* gf = F.in[I_LNF];
    const int gw = F.vcu * NWAVES + F.wave, NGW = F.G * NWAVES;
    f32x4 g4[4];
#pragma unroll
    for (int q = 0; q < 4; ++q) g4[q] = *(const f32x4*)(gf + 256 * q + 4 * lane);
    int t = gw;
#pragma unroll 1
    for (; t + 3 * NGW < NT; t += 4 * NGW) {
        f32x4 q0[4], q1[4]; v2u w[4][4];
#pragma unroll
        for (int u = 0; u < 4; ++u) { const size_t tt = (size_t)(t + u * NGW); q0[u] = *(const f32x4*)(RS8 + tt * 8); q1[u] = *(const f32x4*)(RS8 + tt * 8 + 4);
#pragma unroll
            for (int q = 0; q < 4; ++q) w[u][q] = *(const v2u*)(X + tt * DM + 256 * q + 4 * lane); }
#pragma unroll
        for (int u = 0; u < 4; ++u) { const size_t tt = (size_t)(t + u * NGW);
            const float rs = 1.f / sqrtf((((q0[u].x + q0[u].y) + (q0[u].z + q0[u].w)) + ((q1[u].x + q1[u].y) + (q1[u].z + q1[u].w))) * (1.f / DM) + EPS);
#pragma unroll
            for (int q = 0; q < 4; ++q) *(f32x4*)(OUT + tt * DM + 256 * q + 4 * lane) = (f32x4){bf_lo(w[u][q].x), bf_hi(w[u][q].x), bf_lo(w[u][q].y), bf_hi(w[u][q].y)} * rs * g4[q]; }
    }
    for (; t < NT; t += NGW) {
        const f32x4 q0 = *(const f32x4*)(RS8 + (size_t)t * 8), q1 = *(const f32x4*)(RS8 + (size_t)t * 8 + 4);
        const float rs = 1.f / sqrtf((((q0.x + q0.y) + (q0.z + q0.w)) + ((q1.x + q1.y) + (q1.z + q1.w))) * (1.f / DM) + EPS);
#pragma unroll
        for (int q = 0; q < 4; ++q) { const v2u w = *(const v2u*)(X + (size_t)t * DM + 256 * q + 4 * lane);
            *(f32x4*)(OUT + (size_t)t * DM + 256 * q + 4 * lane) = (f32x4){bf_lo(w.x), bf_hi(w.x), bf_lo(w.y), bf_hi(w.y)} * rs * g4[q]; }
    }
}
}

namespace gla {
__device__ __forceinline__ void prep_unit(Frame& F, int item) {
    const int tid = F.tid, bh = item >> 7, chunk = item & 127, b = bh >> 2, h = bh & 3;
    const int t0 = b * SEQ + 64 * chunk;
    bf16* KG = (bf16*)(F.ws + S1_K); bf16* VG = (bf16*)(F.ws + S1_V); const float* ZG = (const float*)(F.ws + S1_Z);
    float* DEC = (float*)(F.ws + WS_DEC);
    LAS float* TOT = (LAS float*)F.lds;
    LAS bf16* VL = (LAS bf16*)(F.lds + 4096);
    const int dk = tid & 127, seg = tid >> 7;
    float w2r[16];
#pragma unroll
    for (int j = 0; j < 16; ++j) w2r[j] = F.in[I_WG2][j * 512 + h * 128 + dk];
    const float b2 = F.in[I_BG2][h * 128 + dk];
    float cum[16], kv[16]; float run = 0.f;
#pragma unroll
    for (int j = 0; j < 16; ++j) { const int s = 16 * seg + j; const float* zp = ZG + (size_t)(t0 + s) * 16;
        const f32x4 z0 = *(const f32x4*)zp, z1 = *(const f32x4*)(zp + 4), z2 = *(const f32x4*)(zp + 8), z3 = *(const f32x4*)(zp + 12);
        float xg = b2 + z0.x * w2r[0] + z0.y * w2r[1] + z0.z * w2r[2] + z0.w * w2r[3] + z1.x * w2r[4] + z1.y * w2r[5] + z1.z * w2r[6] + z1.w * w2r[7]
                      + z2.x * w2r[8] + z2.y * w2r[9] + z2.z * w2r[10] + z2.w * w2r[11] + z3.x * w2r[12] + z3.y * w2r[13] + z3.z * w2r[14] + z3.w * w2r[15];
        const float la = (fminf(xg, 0.f) - __builtin_amdgcn_logf(1.f + fast_exp2(-fabsf(xg) * LOG2E)) * 0.6931471805599453f) * (1.f / 16.f);
        run += la; cum[j] = run; kv[j] = bf2f(KG[(size_t)(t0 + s) * 512 + h * 128 + dk]); }
    TOT[seg * 128 + dk] = run;
#pragma unroll
    for (int i = 0; i < 4; ++i) { const int q = tid + 512 * i, s = q >> 5, cc = q & 31; const v4u v = *(const v4u*)(VG + (size_t)(t0 + s) * 1024 + h * 256 + 8 * cc);
        *(LAS v2u*)(VL + s * 264 + 8 * cc) = (v2u){v.x, v.y}; *(LAS v2u*)(VL + s * 264 + 8 * cc + 4) = (v2u){v.z, v.w}; }
    __syncthreads();
    float off = 0.f, total = 0.f;
#pragma unroll
    for (int g = 0; g < 4; ++g) { const float tg = TOT[g * 128 + dk]; total += tg; if (g < seg) off += tg; }
    unsigned pk[8];
#pragma unroll
    for (int j = 0; j < 16; j += 2) pk[j >> 1] = pk2(kv[j] * fast_exp2((total - (off + cum[j])) * LOG2E), kv[j + 1] * fast_exp2((total - (off + cum[j + 1])) * LOG2E));
    bf16* kd = KG + (size_t)(t0 + (dk >> 1)) * 512 + h * 128 + (dk & 1) * 64 + 16 * seg;
    *(v4u*)kd = (v4u){pk[0], pk[1], pk[2], pk[3]}; *(v4u*)(kd + 8) = (v4u){pk[4], pk[5], pk[6], pk[7]};
    if (seg == 0) DEC[(size_t)item * 128 + dk] = fast_exp2(total * LOG2E);
#pragma unroll
    for (int i = 0; i < 4; ++i) { const int o = tid + 512 * i, dv = o >> 3, sb = o & 7; unsigned w[4];
#pragma unroll
        for (int j = 0; j < 4; ++j) w[j] = (unsigned)VL[(8 * sb + 2 * j) * 264 + dv] | ((unsigned)VL[(8 * sb + 2 * j + 1) * 264 + dv] << 16);
        *(v4u*)(VG + (size_t)(t0 + (dv >> 2)) * 1024 + h * 256 + (dv & 3) * 64 + 8 * sb) = (v4u){w[0], w[1], w[2], w[3]}; }
    __syncthreads();
}
__device__ __forceinline__ int crow(int r, int hi) { return (r & 3) + 8 * (r >> 2) + 4 * hi; }
constexpr int NSEG = 16, CPS = 128 / NSEG;
constexpr int SK_KSTR = 144, SK_QSTR = 264;
constexpr int SK_OFF_Q = 128 * SK_KSTR, SK_OFF_D = SK_OFF_Q + 64 * SK_QSTR, SK_BUF = SK_OFF_D + 512;
template <bool READOUT>
__device__ __forceinline__ void scan_task(Frame& F, int bh, int seg, int w) {
    const int tid = F.tid, lane = F.lane, r32 = lane & 31, hi = lane >> 5, b = bh >> 2, h = bh & 3;
    const bf16* QG = (const bf16*)(F.ws + S1_Q); const bf16* KG = (const bf16*)(F.ws + S1_K); const bf16* VG = (const bf16*)(F.ws + S1_V);
    const float* DEC = (const float*)(F.ws + WS_DEC); bf16* OUT = (bf16*)(F.ws + WS_XRES);
    float* LSEG = (float*)(F.ws + WS_LSEG); float* PSEG = (float*)(F.ws + WS_PSEG);
    LAS unsigned char* lds = F.lds;
    f32x16 st[4];
#pragma unroll
    for (int d = 0; d < 4; ++d)
#pragma unroll
        for (int r = 0; r < 16; ++r) st[d][r] = 0.f;
    if (!READOUT && w == 0) {
        float p0 = 1.f, p1 = 1.f;
#pragma unroll
        for (int c = 0; c < CPS; ++c) { const float* dc = DEC + (size_t)(bh * 128 + seg * CPS + c) * 128; p0 *= dc[lane]; p1 *= dc[64 + lane]; }
        PSEG[(size_t)(bh * NSEG + seg) * 128 + lane] = p0; PSEG[(size_t)(bh * NSEG + seg) * 128 + 64 + lane] = p1;
    }
    const unsigned lv = (unsigned)((r32 >> 2) * 1024 + (r32 & 3) * 64 + 8 * hi);
    const unsigned lo = (unsigned)(4 * hi * 1024 + r32);
    const unsigned ld = (unsigned)(4 * hi);
    if (READOUT) {
#pragma unroll 1
        for (int j = 0; j < seg; ++j) {
            const float* pj = PSEG + (size_t)(bh * NSEG + j) * 128; const float* lj = LSEG + ((size_t)((bh * NSEG + j) * 8 + w) * 16) * 256;
#pragma unroll
            for (int db = 0; db < 4; ++db)
#pragma unroll
                for (int rg = 0; rg < 4; ++rg) { const f32x4 p4 = *(const f32x4*)(pj + 32 * db + 8 * rg + ld), l4 = *(const f32x4*)(lj + (size_t)(db * 4 + rg) * 256 + 4 * lane);
                    st[db][4 * rg] = st[db][4 * rg] * p4.x + l4.x; st[db][4 * rg + 1] = st[db][4 * rg + 1] * p4.y + l4.y; st[db][4 * rg + 2] = st[db][4 * rg + 2] * p4.z + l4.z; st[db][4 * rg + 3] = st[db][4 * rg + 3] * p4.w + l4.w; }
        }
    }
    const int srow = tid >> 4, spiece = tid & 15;
    const unsigned kdst = (unsigned)((2 * srow + (spiece >> 3)) * SK_KSTR + (spiece & 7) * 16), qdst = (unsigned)(SK_OFF_Q + srow * SK_QSTR + spiece * 16);
    v4u rk0, rk1, rq0, rq1; f32x4 rd; bf16x8 bu[4];
#define SK_LOAD(ch) do { const int t0_ = b * SEQ + 64 * (ch); const bf16* kp_ = KG + (size_t)(t0_ + srow) * 512 + h * 128 + spiece * 8; rk0 = *(const v4u*)kp_; rk1 = *(const v4u*)(kp_ + (size_t)32 * 512); \
        if (READOUT) { const bf16* qp_ = QG + (size_t)(t0_ + srow) * 512 + h * 128 + spiece * 8; rq0 = *(const v4u*)qp_; rq1 = *(const v4u*)(qp_ + (size_t)32 * 512); } \
        if (tid < 32) rd = *(const f32x4*)(DEC + (size_t)(bh * 128 + (ch)) * 128 + 4 * tid); \
        const bf16* vb_ = VG + (size_t)(t0_ + 8 * w) * 1024 + h * 256; _Pragma("unroll") for (int ks = 0; ks < 4; ++ks) bu[ks] = *(const bf16x8*)(vb_ + 16 * ks + lv); } while (0)
#define SK_STORE(bf) do { LAS unsigned char* bb_ = lds + (bf) * SK_BUF; *(LAS v4u*)(bb_ + kdst) = rk0; *(LAS v4u*)(bb_ + kdst + 64 * SK_KSTR) = rk1; \
        if (READOUT) { *(LAS v2u*)(bb_ + qdst) = (v2u){rq0.x, rq0.y}; *(LAS v2u*)(bb_ + qdst + 8) = (v2u){rq0.z, rq0.w}; *(LAS v2u*)(bb_ + qdst + 32 * SK_QSTR) = (v2u){rq1.x, rq1.y}; *(LAS v2u*)(bb_ + qdst + 32 * SK_QSTR + 8) = (v2u){rq1.z, rq1.w}; } \
        if (tid < 32) *(LAS f32x4*)(bb_ + SK_OFF_D + 16 * tid) = rd; } while (0)
    SK_LOAD(seg * CPS); SK_STORE(0);
    bf16x8 bc[4];
#pragma unroll
    for (int ks = 0; ks < 4; ++ks) bc[ks] = bu[ks];
    __syncthreads();
#pragma unroll 1
    for (int i = 0; i < CPS; ++i) {
        const int chunk = seg * CPS + i, buf = i & 1;
        if (i + 1 < CPS) SK_LOAD(chunk + 1);
        const LAS unsigned char* bb = lds + buf * SK_BUF;
#pragma unroll
        for (int db = 0; db < 4; ++db) {
            bf16x8 au[4];
#pragma unroll
            for (int ks = 0; ks < 4; ++ks) au[ks] = *(const LAS bf16x8*)(bb + (32 * db + r32) * SK_KSTR + 32 * ks + 16 * hi);
#pragma unroll
            for (int rg = 0; rg < 4; ++rg) { const f32x4 d4 = *(const LAS f32x4*)(bb + SK_OFF_D + 4 * (32 * db + 8 * rg + 4 * hi));
                st[db][4 * rg] *= d4.x; st[db][4 * rg + 1] *= d4.y; st[db][4 * rg + 2] *= d4.z; st[db][4 * rg + 3] *= d4.w; }
#pragma unroll
            for (int ks = 0; ks < 4; ++ks) st[db] = __builtin_amdgcn_mfma_f32_32x32x16_bf16(au[ks], bc[ks], st[db], 0, 0, 0);
        }
        if (READOUT) {
            bf16* ob = OUT + (size_t)(b * SEQ + 64 * chunk) * 1024 + h * 256 + 32 * w;
#pragma unroll
            for (int sb = 0; sb < 2; ++sb) {
                f32x16 oa;
#pragma unroll
                for (int r = 0; r < 16; ++r) oa[r] = 0.f;
                const LAS unsigned char* qp = bb + SK_OFF_Q + (32 * sb + r32) * SK_QSTR + 8 * hi;
#pragma unroll
                for (int db = 0; db < 4; ++db)
#pragma unroll
                    for (int hs = 0; hs < 2; ++hs) {
                        const v2u qa = *(const LAS v2u*)(qp + 2 * (32 * db + 16 * hs)), qc = *(const LAS v2u*)(qp + 2 * (32 * db + 16 * hs) + 16);
                        const v4u aw = {qa.x, qa.y, qc.x, qc.y};
                        const v4u bw = {pk2(st[db][8 * hs], st[db][8 * hs + 1]), pk2(st[db][8 * hs + 2], st[db][8 * hs + 3]), pk2(st[db][8 * hs + 4], st[db][8 * hs + 5]), pk2(st[db][8 * hs + 6], st[db][8 * hs + 7])};
                        oa = __builtin_amdgcn_mfma_f32_32x32x16_bf16(__builtin_bit_cast(bf16x8, aw), __builtin_bit_cast(bf16x8, bw), oa, 0, 0, 0);
                    }
#pragma unroll
                for (int r = 0; r < 16; ++r) ob[(size_t)(32 * sb + (r & 3) + 8 * (r >> 2)) * 1024 + lo] = f2bf(oa[r]);
            }
        }
        if (i + 1 < CPS) { SK_STORE(buf ^ 1);
#pragma unroll
            for (int ks = 0; ks < 4; ++ks) bc[ks] = bu[ks]; }
        __syncthreads();
    }
#undef SK_LOAD
#undef SK_STORE
    if (!READOUT) {
        float* lj = LSEG + ((size_t)((bh * NSEG + seg) * 8 + w) * 16) * 256;
#pragma unroll
        for (int db = 0; db < 4; ++db)
#pragma unroll
            for (int rg = 0; rg < 4; ++rg) *(f32x4*)(lj + (size_t)(db * 4 + rg) * 256 + 4 * lane) = (f32x4){st[db][4 * rg], st[db][4 * rg + 1], st[db][4 * rg + 2], st[db][4 * rg + 3]};
    }
}
__device__ __forceinline__ void cu_self_fence(Frame& F) {
    asm volatile("s_waitcnt vmcnt(0)" ::: "memory"); __syncthreads();
    if (F.tid == 0) { __threadfence(); asm volatile("s_waitcnt vmcnt(0)" ::: "memory"); }
    __syncthreads();
}
__device__ __forceinline__ void post_tokens(Frame& F, int bh, int seg);
template <bool READOUT>
__device__ __forceinline__ void scan_phase(Frame& F) {
#pragma unroll 1
    for (int a = F.vcu; a < 16 * NSEG; a += F.G) {
        const int bh = a / NSEG, seg = a % NSEG;
        if (!READOUT) { for (int c = 0; c < CPS; ++c) prep_unit(F, bh * 128 + seg * CPS + c); cu_self_fence(F); }
        scan_task<READOUT>(F, bh, seg, F.wave);
        if (READOUT) { cu_self_fence(F); post_tokens(F, bh, seg); }
    }
}
__device__ __forceinline__ void post_phase(Frame& F) {
    const int lane = F.lane; bf16* OUT = (bf16*)(F.ws + WS_XRES); const bf16* GG = (const bf16*)(F.ws + S1_G);
    const float* gn = F.in[I_GLAG] + (lane & 15) * 16;
    float g[16];
#pragma unroll
    for (int i = 0; i < 16; ++i) g[i] = gn[i];
    const int gw = F.vcu * NWAVES + F.wave, NGW = F.G * NWAVES;
    for (int t = gw; t < NT; t += NGW) {
        const v4u o0 = *(const v4u*)(OUT + (size_t)t * 1024 + 16 * lane), o1 = *(const v4u*)(OUT + (size_t)t * 1024 + 16 * lane + 8);
        const v4u g0 = *(const v4u*)(GG + (size_t)t * 1024 + 16 * lane), g1 = *(const v4u*)(GG + (size_t)t * 1024 + 16 * lane + 8);
        float o[16], sg[16];
        o[0] = bf_lo(o0.x); o[1] = bf_hi(o0.x); o[2] = bf_lo(o0.y); o[3] = bf_hi(o0.y); o[4] = bf_lo(o0.z); o[5] = bf_hi(o0.z); o[6] = bf_lo(o0.w); o[7] = bf_hi(o0.w);
        o[8] = bf_lo(o1.x); o[9] = bf_hi(o1.x); o[10] = bf_lo(o1.y); o[11] = bf_hi(o1.y); o[12] = bf_lo(o1.z); o[13] = bf_hi(o1.z); o[14] = bf_lo(o1.w); o[15] = bf_hi(o1.w);
        sg[0] = bf_lo(g0.x); sg[1] = bf_hi(g0.x); sg[2] = bf_lo(g0.y); sg[3] = bf_hi(g0.y); sg[4] = bf_lo(g0.z); sg[5] = bf_hi(g0.z); sg[6] = bf_lo(g0.w); sg[7] = bf_hi(g0.w);
        sg[8] = bf_lo(g1.x); sg[9] = bf_hi(g1.x); sg[10] = bf_lo(g1.y); sg[11] = bf_hi(g1.y); sg[12] = bf_lo(g1.z); sg[13] = bf_hi(g1.z); sg[14] = bf_lo(g1.w); sg[15] = bf_hi(g1.w);
        float ss = 0.f;
#pragma unroll
        for (int i = 0; i < 16; ++i) ss += o[i] * o[i];
        ss = row16_sum(ss);
        const float rs = 1.f / sqrtf(ss * (1.f / 256.f) + EPS);
        float y[16];
#pragma unroll
        for (int i = 0; i < 16; ++i) y[i] = o[i] * rs * g[i] * sg[i];
        *(v4u*)(OUT + (size_t)t * 1024 + 16 * lane) = (v4u){pk2(y[0], y[1]), pk2(y[2], y[3]), pk2(y[4], y[5]), pk2(y[6], y[7])};
        *(v4u*)(OUT + (size_t)t * 1024 + 16 * lane + 8) = (v4u){pk2(y[8], y[9]), pk2(y[10], y[11]), pk2(y[12], y[13]), pk2(y[14], y[15])};
    }
}
__device__ __forceinline__ void post_tokens(Frame& F, int bh, int seg) {
    const int lane = F.lane, b = bh >> 2, h = bh & 3; bf16* OUT = (bf16*)(F.ws + WS_XRES); const bf16* GG = (const bf16*)(F.ws + S1_G);
    const float* gn = F.in[I_GLAG] + (lane & 15) * 16;
    float g[16];
#pragma unroll
    for (int i = 0; i < 16; ++i) g[i] = gn[i];
    const int tbase = b * SEQ + 64 * CPS * seg;
    const size_t off0 = (size_t)(tbase + F.wave * 4 + (lane >> 4)) * 1024 + h * 256 + 16 * (lane & 15);
#pragma unroll 1
    for (int half = 0; half < (64 * CPS) / 256; ++half) {
        v4u O0[8], O1[8], G0[8], G1[8];
#pragma unroll
        for (int u = 0; u < 8; ++u) { const size_t off = off0 + (size_t)(half * 8 + u) * 32 * 1024;
            O0[u] = *(const v4u*)(OUT + off); O1[u] = *(const v4u*)(OUT + off + 8); G0[u] = *(const v4u*)(GG + off); G1[u] = *(const v4u*)(GG + off + 8); }
#pragma unroll
        for (int u = 0; u < 8; ++u) { const size_t off = off0 + (size_t)(half * 8 + u) * 32 * 1024;
            const v4u o0 = O0[u], o1 = O1[u], g0 = G0[u], g1 = G1[u];
            float o[16], sg[16];
            o[0] = bf_lo(o0.x); o[1] = bf_hi(o0.x); o[2] = bf_lo(o0.y); o[3] = bf_hi(o0.y); o[4] = bf_lo(o0.z); o[5] = bf_hi(o0.z); o[6] = bf_lo(o0.w); o[7] = bf_hi(o0.w);
            o[8] = bf_lo(o1.x); o[9] = bf_hi(o1.x); o[10] = bf_lo(o1.y); o[11] = bf_hi(o1.y); o[12] = bf_lo(o1.z); o[13] = bf_hi(o1.z); o[14] = bf_lo(o1.w); o[15] = bf_hi(o1.w);
            sg[0] = bf_lo(g0.x); sg[1] = bf_hi(g0.x); sg[2] = bf_lo(g0.y); sg[3] = bf_hi(g0.y); sg[4] = bf_lo(g0.z); sg[5] = bf_hi(g0.z); sg[6] = bf_lo(g0.w); sg[7] = bf_hi(g0.w);
            sg[8] = bf_lo(g1.x); sg[9] = bf_hi(g1.x); sg[10] = bf_lo(g1.y); sg[11] = bf_hi(g1.y); sg[12] = bf_lo(g1.z); sg[13] = bf_hi(g1.z); sg[14] = bf_lo(g1.w); sg[15] = bf_hi(g1.w);
            float ss = 0.f;
#pragma unroll
            for (int i = 0; i < 16; ++i) ss += o[i] * o[i];
            ss = row16_sum(ss);
            const float rs = 1.f / sqrtf(ss * (1.f / 256.f) + EPS);
            float y[16];
#pragma unroll
            for (int i = 0; i < 16; ++i) y[i] = o[i] * rs * g[i] * sg[i];
            *(v4u*)(OUT + off) = (v4u){pk2(y[0], y[1]), pk2(y[2], y[3]), pk2(y[4], y[5]), pk2(y[6], y[7])};
            *(v4u*)(OUT + off + 8) = (v4u){pk2(y[8], y[9]), pk2(y[10], y[11]), pk2(y[12], y[13]), pk2(y[14], y[15])}; }
    }
}
}

constexpr int CW_BAR = 4096;
constexpr int N_PHASES = 19;
struct Args { const float* in[25]; float* out; unsigned char* ws; int ph_lo, ph_hi; };
__global__ void __launch_bounds__(NTHREADS, 2) fwd_kernel(Args args) {
    extern __shared__ __attribute__((aligned(16))) unsigned char lds_raw[];
    Frame F;
    F.lds = (LAS unsigned char*)lds_raw;
    F.MISC = (volatile LAS unsigned*)(F.lds + MISC_OFF);
    F.tid = threadIdx.x; F.lane = F.tid & 63; F.wave = __builtin_amdgcn_readfirstlane(F.tid >> 6);
    F.G = gridDim.x; { const int bx = blockIdx.x; F.vcu = (F.G % 8 == 0) ? (bx % 8) * (F.G / 8) + bx / 8 : bx; }
    F.in = (const float* const __attribute__((address_space(4)))*)__builtin_amdgcn_kernarg_segment_ptr();
    F.out = args.out; F.ws = args.ws; F.ctl = (unsigned*)(args.ws + WS_CTL);
    if (F.tid < 64) ((LAS unsigned*)(F.lds + MISC_OFF))[F.tid] = 0u;
    __syncthreads();
    const int lo = args.ph_lo, hi = args.ph_hi;
    const bool multi = (hi - lo) > 1;
    XcdBarrier bar; bar.bar = F.ctl + CW_BAR; bar.x = 0; bar.st = nullptr; bar.w = (unsigned)F.wave;
    F.xcc = (int)xb_xcc_id(); F.xrank = -1;
    if (multi) {
        bar.x = (unsigned)F.xcc; bar.st = F.MISC + 8;
        if (F.tid == 0) F.MISC[10] = xb_add(&bar.bar[XB_XCNT(bar.x)], 1u);
        if (F.tid == 0) { unsigned nloc, nx; xcd_barrier_complete(bar.bar, bar.x, nloc, nx); bar.st[0] = nloc; bar.st[1] = nx; }
        __syncthreads();
        F.xrank = (int)F.MISC[10];
    }
#ifndef PH_MASK
#define PH_MASK 0x7ffff
#endif
#define IN(k) ((((PH_MASK) >> (k)) & 1) && lo <= (k) && (k) < hi)
#ifndef DIAG_A
#define DIAG_A -1
#define DIAG_B -1
#endif
#define STAMP(k) do { if (DIAG_A >= 0 && blockIdx.x == 0 && F.tid == 0) F.MISC[16 + (k)] = (unsigned)__builtin_amdgcn_s_memrealtime(); } while (0)
#define SEAM(k) do { if (IN((k) + 1)) xcd_barrier(bar); STAMP((k) + 1); } while (0)
#define REFRESH() do { F.lane = lane_now(); F.tid = F.wave * 64 + F.lane; } while (0)
    bf16* HN = (bf16*)(F.ws + WS_HN);
    STAMP(0);
    if (IN(0)) { REFRESH(); p0_prologue(F); SEAM(0); }
    if (IN(1)) { REFRESH(); pg8::Gemm g{HN, (const bf16*)(F.ws + WS_WIN0), NT, EVEN_IN, DM}; pg8::StaticOrder S; S.init(NT, EVEN_IN, F.G, (int)blockIdx.x);
        EpiIn0 E{(bf16*)(F.ws + S0_Q), (bf16*)(F.ws + S0_K), (bf16*)(F.ws + S0_VT), (bf16*)(F.ws + S0_GLU)};
        pg8::gemm_phase<EpiIn0, pg8::StaticOrder, true, true>(F.lds, g, S, E, F.wave); SEAM(1); }
    if (IN(2)) { REFRESH(); att::p2_attn_conv(F); SEAM(2); }
    if (IN(3)) { REFRESH(); pg8::Gemm g{(const bf16*)(F.ws + S0_CAT), (const bf16*)(F.ws + WS_WOUT0), NT, DM, DM}; pg8::StaticOrder S; S.init(NT, DM, F.G, (int)blockIdx.x);
        EpiRes<true> E{F.in[I_X], nullptr, HN, (float*)(F.ws + WS_ROWSQ0), F.ws + WS_XH8, F.ws + WS_XL8};
        pg8::gemm_phase<EpiRes<true>, pg8::StaticOrder, true, true>(F.lds, g, S, E, F.wave); SEAM(3); }
    if (IN(4)) { REFRESH(); pg8::Gemm g{HN, (const bf16*)(F.ws + WS_WQ0), NT, PQ_N, DM}; pg8::StaticOrder S; S.init(NT, PQ_N, F.G, (int)blockIdx.x);
        EpiPq E{(bf16*)(F.ws + SP_PQ), (const float*)(F.ws + WS_ROWSQ0), (float*)(F.ws + WS_RSV), (LAS float*)(F.lds + EPI_LRS)};
        pg8::gemm_phase<EpiPq, pg8::StaticOrder, true, true>(F.lds, g, S, E, F.wave); SEAM(4); }
    if (IN(5)) { REFRESH(); for (int rep = 0; rep < PROBE_REP_TOPK; ++rep) peer::topk_phase(F, 0); SEAM(5); }
    if (IN(6)) { REFRESH(); peer::e1_phase(F, 0); SEAM(6); }
    if (IN(7)) { REFRESH(); peer::coef_phase(F); SEAM(7); }
    if (IN(8)) { REFRESH(); peer::e2_phase(F, 0, HN, HN, nullptr); SEAM(8); }
    if (IN(9)) { REFRESH(); pg8::Gemm g{HN, (const bf16*)(F.ws + WS_WIN1), NT, 3072, DM}; pg8::StaticOrder S; S.init(NT, 3072, F.G, (int)blockIdx.x);
        EpiIn1 E{(bf16*)(F.ws + S1_Q), (bf16*)(F.ws + S1_K), (bf16*)(F.ws + S1_V), (bf16*)(F.ws + S1_G), (const float*)(F.ws + WS_RS8), (LAS float*)(F.lds + EPI_LRS)};
        pg8::gemm_phase<EpiIn1, pg8::StaticOrder, true, true>(F.lds, g, S, E, F.wave); z_tail(F); SEAM(9); }
    if (IN(10)) { REFRESH(); for (int rep = 0; rep < PROBE_REP_SCAN; ++rep) gla::scan_phase<false>(F); SEAM(10); }
    if (IN(11)) { REFRESH(); for (int rep = 0; rep < PROBE_REP_SCAN; ++rep) gla::scan_phase<true>(F); SEAM(11); }
    if (IN(12)) { REFRESH(); pg8::Gemm g{(const bf16*)(F.ws + WS_XRES), (const bf16*)(F.ws + WS_WOUT1), NT, DM, DM}; pg8::StaticOrder S; S.init(NT, DM, F.G, (int)blockIdx.x);
        EpiRes<false> E{nullptr, HN, (bf16*)(F.ws + S1_G), (float*)(F.ws + WS_ROWSQ1), F.ws + WS_XH8, F.ws + WS_XL8};
        pg8::gemm_phase<EpiRes<false>, pg8::StaticOrder, true, true>(F.lds, g, S, E, F.wave); SEAM(12); }
    if (IN(13)) { REFRESH(); pg8::Gemm g{(const bf16*)(F.ws + S1_G), (const bf16*)(F.ws + WS_WQ1), NT, PQ_N, DM}; pg8::StaticOrder S; S.init(NT, PQ_N, F.G, (int)blockIdx.x);
        EpiPq E{(bf16*)(F.ws + SP_PQ), (const float*)(F.ws + WS_ROWSQ1), (float*)(F.ws + WS_RSV), (LAS float*)(F.lds + EPI_LRS)};
        pg8::gemm_phase<EpiPq, pg8::StaticOrder, true, true>(F.lds, g, S, E, F.wave); SEAM(13); }
    if (IN(14)) { REFRESH(); peer::topk_phase(F, 1); SEAM(14); }
    if (IN(15)) { REFRESH(); peer::e1_phase(F, 1); SEAM(15); }
    if (IN(16)) { REFRESH(); peer::coef_phase(F); SEAM(16); }
    if (IN(17)) { REFRESH(); peer::e2_phase(F, 1, (const bf16*)(F.ws + S1_G), HN, nullptr); SEAM(17); }
    if (IN(18)) { REFRESH(); peer::final_norm_phase(F); }
    if (DIAG_A >= 0 && blockIdx.x == 0) {
        __syncthreads(); STAMP(19);
        if (F.tid == 0) { const int a = DIAG_A, b = DIAG_B;
            const float da = (a >= 19 ? (float)(F.MISC[16 + 19] - F.MISC[16]) : (float)(F.MISC[16 + a + 1] - F.MISC[16 + a])) * 0.01f;
            const float db = (float)(F.MISC[16 + b + 1] - F.MISC[16 + b]) * 0.01f * 0.125f;
            F.out[0] = da; for (int i = 0; i < 1024; ++i) F.out[1024 + i] = db; }
    }
#undef IN
#undef SEAM
}

#ifndef N_LAUNCH_SPLIT
#define N_LAUNCH_SPLIT 0
#endif
extern "C" void kernel_launch(void* const* d_in, const int* in_sizes, int n_in, void* d_out, int out_size, void* d_ws, size_t ws_size, hipStream_t stream) {
    static int grid = 0;
    if (grid == 0) {
        if (n_in != 25 || out_size != NT * DM || ws_size < WS_END) { fprintf(stderr, "kernel_launch: unexpected shapes (n_in %d out %d ws %zu)\n", n_in, out_size, ws_size); grid = -1; return; }
        int dev = 0, cus = 0;
        if (hipGetDevice(&dev) != hipSuccess || hipDeviceGetAttribute(&cus, hipDeviceAttributeMultiprocessorCount, dev) != hipSuccess) { grid = -1; return; }
        if (hipFuncSetAttribute((const void*)fwd_kernel, hipFuncAttributeMaxDynamicSharedMemorySize, LDS_BYTES) != hipSuccess) { fprintf(stderr, "kernel_launch: hipFuncSetAttribute failed\n"); grid = -1; return; }
        int per_cu = 0;
        if (hipOccupancyMaxActiveBlocksPerMultiprocessor(&per_cu, (const void*)fwd_kernel, NTHREADS, LDS_BYTES) != hipSuccess || per_cu < 1) fprintf(stderr, "kernel_launch: occupancy query says %d\n", per_cu);
        (void)hipGetLastError();
        grid = cus;
    }
    if (grid < 0) return;
    (void)hipMemsetAsync((char*)d_ws + WS_CTL, 0, CTL_ZERO_BYTES, stream);
    Args a{};
    for (int i = 0; i < 25; ++i) a.in[i] = (const float*)d_in[i];
    a.out = (float*)d_out; a.ws = (unsigned char*)d_ws;
#if N_LAUNCH_SPLIT
    for (int p = 0; p < N_PHASES; ++p) { a.ph_lo = p; a.ph_hi = p + 1; hipLaunchKernelGGL(fwd_kernel, dim3(grid), dim3(NTHREADS), LDS_BYTES, stream, a); }
#else
    a.ph_lo = 0; a.ph_hi = N_PHASES; hipLaunchKernelGGL(fwd_kernel, dim3(grid), dim3(NTHREADS), LDS_BYTES, stream, a);
#endif
}
```
